# Optimizing an MI355X kernel written in HIP

```python
import math
import jax
import jax.numpy as jnp
from jax import lax
import numpy as np

D_MODEL = 1024
BATCH = 4
SEQ = 8192
DEPTH = 2

GRID_W = 64
CTX_LEN = 256
Q_BLOCK = 128
NORM_EPS = 1e-6

ATTN_HEADS = 8
ATTN_KV_HEADS = 2
ATTN_HEAD_DIM = 64
ATTN_AXIS_FREQS = ATTN_HEAD_DIM // 4
ROPE_THETA = 10000.0

SSD_HEADS = 8
SSD_HEAD_DIM = 64
SSD_D_INNER = SSD_HEADS * SSD_HEAD_DIM
SSD_GROUPS = 2
SSD_STATE = 128
SSD_CONV_K = 3
SSD_CONV_DIM = SSD_D_INNER + 2 * SSD_GROUPS * SSD_STATE
SSD_CHUNK = 128

RET_HEADS = 4
RET_DK = 128
RET_DV = 128
RET_CHUNK = 128

N_BRANCH = 3
BRANCH_W = 512
MLP_HIDDEN = 4 * D_MODEL

IN_SPLITS = (ATTN_HEADS * ATTN_HEAD_DIM, ATTN_KV_HEADS * ATTN_HEAD_DIM, ATTN_KV_HEADS * ATTN_HEAD_DIM,
             SSD_D_INNER, SSD_CONV_DIM, 2 * SSD_HEADS,
             RET_HEADS * RET_DK, RET_HEADS * RET_DK, RET_HEADS * RET_DV, RET_HEADS * RET_DV,
             N_BRANCH * D_MODEL)
IN_DIM = sum(IN_SPLITS)

kernel_name = 'hybrid_attn_ssd_retention_prefix_dit'


def rms_norm(x, w):
    xf = x.astype(jnp.float32)
    y = xf * lax.rsqrt(jnp.mean(xf * xf, axis=-1, keepdims=True) + NORM_EPS)
    return (y * w.astype(jnp.float32)).astype(x.dtype)


def modulate(x, shift, scale):
    return x * (1 + scale[:, None, :]) + shift[:, None, :]


def split_cols(p):
    out = []
    off = 0
    for size in IN_SPLITS:
        out.append(p[..., off:off + size])
        off += size
    return out


def flip(t):
    return jnp.flip(t, axis=1)


def rope_apply(x, cos, sin):
    half = x.shape[-1] // 2
    x1 = x[..., :half]
    x2 = x[..., half:]
    cs = cos[:, None, :].astype(x.dtype)
    sn = sin[:, None, :].astype(x.dtype)
    return jnp.concatenate([x1 * cs - x2 * sn, x1 * sn + x2 * cs], axis=-1)


def axial_angles(rows):
    row = jnp.repeat(jnp.arange(rows, dtype=jnp.float32), GRID_W)
    col = jnp.tile(jnp.arange(GRID_W, dtype=jnp.float32), rows)
    inv = ROPE_THETA ** (-jnp.arange(ATTN_AXIS_FREQS, dtype=jnp.float32) / ATTN_AXIS_FREQS)
    ang = jnp.concatenate([row[:, None] * inv, col[:, None] * inv], axis=-1)
    return jnp.cos(ang), jnp.sin(ang)


def seq_angles(start, n):
    pos = jnp.arange(n, dtype=jnp.float32) + start
    inv = ROPE_THETA ** (-jnp.linspace(0.0, 1.0, RET_DK // 2, dtype=jnp.float32))
    ang = pos[:, None] * inv
    return jnp.cos(ang), jnp.sin(ang)


def dwconv_centred(x, w, bias):
    y = lax.conv_general_dilated(
        x, w[:, None, :].astype(x.dtype), window_strides=(1,),
        padding=[(SSD_CONV_K // 2, SSD_CONV_K // 2)],
        dimension_numbers=('NWC', 'WIO', 'NWC'), feature_group_count=x.shape[-1])
    return y + bias.astype(x.dtype)


def gqa_attend(q, k, v):
    b, lq, h, hd = q.shape
    kvh = k.shape[2]
    grp = h // kvh
    qb = q.reshape(b, lq // Q_BLOCK, Q_BLOCK, kvh, grp, hd).transpose(1, 0, 2, 3, 4, 5)
    scale = hd ** -0.5

    def block(qblk):
        s = jnp.einsum('bqkgd,bskd->bkgqs', qblk, k, preferred_element_type=jnp.float32) * scale
        p = jax.nn.softmax(s, axis=-1).astype(v.dtype)
        return jnp.einsum('bkgqs,bskd->bqkgd', p, v)

    o = lax.map(block, qb)
    return o.transpose(1, 0, 2, 3, 4, 5).reshape(b, lq, h * hd)


def chunk_scan(init, states, decay):
    def step(s, inp):
        st, dc = inp
        return s * dc + st, s
    final, prev = lax.scan(step, init, (states, decay))
    return final, prev


def ssd_scan(xh, dt, a_neg, bm, cm, init, return_y):
    b, l, nh, hp = xh.shape
    ng, ns = bm.shape[2], bm.shape[3]
    r = nh // ng
    L = SSD_CHUNK
    nc = l // L
    dtf = dt.astype(jnp.float32)
    xd = (xh.astype(jnp.float32) * dtf[..., None]).reshape(b, nc, L, ng, r, hp)
    a = (dtf * a_neg).reshape(b, nc, L, ng, r).transpose(0, 3, 4, 1, 2)
    bc = bm.astype(jnp.float32).reshape(b, nc, L, ng, ns)
    a_cum = jnp.cumsum(a, axis=-1)
    decay_states = jnp.exp(a_cum[..., -1:] - a_cum)
    states = jnp.einsum('bclgn,bgrcl,bclgrp->cbgrpn', bc, decay_states, xd)
    chunk_decay = jnp.exp(a_cum[..., -1]).transpose(3, 0, 1, 2)[..., None, None]
    final, prev = chunk_scan(init, states, chunk_decay)
    if not return_y:
        return None, final
    cc = cm.astype(jnp.float32).reshape(b, nc, L, ng, ns)
    seg = a_cum[..., :, None] - a_cum[..., None, :]
    causal = jnp.tril(jnp.ones((L, L), dtype=bool))
    lmat = jnp.where(causal, jnp.exp(jnp.where(causal, seg, 0.0)), 0.0)
    cb = jnp.einsum('bclgn,bcsgn->bcgls', cc, bc)
    y_diag = jnp.einsum('bcgls,bgrcls,bcsgrp->bclgrp', cb, lmat, xd)
    y_off = jnp.einsum('bclgn,cbgrpn,bgrcl->bclgrp', cc, prev, jnp.exp(a_cum))
    return (y_diag + y_off).reshape(b, l, nh, hp), final


def retention_scan(q, k, v, lg, init, return_y):
    b, l, nh, dk = k.shape
    dv = v.shape[-1]
    L = RET_CHUNK
    nc = l // L
    kc = k.astype(jnp.float32).reshape(b, nc, L, nh, dk)
    vc = v.astype(jnp.float32).reshape(b, nc, L, nh, dv)
    pos = jnp.arange(L, dtype=jnp.float32)
    k_decay = jnp.exp((L - 1 - pos)[:, None] * lg)
    states = jnp.einsum('bcshk,sh,bcshv->cbhkv', kc, k_decay, vc)
    chunk_decay = jnp.broadcast_to(jnp.exp(L * lg)[None, None, :, None, None], (nc, 1, nh, 1, 1))
    final, prev = chunk_scan(init, states, chunk_decay)
    if not return_y:
        return None, final
    qc = q.astype(jnp.float32).reshape(b, nc, L, nh, dk)
    diff = pos[:, None] - pos[None, :]
    dmat = jnp.where(diff[None] >= 0, jnp.exp(jnp.maximum(diff, 0.0)[None] * lg[:, None, None]), 0.0)
    s = jnp.einsum('bclhk,bcshk->bchls', qc, kc) * dmat
    y_in = jnp.einsum('bchls,bcshv->bclhv', s, vc)
    q_decay = jnp.exp((pos + 1)[:, None] * lg)
    y_x = jnp.einsum('bclhk,cbhkv,lh->bclhv', qc, prev, q_decay)
    return (y_in + y_x).reshape(b, l, nh, dv), final


def attn_q(aq, q_norm, rope):
    b, l, _ = aq.shape
    q = rms_norm(aq.reshape(b, l, ATTN_HEADS, ATTN_HEAD_DIM), q_norm)
    return q if rope is None else rope_apply(q, *rope)


def attn_kv(ak, av, k_norm, rope):
    b, l, _ = ak.shape
    k = rms_norm(ak.reshape(b, l, ATTN_KV_HEADS, ATTN_HEAD_DIM), k_norm)
    if rope is not None:
        k = rope_apply(k, *rope)
    return k, av.reshape(b, l, ATTN_KV_HEADS, ATTN_HEAD_DIM)


def ssd_inputs(xbc_raw, dt_raw, conv_w, conv_b, dt_bias):
    b, l, _ = xbc_raw.shape
    gn = SSD_GROUPS * SSD_STATE
    xbc = jax.nn.silu(dwconv_centred(xbc_raw, conv_w, conv_b))
    xs = xbc[..., :SSD_D_INNER].reshape(b, l, SSD_HEADS, SSD_HEAD_DIM)
    bm = xbc[..., SSD_D_INNER:SSD_D_INNER + gn].reshape(b, l, SSD_GROUPS, SSD_STATE)
    cm = xbc[..., SSD_D_INNER + gn:].reshape(b, l, SSD_GROUPS, SSD_STATE)
    dt = jax.nn.softplus(dt_raw.astype(jnp.float32).reshape(b, l, 2, SSD_HEADS) + dt_bias.astype(jnp.float32))
    return xs, bm, cm, dt[:, :, 0], dt[:, :, 1]


def ssd_finish(y, xh, z, d_skip, norm_w):
    b, l, nh, hp = xh.shape
    y = y + d_skip.astype(jnp.float32)[:, None] * xh.astype(jnp.float32)
    y = y.reshape(b, l, nh * hp) * jax.nn.silu(z.astype(jnp.float32))
    return rms_norm(y, norm_w).astype(z.dtype)


def ret_q(rq, rope):
    b, l, _ = rq.shape
    return rope_apply(rq.reshape(b, l, RET_HEADS, RET_DK), *rope)


def ret_kv(rk, rv, rope):
    b, l, _ = rk.shape
    k = rope_apply(rk.reshape(b, l, RET_HEADS, RET_DK), *rope) * (RET_DK ** -0.5)
    return k, rv.reshape(b, l, RET_HEADS, RET_DV)


def ret_finish(y, g, gn_w):
    b, l, nh, dv = y.shape
    mu = jnp.mean(y, axis=-1, keepdims=True)
    yc = y - mu
    var = jnp.mean(yc * yc, axis=-1, keepdims=True)
    yn = (yc * lax.rsqrt(var + NORM_EPS)).reshape(b, l, nh * dv) * gn_w.astype(jnp.float32)
    return (yn * jax.nn.silu(g.astype(jnp.float32))).astype(g.dtype)


def merge_branches(br_attn, br_ssd, br_ret, gate_logits, w_branch, w_out):
    b, l, _ = gate_logits.shape
    gates = jax.nn.sigmoid(gate_logits.reshape(b, l, N_BRANCH, D_MODEL))
    merged = (gates[:, :, 0] * (br_attn @ w_branch[0])
              + gates[:, :, 1] * (br_ssd @ w_branch[1])
              + gates[:, :, 2] * (br_ret @ w_branch[2]))
    return merged @ w_out


def sq_relu_mlp(x, w1, w2):
    h = jax.nn.relu(x @ w1)
    return (h * h) @ w2


def hybrid_mixer(u_lat, u_ctx, w_in, q_norm, k_norm, conv_w, conv_b, dt_bias, a_log, d_skip,
                 ssd_norm_w, ret_log_decay, ret_gn_w, w_branch, w_out,
                 rope_lat, ret_rope_ctx, ret_rope_lat, need_ctx):
    b = u_lat.shape[0]
    pl = split_cols(u_lat @ w_in)
    pc = split_cols(u_ctx @ w_in)

    k_c, v_c = attn_kv(pc[1], pc[2], k_norm, None)
    k_l, v_l = attn_kv(pl[1], pl[2], k_norm, rope_lat)
    q_l = attn_q(pl[0], q_norm, rope_lat)
    attn_l = gqa_attend(q_l, jnp.concatenate([k_c, k_l], axis=1), jnp.concatenate([v_c, v_l], axis=1))

    x_c, b_c, c_c, dtf_c, dtb_c = ssd_inputs(pc[4], pc[5], conv_w, conv_b, dt_bias)
    x_l, b_l, c_l, dtf_l, dtb_l = ssd_inputs(pl[4], pl[5], conv_w, conv_b, dt_bias)
    a_neg = -jnp.exp(a_log.astype(jnp.float32))
    s_init = jnp.zeros((b, SSD_GROUPS, SSD_HEADS // SSD_GROUPS, SSD_HEAD_DIM, SSD_STATE), jnp.float32)
    yc_f, st_f = ssd_scan(x_c, dtf_c, a_neg[0], b_c, c_c, s_init, need_ctx)
    yc_b, st_b = ssd_scan(flip(x_c), flip(dtb_c), a_neg[1], flip(b_c), flip(c_c), s_init, need_ctx)
    yl_f, _ = ssd_scan(x_l, dtf_l, a_neg[0], b_l, c_l, st_f, True)
    yl_b, _ = ssd_scan(flip(x_l), flip(dtb_l), a_neg[1], flip(b_l), flip(c_l), st_b, True)
    ssd_l = ssd_finish(yl_f + flip(yl_b), x_l, pl[3], d_skip, ssd_norm_w)

    lg = -jnp.exp(ret_log_decay.astype(jnp.float32))
    r_init = jnp.zeros((b, RET_HEADS, RET_DK, RET_DV), jnp.float32)
    rk_c, rv_c = ret_kv(pc[7], pc[8], ret_rope_ctx)
    rq_c = ret_q(pc[6], ret_rope_ctx) if need_ctx else None
    rk_l, rv_l = ret_kv(pl[7], pl[8], ret_rope_lat)
    rq_l = ret_q(pl[6], ret_rope_lat)
    rc_f, rs_f = retention_scan(rq_c, rk_c, rv_c, lg[0], r_init, need_ctx)
    rc_b, rs_b = retention_scan(None if rq_c is None else flip(rq_c), flip(rk_c), flip(rv_c), lg[1], r_init, need_ctx)
    rl_f, _ = retention_scan(rq_l, rk_l, rv_l, lg[0], rs_f, True)
    rl_b, _ = retention_scan(flip(rq_l), flip(rk_l), flip(rv_l), lg[1], rs_b, True)
    ret_l = ret_finish(rl_f + flip(rl_b), pl[9], ret_gn_w)

    out_l = merge_branches(attn_l, ssd_l, ret_l, pl[10], w_branch, w_out)
    if not need_ctx:
        return out_l, None

    attn_c = gqa_attend(attn_q(pc[0], q_norm, None), k_c, v_c)
    ssd_c = ssd_finish(yc_f + flip(yc_b), x_c, pc[3], d_skip, ssd_norm_w)
    ret_c = ret_finish(rc_f + flip(rc_b), pc[9], ret_gn_w)
    out_c = merge_branches(attn_c, ssd_c, ret_c, pc[10], w_branch, w_out)
    return out_l, out_c


def setup_inputs(seed: int = 0) -> dict:
    key = jax.random.key(seed)
    ks = jax.random.split(key, 24)
    f32 = jnp.float32

    def nrm(k, shape, scale):
        return jax.random.normal(k, shape, f32) * scale

    dt = jnp.exp(jax.random.uniform(ks[13], (DEPTH, 2, SSD_HEADS), f32, math.log(1e-3), math.log(1e-1)))
    return {
        'x': nrm(ks[0], (BATCH, SEQ, D_MODEL), 1.0),
        'c': nrm(ks[1], (BATCH, D_MODEL), 1.0),
        'ctx': nrm(ks[2], (BATCH, CTX_LEN, D_MODEL), 1.0),
        'c_ctx': nrm(ks[3], (D_MODEL,), 1.0),
        'w_mod': nrm(ks[4], (DEPTH, D_MODEL, 6 * D_MODEL), 0.5 * D_MODEL ** -0.5),
        'b_mod': nrm(ks[5], (DEPTH, 6 * D_MODEL), 0.01),
        'norm1_w': 1.0 + nrm(ks[6], (DEPTH, D_MODEL), 0.02),
        'norm2_w': 1.0 + nrm(ks[7], (DEPTH, D_MODEL), 0.02),
        'w_in': nrm(ks[8], (DEPTH, D_MODEL, IN_DIM), D_MODEL ** -0.5),
        'attn_q_norm': 1.0 + nrm(ks[9], (DEPTH, ATTN_HEAD_DIM), 0.02),
        'attn_k_norm': 1.0 + nrm(ks[10], (DEPTH, ATTN_HEAD_DIM), 0.02),
        'ssd_conv_w': nrm(ks[11], (DEPTH, SSD_CONV_K, SSD_CONV_DIM), SSD_CONV_K ** -0.5),
        'ssd_conv_b': nrm(ks[12], (DEPTH, SSD_CONV_DIM), 0.01),
        'ssd_dt_bias': dt + jnp.log(-jnp.expm1(-dt)),
        'ssd_a_log': jnp.log(jax.random.uniform(ks[14], (DEPTH, 2, SSD_HEADS), f32, 1.0, 16.0)),
        'ssd_d': 1.0 + nrm(ks[15], (DEPTH, SSD_HEADS), 0.1),
        'ssd_norm_w': 1.0 + nrm(ks[16], (DEPTH, SSD_D_INNER), 0.02),
        'ret_log_decay': (-5.0 - jnp.arange(RET_HEADS, dtype=f32)) * math.log(2.0)
                         + nrm(ks[17], (DEPTH, 2, RET_HEADS), 0.1),
        'ret_gn_w': 1.0 + nrm(ks[18], (DEPTH, RET_HEADS * RET_DV), 0.02),
        'w_branch': nrm(ks[19], (DEPTH, N_BRANCH, BRANCH_W, D_MODEL), BRANCH_W ** -0.5),
        'w_out': nrm(ks[20], (DEPTH, D_MODEL, D_MODEL), D_MODEL ** -0.5),
        'w_mlp1': nrm(ks[21], (DEPTH, D_MODEL, MLP_HIDDEN), D_MODEL ** -0.5),
        'w_mlp2': nrm(ks[22], (DEPTH, MLP_HIDDEN, D_MODEL), MLP_HIDDEN ** -0.5),
        'final_norm_w': 1.0 + nrm(ks[23], (D_MODEL,), 0.02),
    }


def reference(x, c, ctx, c_ctx, w_mod, b_mod, norm1_w, norm2_w, w_in, attn_q_norm, attn_k_norm,
              ssd_conv_w, ssd_conv_b, ssd_dt_bias, ssd_a_log, ssd_d, ssd_norm_w, ret_log_decay,
              ret_gn_w, w_branch, w_out, w_mlp1, w_mlp2, final_norm_w):
    n = x.shape[1]
    m = ctx.shape[1]
    ROWS = n // GRID_W
    rope_lat = axial_angles(ROWS)
    ret_rope_ctx = seq_angles(0, m)
    ret_rope_lat = seq_angles(m, n)
    h_lat, h_ctx = x, ctx
    for layer in range(DEPTH):
        need_ctx = layer < DEPTH - 1
        mod_lat = jnp.split(jax.nn.silu(c) @ w_mod[layer] + b_mod[layer], 6, axis=-1)
        mod_ctx = jnp.split(jax.nn.silu(c_ctx)[None, :] @ w_mod[layer] + b_mod[layer], 6, axis=-1)
        u_lat = modulate(rms_norm(h_lat, norm1_w[layer]), mod_lat[0], mod_lat[1])
        u_ctx = modulate(rms_norm(h_ctx, norm1_w[layer]), mod_ctx[0], mod_ctx[1])
        mix_lat, mix_ctx = hybrid_mixer(
            u_lat, u_ctx, w_in[layer], attn_q_norm[layer], attn_k_norm[layer],
            ssd_conv_w[layer], ssd_conv_b[layer], ssd_dt_bias[layer], ssd_a_log[layer], ssd_d[layer],
            ssd_norm_w[layer], ret_log_decay[layer], ret_gn_w[layer], w_branch[layer], w_out[layer],
            rope_lat, ret_rope_ctx, ret_rope_lat, need_ctx)
        h_lat = h_lat + mod_lat[2][:, None, :] * mix_lat
        v_lat = modulate(rms_norm(h_lat, norm2_w[layer]), mod_lat[3], mod_lat[4])
        h_lat = h_lat + mod_lat[5][:, None, :] * sq_relu_mlp(v_lat, w_mlp1[layer], w_mlp2[layer])
        if need_ctx:
            h_ctx = h_ctx + mod_ctx[2][:, None, :] * mix_ctx
            v_ctx = modulate(rms_norm(h_ctx, norm2_w[layer]), mod_ctx[3], mod_ctx[4])
            h_ctx = h_ctx + mod_ctx[5][:, None, :] * sq_relu_mlp(v_ctx, w_mlp1[layer], w_mlp2[layer])
    return rms_norm(h_lat, final_norm_w)
```

```cpp
#include <hip/hip_runtime.h>
#include <hip/hip_cooperative_groups.h>
#include <hip/hip_bf16.h>
#include <cstdint>
#include <cstdio>
#include <cmath>
namespace cg = cooperative_groups;

#ifndef MK_ONE_LAUNCH
#define MK_ONE_LAUNCH 1
#endif

constexpr int NB = 4, NLAT = 8192, NCTX = 256, SA = NLAT + NCTX  , T = NB * SA  , DM = 1024, DEPTH = 2;
constexpr int NCH = SA / 128;
constexpr int N1 = 4352, N1W = 4608  , NGATE = 3072, HID = 4096, INDIM = 7440, MODW = 6144;
constexpr float EPS = 1e-6f;
constexpr float QC2 = 0.125f * 1.4426950408889634f;

constexpr size_t KiB = 1024, MiB = 1u << 20;
constexpr size_t OFF_MOD = 0;
constexpr size_t OFF_DT = 256 * KiB;
constexpr size_t OFF_G = OFF_DT + 2304 * KiB;
constexpr size_t OFF_CD = OFF_G + 2304 * KiB;
constexpr size_t OFF_SSQ = OFF_CD + 64 * KiB;
constexpr size_t OFF_ATAB = 6 * MiB;
constexpr size_t OFF_RTAB = 8 * MiB;
constexpr size_t OFF_HCTX = 16 * MiB;
constexpr size_t OFF_W = 20 * MiB;
constexpr size_t W_LAYER = 36 * MiB, W_P = 0, W_G = 9 * MiB, W_B = 15 * MiB, W_O = 18 * MiB, W_1 = 20 * MiB, W_2 = 28 * MiB;
constexpr size_t OFF_U = 92 * MiB;
constexpr size_t SZ512 = (size_t)T * 512 * 2;
constexpr size_t OFF_Q = 158 * MiB, OFF_Z = OFF_Q + SZ512, OFF_RG = OFF_Z + SZ512, OFF_KV = OFF_RG + SZ512;
constexpr size_t OFF_XBC = OFF_KV + SZ512 / 2, OFF_ST = OFF_XBC, OFF_CONV = OFF_XBC + 2 * SZ512;
constexpr size_t OFF_RQ = OFF_CONV + 2 * SZ512, OFF_RK = OFF_RQ + SZ512, OFF_RV = OFF_RK + SZ512, OFF_END = OFF_RV + SZ512;
constexpr size_t OFF_GATE = OFF_KV;
constexpr size_t OFF_HID = OFF_Q;
static_assert(OFF_END <= 512 * MiB, "ws map");
static_assert(OFF_GATE + (size_t)T * 3072 * 2 <= OFF_END && OFF_HID + (size_t)T * 4096 * 2 <= OFF_END, "overlays");
static_assert(OFF_SSQ + (size_t)T * 8 * 4 <= OFF_ATAB && OFF_RTAB + 8448 * 64 * 8 <= OFF_HCTX, "misc map");

constexpr int LDS_BYTES = 155648;

typedef unsigned short bf16_t;
__device__ __forceinline__ unsigned f2bf(float f) { unsigned u = __builtin_bit_cast(unsigned, f); return (u + 0x7fffu + ((u >> 16) & 1u)) >> 16; }
__device__ __forceinline__ unsigned pk2(float lo, float hi) { return f2bf(lo) | (f2bf(hi) << 16); }
__device__ __forceinline__ float bf2f(unsigned h) { return __builtin_bit_cast(float, h << 16); }
__device__ __forceinline__ float siluf(float x) { return x * __builtin_amdgcn_rcpf(1.f + __expf(-x)); }

__device__ __forceinline__ float shx(float v, int m, int lane) { return __builtin_bit_cast(float, __builtin_amdgcn_ds_bpermute((lane ^ m) << 2, __builtin_bit_cast(int, v))); }

namespace pg8 {
#define PG8_LAS __attribute__((address_space(3)))
typedef unsigned short bf16_t;
typedef short bf16x8 __attribute__((ext_vector_type(8)));
typedef float f32x4 __attribute__((ext_vector_type(4)));
typedef unsigned u32x4 __attribute__((ext_vector_type(4)));
constexpr int BM = 256, BK = 64, HALF = 128, HTB = HALF * BK * 2  , STAGE_BYTES = 8 * HTB, NXCD = 8, WGM = 8;

__host__ __device__ __forceinline__ int lds_byte(int r, int c) { const int st = (r >> 4) * 2 + (c >> 5), rr = r & 15, cc = c & 31, ob = rr * 64 + cc * 2; return st * 1024 + (ob ^ (((ob >> 9) & 1) << 5)); }
__host__ __device__ __forceinline__ void stage_rc(int b, int& R, int& C) { const int st = b / 1024, sb = b % 1024, swz = sb ^ (((sb >> 9) & 1) << 5); R = (st >> 1) * 16 + swz / 64; C = (st & 1) * 32 + (swz % 64) / 2; }
__host__ __device__ __forceinline__ int perm32(int rho) { const int n = rho >> 4, i = rho & 15; return 8 * (i >> 2) + 4 * n + (i & 3); }

struct Unit { int pm, pn, sel; };
struct Gemm { const bf16_t* A; const bf16_t* Bt; size_t strideA, strideB; int M, N, K, ld, packA, packB;
    __device__ __forceinline__ const char* a(int s) const { return (const char*)A + (size_t)s * strideA; }
    __device__ __forceinline__ const char* b(int s) const { return (const char*)Bt + (size_t)s * strideB; } };

struct StaticOrder {
    int nM, nN, nwg, G, c, skipctx;
    __device__ __forceinline__ void init(int M, int N, int G_, int c_, int skip_ = 0) { nM = M / BM; if (skip_) nM = 128; nN = N / BM; nwg = nM * nN; G = G_; c = c_; skipctx = skip_; }
    __device__ __forceinline__ bool tile(long L, Unit& u) const {
        if (L >= nwg) return false;
        int wgid = (int)L; { const int q = nwg / NXCD, r = nwg % NXCD, xcd = wgid % NXCD, off = wgid / NXCD; wgid = (xcd < r ? xcd * (q + 1) : r * (q + 1) + (xcd - r) * q) + off; }
        const int nig = WGM * nN, gid = wgid / nig, fm = gid * WGM, gsz = (nM - fm) < WGM ? (nM - fm) : WGM;
        u.pm = fm + ((wgid % nig) % gsz); if (skipctx) u.pm += (u.pm >> 5) + 1; u.pn = (wgid % nig) / gsz; u.sel = 0; return true;
    }
    __device__ __forceinline__ bool next(int i, Unit& u) const { return tile((long)i * G + c, u); }
    __device__ __forceinline__ void a_ready(const Unit&) const {}
};
struct MergeOrder {
    StaticOrder S;
    __device__ __forceinline__ bool next(int i, Unit& u) const { const int t = i / 3; if (!S.tile((long)t * S.G + S.c, u)) return false; u.sel = i - 3 * t; return true; }
    __device__ __forceinline__ void a_ready(const Unit&) const {}
};


struct CtxSplitOrder {
    int parts, G, c;
    __device__ __forceinline__ bool next(int i, Unit& u) const { const int L = i * G + c; if (L >= 16 * parts) return false; const int t = L & 15; u.pm = 33 * (t >> 2); u.pn = t & 3; u.sel = L >> 4; return true; }
    __device__ __forceinline__ void a_ready(const Unit&) const {}
};
typedef float f32x2 __attribute__((ext_vector_type(2)));
typedef unsigned u32x2 __attribute__((ext_vector_type(2)));

template <int ACT  > struct EpiBf16 {
    static constexpr bool PERM = true;
    bf16_t* O; int ldc, pack;
    __device__ __forceinline__ bool keep(const Unit&) const { return false; }
    __device__ __forceinline__ void operator()(f32x4 (&acc)[2][2][4][2], const Unit& u, int wr, int wc, int fr, int fq) const {
        const int row0 = u.pm * BM + wr * 64 + fr, col0 = u.pn * BM + wc * 32 + 8 * fq;
#pragma unroll
        for (int ai = 0; ai < 2; ++ai)
#pragma unroll
            for (int m = 0; m < 4; ++m) { const int rr = wr * 64 + fr + ai * HALF + m * 16;
                bf16_t* rowp = pack ? O + (((size_t)u.pm * (ldc >> 6) + (col0 >> 6)) * 256 + rr) * 64 + (col0 & 63) : O + (size_t)(row0 + ai * HALF + m * 16) * ldc + col0;
#pragma unroll
                for (int bj = 0; bj < 2; ++bj) { f32x4 v0 = acc[ai][bj][m][0], v1 = acc[ai][bj][m][1];
#pragma unroll
                    for (int e = 0; e < 4; ++e) {
                        if (ACT == 1) { float a = fmaxf(v0[e], 0.f), b = fmaxf(v1[e], 0.f); v0[e] = a * a; v1[e] = b * b; }
                        if (ACT == 2) { float a = fminf(fmaxf(v0[e], -30.f), 30.f), b = fminf(fmaxf(v1[e], -30.f), 30.f); v0[e] = __builtin_amdgcn_rcpf(1.f + __expf(-a)); v1[e] = __builtin_amdgcn_rcpf(1.f + __expf(-b)); } }
                    u32x4 w; w.x = pk2(v0[0], v0[1]); w.y = pk2(v0[2], v0[3]); w.z = pk2(v1[0], v1[1]); w.w = pk2(v1[2], v1[3]);
                    *(u32x4*)(rowp + (pack ? bj * (2 * 256 * 64) : bj * HALF)) = w; } }
    }
};

struct EpiResid {
    static constexpr bool PERM = true;
    const float* base_lat; const float* base_ctx; float* out_lat; float* out_ctx; const float* gate;
    __device__ __forceinline__ bool keep(const Unit&) const { return false; }
    __device__ __forceinline__ void operator()(f32x4 (&acc)[2][2][4][2], const Unit& u, int wr, int wc, int fr, int fq) const {
        const int b = u.pm / 33, j = u.pm % 33; const bool isctx = (j == 0);
        const float* gv = gate + (size_t)(isctx ? 4 : b) * MODW;
        const int col0 = u.pn * BM + wc * 32 + 8 * fq;
        f32x4 g[2][2];
#pragma unroll
        for (int bj = 0; bj < 2; ++bj) { g[bj][0] = *(const f32x4*)(gv + col0 + bj * HALF); g[bj][1] = *(const f32x4*)(gv + col0 + bj * HALF + 4); }
        const size_t rbase = isctx ? (size_t)(b * NCTX) : (size_t)(b * NLAT + (j - 1) * 256);
        const float* bp = isctx ? base_ctx : base_lat; float* op = isctx ? out_ctx : out_lat;
#pragma unroll
        for (int ai = 0; ai < 2; ++ai)
#pragma unroll
            for (int m = 0; m < 4; ++m) { const size_t off = (rbase + ai * HALF + wr * 64 + m * 16 + fr) * DM + col0;
#pragma unroll
                for (int bj = 0; bj < 2; ++bj)
#pragma unroll
                    for (int n = 0; n < 2; ++n) { const f32x4 bs = *(const f32x4*)(bp + off + bj * HALF + 4 * n);
                        *(f32x4*)(op + off + bj * HALF + 4 * n) = bs + g[bj][n] * acc[ai][bj][m][n]; } }
    }
};


struct EpiPartial {
    static constexpr bool PERM = true;
    float* part;
    __device__ __forceinline__ bool keep(const Unit&) const { return false; }
    __device__ __forceinline__ void operator()(f32x4 (&acc)[2][2][4][2], const Unit& u, int wr, int wc, int fr, int fq) const {
        { unsigned m_ = ~0u; asm volatile("" : "+s"(m_)); const int ln = (int)__builtin_amdgcn_mbcnt_hi(m_, __builtin_amdgcn_mbcnt_lo(m_, 0u)); fr = ln & 15; fq = ln >> 4; }
        const int b = u.pm / 33; const int col0 = u.pn * BM + wc * 32 + 8 * fq;
        float* pb = part + (size_t)u.sel * (NB * NCTX) * DM;
#pragma unroll
        for (int ai = 0; ai < 2; ++ai)
#pragma unroll
            for (int m = 0; m < 4; ++m) { float* p = pb + ((size_t)(b * NCTX) + ai * HALF + wr * 64 + m * 16 + fr) * DM + col0;
#pragma unroll
                for (int bj = 0; bj < 2; ++bj)
#pragma unroll
                    for (int n = 0; n < 2; ++n) *(f32x4*)(p + bj * HALF + 4 * n) = acc[ai][bj][m][n]; }
    }
};

struct EpiMerge {
    static constexpr bool PERM = true;
    const bf16_t* G; const float* SSQ; bf16_t* O;
    __device__ __forceinline__ bool keep(const Unit& u) const { return u.sel < 2; }
    __device__ __forceinline__ void operator()(f32x4 (&acc)[2][2][4][2], const Unit& u, int wr, int wc, int fr, int fq) const {
        const int row0 = u.pm * BM + wr * 64 + fr, col0 = u.pn * BM + wc * 32 + 8 * fq; const int sel = u.sel;
#pragma unroll
        for (int ai = 0; ai < 2; ++ai)
#pragma unroll
            for (int m = 0; m < 4; ++m) { const size_t row = (size_t)(row0 + ai * HALF + m * 16);
                const f32x4 q0 = *(const f32x4*)(SSQ + row * 8), q1 = *(const f32x4*)(SSQ + row * 8 + 4);
                const float s1 = rsqrtf(((q0[0] + q0[1]) + (q0[2] + q0[3]) + (q1[0] + q1[1]) + (q1[2] + q1[3])) * (1.f / 512.f) + EPS);
#pragma unroll
                for (int bj = 0; bj < 2; ++bj) { const bf16_t* gp = G + row * NGATE + col0 + bj * HALF;
                    float f[8];
                    if (sel == 0) { const u32x4 a = *(const u32x4*)(gp), b = *(const u32x4*)(gp + 1024);
#pragma unroll
                        for (int t = 0; t < 4; ++t) { f[2 * t] = bf2f(a[t] & 0xffffu) * __builtin_amdgcn_rcpf(s1 * bf2f(b[t] & 0xffffu)); f[2 * t + 1] = bf2f(a[t] >> 16) * __builtin_amdgcn_rcpf(s1 * bf2f(b[t] >> 16)); } }
                    else if (sel == 1) { const u32x4 a = *(const u32x4*)(gp + 1024), b = *(const u32x4*)(gp + 2048);
#pragma unroll
                        for (int t = 0; t < 4; ++t) { f[2 * t] = s1 * bf2f(a[t] & 0xffffu) * __builtin_amdgcn_rcpf(bf2f(b[t] & 0xffffu)); f[2 * t + 1] = s1 * bf2f(a[t] >> 16) * __builtin_amdgcn_rcpf(bf2f(b[t] >> 16)); } }
                    else { const u32x4 a = *(const u32x4*)(gp + 2048);
#pragma unroll
                        for (int t = 0; t < 4; ++t) { f[2 * t] = bf2f(a[t] & 0xffffu); f[2 * t + 1] = bf2f(a[t] >> 16); } }
                    f32x4 v0 = acc[ai][bj][m][0], v1 = acc[ai][bj][m][1];
#pragma unroll
                    for (int e = 0; e < 4; ++e) { v0[e] *= f[e]; v1[e] *= f[4 + e]; }
                    if (sel == 2) { u32x4 w; w.x = pk2(v0[0], v0[1]); w.y = pk2(v0[2], v0[3]); w.z = pk2(v1[0], v1[1]); w.w = pk2(v1[2], v1[3]);
                        *(u32x4*)(O + row * DM + col0 + bj * HALF) = w; }
                    else { acc[ai][bj][m][0] = v0; acc[ai][bj][m][1] = v1; } } }
    }
};
struct EpiInProj {
    static constexpr bool PERM = true;
    unsigned char* ws; float* DT;
    const float *qnw, *knw, *dtb; const f32x2 *atab, *rtab;
    __device__ __forceinline__ bool keep(const Unit&) const { return false; }
    __device__ __forceinline__ void store8(bf16_t* p, const float* v) const { u32x4 w; w.x = pk2(v[0], v[1]); w.y = pk2(v[2], v[3]); w.z = pk2(v[4], v[5]); w.w = pk2(v[6], v[7]); *(u32x4*)p = w; }
    __device__ __forceinline__ void operator()(f32x4 (&acc)[2][2][4][2], const Unit& u, int wr, int wc, int fr, int fq) const {
        const int pn = u.pn, j = u.pm % 33; const bool isctx = (j == 0);
        const int rowt = u.pm * BM + wr * 64 + fr, post = j * 256 + wr * 64 + fr;
        if (pn <= 2) {
            const bool isv = (pn == 2 && wc >= 2), isk = (pn == 2 && wc < 2);
            const float* nw = isk ? knw : qnw;
#pragma unroll
            for (int ai = 0; ai < 2; ++ai)
#pragma unroll
                for (int m = 0; m < 4; ++m) {
                    const size_t row = (size_t)(rowt + ai * HALF + m * 16); const int pos = post + ai * HALF + m * 16;
                    float v[2][8];
#pragma unroll
                    for (int bj = 0; bj < 2; ++bj)
#pragma unroll
                        for (int t = 0; t < 8; ++t) v[bj][t] = acc[ai][bj][m][t >> 2][t & 3];
                    if (!isv) {
                        float ss = 0.f;
#pragma unroll
                        for (int bj = 0; bj < 2; ++bj)
#pragma unroll
                            for (int t = 0; t < 8; ++t) ss += v[bj][t] * v[bj][t];
                        ss += shx(ss, 16, fq * 16 + fr); ss += shx(ss, 32, fq * 16 + fr);
                        const float rstd = rsqrtf(ss * (1.f / 64.f) + EPS);
#pragma unroll
                        for (int bj = 0; bj < 2; ++bj) { const f32x4 wa = *(const f32x4*)(nw + 32 * bj + 8 * fq), wb = *(const f32x4*)(nw + 32 * bj + 8 * fq + 4);
#pragma unroll
                            for (int t = 0; t < 4; ++t) { v[bj][t] = v[bj][t] * rstd * wa[t]; v[bj][4 + t] = v[bj][4 + t] * rstd * wb[t]; } }
                        if (!isctx) {
                            const f32x4* tp = (const f32x4*)(atab + (size_t)(pos - NCTX) * 32 + 8 * fq);
#pragma unroll
                            for (int t2 = 0; t2 < 4; ++t2) { const f32x4 cs = tp[t2];
                                { const float x1 = v[0][2 * t2], x2 = v[1][2 * t2]; v[0][2 * t2] = x1 * cs[0] - x2 * cs[1]; v[1][2 * t2] = x1 * cs[1] + x2 * cs[0]; }
                                { const float x1 = v[0][2 * t2 + 1], x2 = v[1][2 * t2 + 1]; v[0][2 * t2 + 1] = x1 * cs[2] - x2 * cs[3]; v[1][2 * t2 + 1] = x1 * cs[3] + x2 * cs[2]; } }
                        }
                        if (pn < 2) {
#pragma unroll
                            for (int bj = 0; bj < 2; ++bj)
#pragma unroll
                                for (int t = 0; t < 8; ++t) v[bj][t] *= QC2;
                        }
                    }
                    const size_t doff = (pn < 2) ? OFF_Q + (row * 512 + 64 * (4 * pn + wc) + 8 * fq) * 2
                                                 : OFF_KV + (row * 256 + (isk ? 64 * wc : 128 + 64 * (wc - 2)) + 8 * fq) * 2;
                    bf16_t* dst = (bf16_t*)(ws + doff);
                    store8(dst, v[0]); store8(dst + 32, v[1]);
                    asm volatile("" ::: "memory");
                }
        } else if (pn >= 9 && pn <= 12) {
            const bool isk = pn >= 11; const int head = 2 * ((pn - 9) & 1) + (wc >> 1);
            bf16_t* dbase = (bf16_t*)(ws + (isk ? OFF_RK : OFF_RQ)) + 128 * head + 32 * (wc & 1) + 8 * fq;
            const float sc = isk ? 0.08838834764831845f : 1.f;
#pragma unroll
            for (int ai = 0; ai < 2; ++ai)
#pragma unroll
                for (int m = 0; m < 4; ++m) {
                    const size_t row = (size_t)(rowt + ai * HALF + m * 16); const int pos = post + ai * HALF + m * 16;
                    const f32x4* tp = (const f32x4*)(rtab + (size_t)pos * 64 + 32 * (wc & 1) + 8 * fq);
                    float o1[8], o2[8];
#pragma unroll
                    for (int t2 = 0; t2 < 4; ++t2) { const f32x4 cs = tp[t2];
                        { const int t = 2 * t2; const float x1 = acc[ai][0][m][t >> 2][t & 3], x2 = acc[ai][1][m][t >> 2][t & 3]; o1[t] = (x1 * cs[0] - x2 * cs[1]) * sc; o2[t] = (x1 * cs[1] + x2 * cs[0]) * sc; }
                        { const int t = 2 * t2 + 1; const float x1 = acc[ai][0][m][t >> 2][t & 3], x2 = acc[ai][1][m][t >> 2][t & 3]; o1[t] = (x1 * cs[2] - x2 * cs[3]) * sc; o2[t] = (x1 * cs[3] + x2 * cs[2]) * sc; } }
                    store8(dbase + row * 512, o1); store8(dbase + row * 512 + 64, o2);
                    asm volatile("" ::: "memory");
                }
        } else if (pn == 17) {
            if (wc == 0 && fq < 2) {
                float bb[8];
#pragma unroll
                for (int t = 0; t < 8; ++t) bb[t] = dtb[8 * fq + t];
#pragma unroll
                for (int ai = 0; ai < 2; ++ai)
#pragma unroll
                    for (int m = 0; m < 4; ++m) { const size_t row = (size_t)(rowt + ai * HALF + m * 16); f32x4 o[2];
#pragma unroll
                        for (int t = 0; t < 8; ++t) { const float x = acc[ai][0][m][t >> 2][t & 3] + bb[t]; o[t >> 2][t & 3] = x > 20.f ? x : log1pf(__expf(x)); }
                        *(f32x4*)(DT + row * 16 + 8 * fq) = o[0]; *(f32x4*)(DT + row * 16 + 8 * fq + 4) = o[1]; }
            }
        } else {
            size_t doff; int ld, cb;
            if (pn <= 4) { doff = OFF_Z; ld = 512; cb = (pn - 3) * 256; } else if (pn <= 8) { doff = OFF_XBC; ld = 1024; cb = (pn - 5) * 256; }
            else if (pn <= 14) { doff = OFF_RV; ld = 512; cb = (pn - 13) * 256; } else { doff = OFF_RG; ld = 512; cb = (pn - 15) * 256; }
            bf16_t* dst = (bf16_t*)(ws + doff);
            cb += wc * 32 + 8 * fq;
#pragma unroll
            for (int ai = 0; ai < 2; ++ai)
#pragma unroll
                for (int m = 0; m < 4; ++m) { bf16_t* rowp = dst + (size_t)(rowt + ai * HALF + m * 16) * ld + cb;
#pragma unroll
                    for (int bj = 0; bj < 2; ++bj) { const f32x4 v0 = acc[ai][bj][m][0], v1 = acc[ai][bj][m][1];
                        u32x4 w; w.x = pk2(v0[0], v0[1]); w.y = pk2(v0[2], v0[3]); w.z = pk2(v1[0], v1[1]); w.w = pk2(v1[2], v1[3]);
                        *(u32x4*)(rowp + bj * HALF) = w; } }
        }
    }
};
template <class Epi, class Sched, bool ALIGN_EPI = false, bool SP2 = false>
__device__ __forceinline__ void gemm_phase(PG8_LAS unsigned char* lds, const Gemm g, const Sched& S, const Epi& E, const int tid_in) {
    const int tid = tid_in, wid = __builtin_amdgcn_readfirstlane(tid >> 6), lane = tid & 63, wr = wid >> 2, wc = wid & 3, fr = lane & 15, fq = lane >> 4;
    const int K = g.K, nt = K / BK;
    unsigned voffA[2], voffB[2];
#pragma unroll
    for (int i = 0; i < 2; ++i) { int R, C; stage_rc(tid * 16 + i * 8192, R, C); const int Rb = Epi::PERM ? ((R & ~31) + perm32(R & 31)) : R;
        voffA[i] = (unsigned)(R * (g.packA ? BK : g.ld) + C) * 2u; voffB[i] = (unsigned)(Rb * (g.packB ? BK : g.ld) + C) * 2u; }
    const size_t kstep = g.packA ? (size_t)(BM * BK * 2) : (size_t)(BK * 2), kstepB = g.packB ? (size_t)(BM * BK * 2) : (size_t)(BK * 2);
    const size_t hstep = g.packA ? (size_t)(HALF * BK * 2) : (size_t)HALF * g.ld * 2, hstepB = g.packB ? (size_t)(HALF * BK * 2) : (size_t)HALF * g.ld * 2;
    const size_t tstep = (size_t)BM * g.ld * 2, tstepB = tstep;
    const unsigned ldsw = (unsigned)wid * 1024u;
    const int aoff = lds_byte(wr * 64 + fr, fq * 8), boff = lds_byte(wc * 32 + fr, fq * 8);
#define PG8_SA(b, h) (((b) * 2 + (h)) * HTB)
#define PG8_SB(b, h) ((4 + (b) * 2 + (h)) * HTB)
#define PG8_STAGE(bufoff, gbase, voff) do { _Pragma("unroll") for (int _i = 0; _i < 2; ++_i) \
        __builtin_amdgcn_global_load_lds((const unsigned*)((const char*)(gbase) + (voff)[_i]), (PG8_LAS unsigned*)(lds + (bufoff) + ldsw + _i * 8192), 16, 0, 0); } while (0)
#define PG8_LDA(dst, b, h) do { _Pragma("unroll") for (int m = 0; m < 4; ++m) _Pragma("unroll") for (int k = 0; k < 2; ++k) dst[m][k] = *(const PG8_LAS bf16x8*)(lds + PG8_SA(b, h) + aoff + m * 2048 + k * 1024); } while (0)
#define PG8_LDB(dst, b, h) do { _Pragma("unroll") for (int n = 0; n < 2; ++n) _Pragma("unroll") for (int k = 0; k < 2; ++k) dst[n][k] = *(const PG8_LAS bf16x8*)(lds + PG8_SB(b, h) + boff + n * 2048 + k * 1024); } while (0)
#define PG8_MMA(ai, bj, At, Bt) do { __builtin_amdgcn_s_setprio(1); _Pragma("unroll") for (int m = 0; m < 4; ++m) _Pragma("unroll") for (int n = 0; n < 2; ++n) _Pragma("unroll") for (int k = 0; k < 2; ++k) \
        acc[ai][bj][m][n] = __builtin_amdgcn_mfma_f32_16x16x32_bf16(Bt[n][k], At[m][k], acc[ai][bj][m][n], 0, 0, 0); __builtin_amdgcn_s_setprio(0); } while (0)
#define PG8_WAIT_V(n) asm volatile("s_waitcnt vmcnt(" #n ")" ::: "memory")
#define PG8_WAIT_L(n) asm volatile("s_waitcnt lgkmcnt(" #n ")" ::: "memory")
#define PG8_BAR __builtin_amdgcn_s_barrier()
#define PG8_SCHED __builtin_amdgcn_sched_barrier(0)
    Unit cur, nxt; int ui = 0;
    if (!S.next(0, cur)) return;
    f32x4 acc[2][2][4][2];
#pragma unroll
    for (int a = 0; a < 2; ++a)
#pragma unroll
        for (int b = 0; b < 2; ++b)
#pragma unroll
            for (int m = 0; m < 4; ++m)
#pragma unroll
                for (int n = 0; n < 2; ++n) acc[a][b][m][n] = (f32x4){0.f, 0.f, 0.f, 0.f};
    bf16x8 At[4][2], B0[2][2], B1[2][2];
    const char* cA = g.a(cur.sel) + (size_t)cur.pm * tstep; const char* cB = g.b(cur.sel) + (size_t)cur.pn * tstepB;
    S.a_ready(cur);
    if constexpr (SP2) {
        PG8_STAGE(PG8_SB(0, 0), cB, voffB); PG8_STAGE(PG8_SB(0, 1), cB + hstepB, voffB); PG8_STAGE(PG8_SA(0, 0), cA, voffA); PG8_STAGE(PG8_SA(0, 1), cA + hstep, voffA);
        if (wr == 1) PG8_BAR;
        PG8_WAIT_V(2); PG8_BAR;
        PG8_STAGE(PG8_SB(1, 0), cB + kstepB, voffB); PG8_STAGE(PG8_SA(1, 0), cA + kstep, voffA); PG8_STAGE(PG8_SB(1, 1), cB + hstepB + kstepB, voffB);
        PG8_WAIT_V(6); PG8_BAR;
    } else {
        PG8_STAGE(PG8_SB(0, 0), cB, voffB); PG8_STAGE(PG8_SA(0, 0), cA, voffA); PG8_STAGE(PG8_SB(0, 1), cB + hstepB, voffB); PG8_STAGE(PG8_SA(0, 1), cA + hstep, voffA);
        if (wr == 1) PG8_BAR;
        PG8_WAIT_V(4); PG8_BAR;
        PG8_STAGE(PG8_SB(1, 0), cB + kstepB, voffB); PG8_STAGE(PG8_SA(1, 0), cA + kstep, voffA); PG8_STAGE(PG8_SB(1, 1), cB + hstepB + kstepB, voffB);
        PG8_WAIT_V(6); PG8_BAR;
    }
    for (;;) {
        const bool has_next = S.next(ui + 1, nxt);
        const char* nA = has_next ? g.a(nxt.sel) + (size_t)nxt.pm * tstep : cA; const char* nB = has_next ? g.b(nxt.sel) + (size_t)nxt.pn * tstepB : cB;
        for (int t = 0; t < nt; t += 2) {
            const bool last = (t == nt - 2);
            const char* a1 = cA + (size_t)(t + 1) * kstep;
            const char* a2 = last ? nA : cA + (size_t)(t + 2) * kstep; const char* b2 = last ? nB : cB + (size_t)(t + 2) * kstepB;
            const char* a3 = a2 + kstep; const char* b3 = b2 + kstepB;
            if (last && has_next) S.a_ready(nxt);
            if constexpr (SP2) {
            PG8_LDB(B0, 0, 0); PG8_LDB(B1, 0, 1); PG8_SCHED; PG8_LDA(At, 0, 0); PG8_STAGE(PG8_SA(1, 1), a1 + hstep, voffA);
            PG8_WAIT_V(8); PG8_WAIT_L(0); PG8_BAR; PG8_MMA(0, 0, At, B0); PG8_MMA(0, 1, At, B1); PG8_BAR; PG8_SCHED;
            PG8_LDA(At, 0, 1); PG8_STAGE(PG8_SB(0, 0), b2, voffB); PG8_STAGE(PG8_SB(0, 1), b2 + hstepB, voffB); PG8_STAGE(PG8_SA(0, 0), a2, voffA);
            PG8_WAIT_V(8); PG8_WAIT_L(0); PG8_BAR; PG8_MMA(1, 0, At, B0); PG8_MMA(1, 1, At, B1); PG8_BAR; PG8_SCHED;
            PG8_LDB(B0, 1, 0); PG8_LDB(B1, 1, 1); PG8_SCHED; PG8_LDA(At, 1, 0); PG8_STAGE(PG8_SA(0, 1), a2 + hstep, voffA);
            PG8_WAIT_V(8); PG8_WAIT_L(0); PG8_BAR; PG8_MMA(0, 0, At, B0); PG8_MMA(0, 1, At, B1); PG8_BAR; PG8_SCHED;
            PG8_LDA(At, 1, 1); PG8_STAGE(PG8_SB(1, 0), b3, voffB); PG8_STAGE(PG8_SB(1, 1), b3 + hstepB, voffB); PG8_STAGE(PG8_SA(1, 0), a3, voffA);
            PG8_WAIT_V(8); PG8_WAIT_L(0); PG8_BAR; PG8_MMA(1, 0, At, B0); PG8_MMA(1, 1, At, B1); PG8_BAR; PG8_SCHED;
            } else {
            PG8_LDB(B0, 0, 0); PG8_SCHED; PG8_LDA(At, 0, 0); PG8_STAGE(PG8_SA(1, 1), a1 + hstep, voffA);
            PG8_WAIT_L(8); PG8_BAR; PG8_WAIT_L(0); PG8_MMA(0, 0, At, B0); PG8_BAR; PG8_SCHED;
            PG8_LDB(B1, 0, 1); PG8_STAGE(PG8_SB(0, 0), b2, voffB);
            PG8_BAR; PG8_WAIT_L(0); PG8_MMA(0, 1, At, B1); PG8_BAR;
            PG8_LDA(At, 0, 1); PG8_STAGE(PG8_SA(0, 0), a2, voffA);
            PG8_BAR; PG8_WAIT_L(0); PG8_MMA(1, 0, At, B0); PG8_BAR; PG8_SCHED;
            PG8_STAGE(PG8_SB(0, 1), b2 + hstepB, voffB);
            PG8_WAIT_V(6); PG8_BAR; PG8_MMA(1, 1, At, B1); PG8_BAR;
            PG8_LDB(B0, 1, 0); PG8_SCHED; PG8_LDA(At, 1, 0); PG8_STAGE(PG8_SA(0, 1), a2 + hstep, voffA);
            PG8_WAIT_L(8); PG8_BAR; PG8_WAIT_L(0); PG8_MMA(0, 0, At, B0); PG8_BAR; PG8_SCHED;
            PG8_LDB(B1, 1, 1); PG8_STAGE(PG8_SB(1, 0), b3, voffB);
            PG8_BAR; PG8_WAIT_L(0); PG8_MMA(0, 1, At, B1); PG8_BAR;
            PG8_LDA(At, 1, 1); PG8_STAGE(PG8_SA(1, 0), a3, voffA);
            PG8_BAR; PG8_WAIT_L(0); PG8_MMA(1, 0, At, B0); PG8_BAR; PG8_SCHED;
            PG8_STAGE(PG8_SB(1, 1), b3 + hstepB, voffB);
            PG8_WAIT_V(6); PG8_BAR; PG8_MMA(1, 1, At, B1); PG8_BAR;
            }
        }
        if constexpr (ALIGN_EPI) { if (wr == 0) PG8_BAR; }
        E(acc, cur, wr, wc, fr, fq);
        if (!has_next) break;
        if (!E.keep(cur)) {
#pragma unroll
        for (int a = 0; a < 2; ++a)
#pragma unroll
            for (int b = 0; b < 2; ++b)
#pragma unroll
                for (int m = 0; m < 4; ++m)
#pragma unroll
                    for (int n = 0; n < 2; ++n) acc[a][b][m][n] = (f32x4){0.f, 0.f, 0.f, 0.f}; }
        cur = nxt; cA = nA; cB = nB; ++ui;
        if constexpr (ALIGN_EPI) { if (wr == 1) PG8_BAR; }
    }
    PG8_WAIT_V(0);
    if constexpr (!ALIGN_EPI) { if (wr == 0) PG8_BAR; }
    PG8_BAR;

#undef PG8_SA
#undef PG8_SB
#undef PG8_STAGE
#undef PG8_LDA
#undef PG8_LDB
#undef PG8_MMA
#undef PG8_WAIT_V
#undef PG8_WAIT_L
#undef PG8_BAR
#undef PG8_SCHED
}
}
#include <hip/hip_bf16.h>
namespace attn_body {
using bf16=__hip_bfloat16;
using bf16x8=__attribute__((ext_vector_type(8)))short;
using s16x4=__attribute__((ext_vector_type(4)))short;
using f32x16=__attribute__((ext_vector_type(16)))float;
using u32x4=__attribute__((ext_vector_type(4)))unsigned;
constexpr int BATCH=2,NHEAD=16,SEQ=8192,D=64,DM=NHEAD*D;
constexpr int NW=8,QBLK=32,QB=QBLK*NW,KVBLK=64,NQB=SEQ/QB;
constexpr int ATTN_PITCH=DM, ATTN_UNIT_ROWS=QB;
__device__ __forceinline__ int crow(int r,int hi){return (r&3)+8*(r>>2)+4*hi;}
#define SBAR() __builtin_amdgcn_sched_barrier(0)
constexpr int NSLOT=3, SLOTB=8192;
constexpr int LDS_K=0, LDS_V=NSLOT*SLOTB, LDS_WS=2*NSLOT*SLOTB, LDS_OST=LDS_WS+NW*64*4, LDS_BYTES=LDS_OST+NW*4096;
constexpr float C2=0.125f*1.4426950408889634f;
__device__ __forceinline__ void glds16(const void*gsrc,unsigned lds_dst){unsigned keep;
  asm volatile("s_mov_b32 %0, m0\n\ts_mov_b32 m0, %2\n\ts_nop 0\n\tglobal_load_lds_dwordx4 %1, off\n\ts_mov_b32 m0, %0":"=&s"(keep):"v"(gsrc),"s"(lds_dst):"memory");}
__device__ __forceinline__ float max3f(float a,float b,float c){float r;asm("v_max3_f32 %0, %1, %2, %3":"=v"(r):"v"(a),"v"(b),"v"(c));return r;}
__device__ __forceinline__ float max2f(float a,float b){float r;asm("v_max_f32_e32 %0, %1, %2":"=v"(r):"v"(a),"v"(b));return r;}
__device__ __forceinline__ float fadd_s(float a,float b){float r;asm("v_add_f32_e32 %0, %1, %2":"=v"(r):"v"(a),"v"(b));return r;}
__device__ __forceinline__ float fsub_s(float a,float b){float r;asm("v_sub_f32_e32 %0, %1, %2":"=v"(r):"v"(a),"v"(b));return r;}
typedef float f32x2_t __attribute__((ext_vector_type(2))); typedef __bf16 bf16x2_t __attribute__((ext_vector_type(2)));
__device__ __forceinline__ unsigned cvtpk_s(float lo,float hi){f32x2_t v={lo,hi};bf16x2_t b=__builtin_convertvector(v,bf16x2_t);return __builtin_bit_cast(unsigned,b);}
#define WAIT_BAR(N) asm volatile("s_waitcnt vmcnt(" #N ") lgkmcnt(0)\n\ts_barrier":::"memory")

__device__ __forceinline__ void qkt(f32x16&p0,f32x16&p1,const char*Kslot,const bf16x8*qr,const f32x16&negm,int r32,int hi){
  const char*kb=Kslot+hi*1024+r32*16;
  #pragma unroll
  for(int d0=0;d0<4;++d0){
    const bf16x8 b0=*reinterpret_cast<const bf16x8*>(kb+d0*2048);
    const bf16x8 b1=*reinterpret_cast<const bf16x8*>(kb+d0*2048+512);
    if(d0==0){p0=__builtin_amdgcn_mfma_f32_32x32x16_bf16(b0,qr[0],negm,0,0,0);p1=__builtin_amdgcn_mfma_f32_32x32x16_bf16(b1,qr[0],negm,0,0,0);}
    else{p0=__builtin_amdgcn_mfma_f32_32x32x16_bf16(b0,qr[d0],p0,0,0,0);p1=__builtin_amdgcn_mfma_f32_32x32x16_bf16(b1,qr[d0],p1,0,0,0);}}
}
typedef __attribute__((address_space(3))) const char* lds_cptr;
typedef short v4i16_t __attribute__((ext_vector_type(4)));
__device__ __forceinline__ void kload8(bf16x8*kf,lds_cptr kp){
  kf[0]=*(const __attribute__((address_space(3))) bf16x8*)(kp);      kf[1]=*(const __attribute__((address_space(3))) bf16x8*)(kp+512);
  kf[2]=*(const __attribute__((address_space(3))) bf16x8*)(kp+2048); kf[3]=*(const __attribute__((address_space(3))) bf16x8*)(kp+2560);
  kf[4]=*(const __attribute__((address_space(3))) bf16x8*)(kp+4096); kf[5]=*(const __attribute__((address_space(3))) bf16x8*)(kp+4608);
  kf[6]=*(const __attribute__((address_space(3))) bf16x8*)(kp+6144); kf[7]=*(const __attribute__((address_space(3))) bf16x8*)(kp+6656);
}
__device__ __forceinline__ void kload2(bf16x8*kf,lds_cptr kp,int j){ kf[2*j]=*(const __attribute__((address_space(3))) bf16x8*)(kp+j*2048); kf[2*j+1]=*(const __attribute__((address_space(3))) bf16x8*)(kp+j*2048+512); }
__device__ __forceinline__ s16x4 vtr(lds_cptr p){ return __builtin_bit_cast(s16x4,__builtin_amdgcn_ds_read_tr16_b64_v4i16((__attribute__((address_space(3))) v4i16_t*)p)); }
__device__ __forceinline__ float rowmax(const f32x16&p0,const f32x16&p1){
  float a=max3f(p0[0],p0[1],p1[0]),b=max3f(p0[2],p0[3],p1[1]);a=max3f(a,p1[2],p1[3]);
  #pragma unroll
  for(int r=4;r<16;r+=4){a=max3f(a,p0[r],p0[r+1]);b=max3f(b,p0[r+2],p0[r+3]);a=max3f(a,p1[r],p1[r+1]);b=max3f(b,p1[r+2],p1[r+3]);}
  const float m=max2f(a,b);
  auto rr=__builtin_amdgcn_permlane32_swap(__float_as_uint(m),__float_as_uint(m),false,false);
  return max2f(__uint_as_float(rr[0]),__uint_as_float(rr[1]));
}
__device__ __forceinline__ void pv(f32x16*o,int vb,bf16x8 pa0,bf16x8 pa1,bf16x8 pa2,bf16x8 pa3){
  #pragma unroll
  for(int d0=0;d0<2;++d0){s16x4 lo[4],hi[4];
    #pragma unroll
    for(int ks=0;ks<4;++ks){
      asm volatile("ds_read_b64_tr_b16 %0,%1 offset:%c2":"=&v"(lo[ks]):"v"(vb),"i"(d0*4096+ks*1024):"memory");
      asm volatile("ds_read_b64_tr_b16 %0,%1 offset:%c2":"=&v"(hi[ks]):"v"(vb),"i"(d0*4096+ks*1024+512):"memory");}
    asm volatile("s_waitcnt lgkmcnt(0)":::"memory");SBAR();
    #define PK(k) (bf16x8){lo[k][0],lo[k][1],lo[k][2],lo[k][3],hi[k][0],hi[k][1],hi[k][2],hi[k][3]}
    o[d0]=__builtin_amdgcn_mfma_f32_32x32x16_bf16(pa0,PK(0),o[d0],0,0,0);
    o[d0]=__builtin_amdgcn_mfma_f32_32x32x16_bf16(pa1,PK(1),o[d0],0,0,0);
    o[d0]=__builtin_amdgcn_mfma_f32_32x32x16_bf16(pa2,PK(2),o[d0],0,0,0);
    o[d0]=__builtin_amdgcn_mfma_f32_32x32x16_bf16(pa3,PK(3),o[d0],0,0,0);
    #undef PK
  }
}
#define ATTN_STORE16(p,v) (*(u32x4*)(p)=(v))
template<int THRL> __device__ __forceinline__ void attn_unit(long qrow0,long krow0,int NT,const bf16*Q,const bf16*__restrict__ K,const bf16*__restrict__ V,bf16*O,char*shm,const int tid_in){
  const int tid=tid_in,lane=tid&63,r32=lane&31,hi=lane>>5; const int wid=__builtin_amdgcn_readfirstlane(tid>>6);
  constexpr int PQ=512,PK=256;
  const bf16*Qw=Q+(qrow0+wid*QBLK)*PQ;
  const bf16*Kh=K+krow0*PK,*Vh=V+krow0*PK;
  const unsigned lds0=(unsigned)(uintptr_t)shm;
  float*wsf=(float*)(shm+LDS_WS)+wid*64;
  const bf16*ksrc=Kh+(long)lane*PK+wid*8;
  const bf16*vsrc=Vh+(long)(16*(wid&3)+(lane>>2))*PK+(wid>>2)*32+(lane&3)*8;
  const unsigned kdst=lds0+LDS_K+wid*1024, vdst=lds0+LDS_V+wid*1024;
  #define DMA_K(t,slot) glds16(ksrc+(long)(t)*KVBLK*PK,(unsigned)__builtin_amdgcn_readfirstlane(kdst+(slot)))
  #define DMA_V(t,slot) glds16(vsrc+(long)(t)*KVBLK*PK,(unsigned)__builtin_amdgcn_readfirstlane(vdst+(slot)))
  const int vb0=(int)(lds0+LDS_V)+((lane>>4)&1)*32+(lane&3)*8+(4*hi+((lane&15)>>2))*64;
  const char*Kbase=shm+LDS_K; bf16x8 kf[8];
  const lds_cptr shm3=(lds_cptr)shm; const lds_cptr kp0=shm3+LDS_K+hi*1024+r32*16; const lds_cptr vp0=shm3+LDS_V+((lane>>4)&1)*32+(lane&3)*8+(4*hi+((lane&15)>>2))*64;

  DMA_K(0,0);DMA_V(0,0);DMA_K(1,SLOTB);
  bf16x8 qr[4];
  #pragma unroll
  for(int d0=0;d0<4;++d0)qr[d0]=*reinterpret_cast<const bf16x8*>(&Qw[(long)r32*PQ+d0*16+hi*8]);
  float mhat=0.f,l_reg=0.f;f32x16 o[2];o[0]=f32x16{};o[1]=f32x16{};f32x16 negm=f32x16{};asm volatile("":"+v"(negm));

  #define CMASK(P0,P1,t) do{}while(0)
  bool resc=false;
  #define START(P0,P1) do{ const float rm=rowmax(P0,P1); resc=false; \
    { const float dl=rm; mhat=fadd_s(mhat,dl); \
      _Pragma("unroll") for(int r=0;r<16;++r){P0[r]=fsub_s(P0[r],dl);P1[r]=fsub_s(P1[r],dl);} \
      _Pragma("unroll") for(int r=0;r<16;++r)negm[r]=-mhat; asm volatile("":"+v"(negm)); } \
    _Pragma("unroll") for(int r=0;r<16;++r)P0[r]=__builtin_amdgcn_exp2f(P0[r]); }while(0)
  #define RESC() do{ if(resc){ asm volatile("s_waitcnt lgkmcnt(0)":::"memory"); \
      _Pragma("unroll") for(int d_=0;d_<2;++d_) _Pragma("unroll") for(int r=0;r<16;++r)o[d_][r]*=wsf[crow(r,hi)]; } }while(0)
  f32x16 pA0,pA1,pB0,pB1;
  int sl_prev=0,sl_cur=0,sl_next=SLOTB;
  #define ROT() do{sl_prev=sl_cur;sl_cur=sl_next;sl_next=(sl_next==(NSLOT-1)*SLOTB)?0:sl_next+SLOTB;}while(0)
  DMA_K(2,2*SLOTB);
  WAIT_BAR(3);
  qkt(pA0,pA1,Kbase,qr,negm,r32,hi);asm volatile("s_nop 15\n\ts_nop 7":"+v"(pA0),"+v"(pA1));CMASK(pA0,pA1,0);
  START(pA0,pA1);
  _Pragma("unroll") for(int r=0;r<16;++r)pA1[r]=__builtin_amdgcn_exp2f(pA1[r]);
  WAIT_BAR(0);
  DMA_K(3,0);DMA_V(1,SLOTB);
  ROT();
  kload8(kf,kp0+sl_cur);
  WAIT_BAR(2);
  s16x4 vlo[8],vhi[8]; u32x4 pw0,pw1,pw2,pw3;
  #define PKW(P,B) cvtpk_s(P[B],P[B+1])
  #define PAF(k) __builtin_bit_cast(bf16x8,pw##k)
  #define VFR(i) (bf16x8){vlo[i][0],vlo[i][1],vlo[i][2],vlo[i][3],vhi[i][0],vhi[i][1],vhi[i][2],vhi[i][3]}
  #define PIN(x) asm volatile("":"+v"(x))
  #define MX3(a,b,c) __builtin_fmaxf(__builtin_fmaxf((a),(b)),(c))
  #define GAPA(MF,A0,A1,A2,A3,W0,W1,PW) do{ MF; sacc+=A0; sacc+=A1; sacc+=A2; sacc+=A3; PIN(sacc); W0; W1; PIN(PW); SBAR(); }while(0)
  #define EX(v) __builtin_amdgcn_exp2f(v)
  #define GAPB(MF,X,B) do{ MF; X[B]=EX(X[B]); X[B+1]=EX(X[B+1]); X[B+2]=EX(X[B+2]); X[B+3]=EX(X[B+3]); PIN(X); SBAR(); }while(0)
  #define VRD(i) do{ vlo[i]=vtr(vp_+(((i)>>2)*4096+((i)&3)*1024)); vhi[i]=vtr(vp_+(((i)>>2)*4096+((i)&3)*1024+512)); }while(0)
  #define KRD(G,j) do{ if(G){ kload2(kf,kp0+sl_next,j); SBAR(); } }while(0)
  #define STEP(C0,C1,P0,P1,t,GK,GV,GL) do{ SBAR(); \
    const lds_cptr vp_=vp0+sl_prev; \
    VRD(0); SBAR(); float sacc=(P0[0]+P0[1]); \
    GAPA(C0=__builtin_amdgcn_mfma_f32_32x32x16_bf16(kf[0],qr[0],negm,0,0,0), P0[2],P0[3],P0[4],P0[5],     pw0[0]=PKW(P0,0), pw0[1]=PKW(P0,2), pw0); \
    VRD(4); SBAR(); GAPA(C1=__builtin_amdgcn_mfma_f32_32x32x16_bf16(kf[1],qr[0],negm,0,0,0), P0[6],P0[7],P0[8],P0[9],     pw0[2]=PKW(P0,4), pw0[3]=PKW(P0,6), pw0); \
    VRD(1); SBAR(); GAPA(C0=__builtin_amdgcn_mfma_f32_32x32x16_bf16(kf[2],qr[1],C0,0,0,0),   P0[10],P0[11],P0[12],P0[13], pw1[0]=PKW(P0,8), pw1[1]=PKW(P0,10), pw1); \
    VRD(5); SBAR(); GAPA(C1=__builtin_amdgcn_mfma_f32_32x32x16_bf16(kf[3],qr[1],C1,0,0,0),   P0[14],P0[15],P1[0],P1[1],   pw1[2]=PKW(P0,12),pw1[3]=PKW(P0,14), pw1); \
    VRD(2); SBAR(); GAPA(C0=__builtin_amdgcn_mfma_f32_32x32x16_bf16(kf[4],qr[2],C0,0,0,0),   P1[2],P1[3],P1[4],P1[5],     pw2[0]=PKW(P1,0), pw2[1]=PKW(P1,2), pw2); \
    VRD(6); SBAR(); GAPA(C1=__builtin_amdgcn_mfma_f32_32x32x16_bf16(kf[5],qr[2],C1,0,0,0),   P1[6],P1[7],P1[8],P1[9],     pw2[2]=PKW(P1,4), pw2[3]=PKW(P1,6), pw2); \
    VRD(3); SBAR(); GAPA(C0=__builtin_amdgcn_mfma_f32_32x32x16_bf16(kf[6],qr[3],C0,0,0,0),   P1[10],P1[11],P1[12],P1[13], pw3[0]=PKW(P1,8), pw3[1]=PKW(P1,10), pw3); \
    VRD(7); SBAR(); GAPA(C1=__builtin_amdgcn_mfma_f32_32x32x16_bf16(kf[7],qr[3],C1,0,0,0),   P1[14],P1[15],0.f,0.f,       pw3[2]=PKW(P1,12),pw3[3]=PKW(P1,14), pw3); \
    l_reg+=sacc; \
    if(GK){DMA_K((t)+3,sl_cur);} if(GV){DMA_V((t)+1,sl_next);} \
    CMASK(C0,C1,t); \
    { float a=MX3(C0[0],C0[1],C1[0]),b=MX3(C0[2],C0[3],C1[1]); a=MX3(a,C1[2],C1[3]); \
      _Pragma("unroll") for(int r=4;r<16;r+=4){a=MX3(a,C0[r],C0[r+1]);b=MX3(b,C0[r+2],C0[r+3]);a=MX3(a,C1[r],C1[r+1]);b=MX3(b,C1[r+2],C1[r+3]);} \
      float rm=__builtin_fmaxf(a,b); { auto rr=__builtin_amdgcn_permlane32_swap(__float_as_uint(rm),__float_as_uint(rm),false,false); rm=__builtin_fmaxf(__uint_as_float(rr[0]),__uint_as_float(rr[1])); } \
      resc=false; \
      if(__builtin_expect(__any(rm>(float)THRL),0)){ const float dl=__builtin_fmaxf(rm,0.f); mhat+=dl; \
        _Pragma("unroll") for(int r=0;r<16;++r){C0[r]-=dl;C1[r]-=dl;} \
        _Pragma("unroll") for(int r=0;r<16;++r)negm[r]=-mhat; asm volatile("":"+v"(negm)); \
        const float f=__builtin_amdgcn_exp2f(-dl); l_reg*=f; if(hi==0)wsf[r32]=f; resc=true; } } \
    SBAR(); \
    GAPB(o[0]=__builtin_amdgcn_mfma_f32_32x32x16_bf16(PAF(0),VFR(0),o[0],0,0,0), C0,0); \
    GAPB(o[1]=__builtin_amdgcn_mfma_f32_32x32x16_bf16(PAF(0),VFR(4),o[1],0,0,0), C0,4); \
    KRD(GL,0); GAPB(o[0]=__builtin_amdgcn_mfma_f32_32x32x16_bf16(PAF(1),VFR(1),o[0],0,0,0), C0,8); \
    KRD(GL,1); GAPB(o[1]=__builtin_amdgcn_mfma_f32_32x32x16_bf16(PAF(1),VFR(5),o[1],0,0,0), C0,12); \
    KRD(GL,2); GAPB(o[0]=__builtin_amdgcn_mfma_f32_32x32x16_bf16(PAF(2),VFR(2),o[0],0,0,0), C1,0); \
    KRD(GL,3); GAPB(o[1]=__builtin_amdgcn_mfma_f32_32x32x16_bf16(PAF(2),VFR(6),o[1],0,0,0), C1,4); \
    GAPB(o[0]=__builtin_amdgcn_mfma_f32_32x32x16_bf16(PAF(3),VFR(3),o[0],0,0,0), C1,8); \
    GAPB(o[1]=__builtin_amdgcn_mfma_f32_32x32x16_bf16(PAF(3),VFR(7),o[1],0,0,0), C1,12); \
    }while(0)
  int t=1;
  #undef CMASK
  #define CMASK(P0,P1,t) do{}while(0)
  for(;t+5<NT;t+=2){
    STEP(pB0,pB1,pA0,pA1,t,true,true,true);     WAIT_BAR(2); RESC(); ROT();
    STEP(pA0,pA1,pB0,pB1,t+1,true,true,true);   WAIT_BAR(2); RESC(); ROT();
  }
  #undef CMASK
  #define CMASK(P0,P1,t) do{}while(0)
  #define ENDW(tt) do{ if((tt)+3<NT){WAIT_BAR(2);} else if((tt)+2<NT){WAIT_BAR(1);} else {WAIT_BAR(0);} }while(0)
  for(;t+1<NT;t+=2){
    STEP(pB0,pB1,pA0,pA1,t,(t+3<NT),(t+1<NT),(t+1<NT));       ENDW(t);   RESC(); ROT();
    STEP(pA0,pA1,pB0,pB1,t+1,(t+4<NT),(t+2<NT),(t+2<NT));     ENDW(t+1); RESC(); ROT();
  }
  STEP(pB0,pB1,pA0,pA1,NT-1,false,false,false); RESC();
  { float sacc=pB0[0]+pB0[1]; _Pragma("unroll") for(int r=2;r<16;++r)sacc+=pB0[r]; _Pragma("unroll") for(int r=0;r<16;++r)sacc+=pB1[r]; l_reg+=sacc;
    pw0=(u32x4){PKW(pB0,0),PKW(pB0,2),PKW(pB0,4),PKW(pB0,6)};pw1=(u32x4){PKW(pB0,8),PKW(pB0,10),PKW(pB0,12),PKW(pB0,14)};pw2=(u32x4){PKW(pB1,0),PKW(pB1,2),PKW(pB1,4),PKW(pB1,6)};pw3=(u32x4){PKW(pB1,8),PKW(pB1,10),PKW(pB1,12),PKW(pB1,14)};
    SBAR(); pv(o,vb0+sl_cur,PAF(0),PAF(1),PAF(2),PAF(3)); }
  #undef PKW
  #undef PAF
  #undef VFR
  #undef PIN
  #undef MX3
  #undef GAPA
  #undef GAPB
  #undef EX
  #undef VRD
  #undef KRD
  #undef STEP
  #undef ENDW
  {auto rr=__builtin_amdgcn_permlane32_swap(__float_as_uint(l_reg),__float_as_uint(l_reg),false,false);l_reg=__uint_as_float(rr[0])+__uint_as_float(rr[1]);}
  if(hi==0)wsf[32+r32]=l_reg;asm volatile("s_waitcnt lgkmcnt(0)":::"memory");
  float rli[16];
  #pragma unroll
  for(int r=0;r<16;++r)rli[r]=__builtin_amdgcn_rcpf(wsf[32+crow(r,hi)]);
  bf16*Ow=O+(qrow0+wid*QBLK)*PQ;
  { bf16*stg=(bf16*)(shm+LDS_OST)+wid*2048;
    #pragma unroll
    for(int r=0;r<16;++r){const int orow=crow(r,hi);
      #pragma unroll
      for(int d0=0;d0<2;++d0)stg[orow*64+d0*32+r32]=__float2bfloat16(o[d0][r]*rli[r]);}
    asm volatile("s_waitcnt lgkmcnt(0)":::"memory");
    #pragma unroll
    for(int i=0;i<4;++i){const int row=i*8+(lane>>3),ch=lane&7; const u32x4 v=*(const u32x4*)(stg+row*64+ch*8); ATTN_STORE16(Ow+(long)row*PQ+ch*8,v);} }
  asm volatile("s_waitcnt lgkmcnt(0)\n\ts_barrier":::"memory");
  #undef DMA_K
  #undef DMA_V
  #undef CMASK
  #undef START
  #undef RESC
  #undef ROT
}
#undef SBAR
#undef WAIT_BAR
}
#define LAS __attribute__((address_space(3)))
typedef short bf16x8 __attribute__((ext_vector_type(8)));
typedef float f32x4 __attribute__((ext_vector_type(4)));
typedef float f32x2 __attribute__((ext_vector_type(2)));
typedef unsigned u32x4 __attribute__((ext_vector_type(4)));
typedef unsigned u32x2 __attribute__((ext_vector_type(2)));

struct Args {
    const float* in[24]; float* out; unsigned char* ws; int ph_lo, ph_hi;
};

__device__ __forceinline__ float wave_sum(float v, int lane) {
#pragma unroll
    for (int o = 1; o < 64; o <<= 1) v += shx(v, o, lane);
    return v;
}

__device__ __forceinline__ void transpose_item(const float* W, int ldw, int k0, int src0, int nvalid, bf16_t* WT, int K, int dst0, const float* kscale, LAS float* scr, int lane) {
#pragma unroll
    for (int i = 0; i < 32; ++i) { const int kk = 2 * i + (lane >> 5), c = lane & 31;
        float v = (c < nvalid) ? W[(size_t)(k0 + kk) * ldw + src0 + c] : 0.f; if (kscale) v *= kscale[k0 + kk];
        scr[kk * 33 + c] = v; }
    asm volatile("s_waitcnt lgkmcnt(0)" ::: "memory");
    const int c = lane & 7;
#pragma unroll
    for (int j = 0; j < 4; ++j) { const int n = (lane >> 3) + 8 * j; const LAS float* s = scr + (8 * c) * 33 + n;
        u32x4 o; o.x = pk2(s[0 * 33], s[1 * 33]); o.y = pk2(s[2 * 33], s[3 * 33]); o.z = pk2(s[4 * 33], s[5 * 33]); o.w = pk2(s[6 * 33], s[7 * 33]);
        const int row = dst0 + n; *(u32x4*)(WT + ((((size_t)(row >> 8) * (K >> 6) + (k0 >> 6)) * 256 + (row & 255)) * 64) + 8 * c) = o; }
    asm volatile("s_waitcnt lgkmcnt(0)" ::: "memory");
}
__device__ __forceinline__ int inproj_src(int lam0, int& nvalid) {
    nvalid = 32;
    const int t = lam0 >> 8, loc = lam0 & 255, bj = loc >> 7, wc = (loc >> 5) & 3;
    if (t < 2) return 64 * (4 * t + wc) + 32 * bj;
    if (t == 2) return wc < 2 ? 512 + 64 * wc + 32 * bj : 640 + 64 * (wc - 2) + 32 * bj;
    if (t < 9) return lam0;
    if (t < 13) { const int base = t < 11 ? 2320 : 2832, head = 2 * ((t - 9) & 1) + (wc >> 1); return base + 128 * head + 64 * bj + 32 * (wc & 1); }
    if (t < 17) return lam0 + 16;
    if (loc == 0) { nvalid = 16; return 2304; }
    nvalid = 0; return 0;
}

typedef const __attribute__((address_space(4))) Args* CArgsP;
__device__ __forceinline__ void prologue_phase(CArgsP a, LAS unsigned char* lds, int tid, int lane, int wave) {
    unsigned char* ws = a->ws;
    const int G = gridDim.x, gw = blockIdx.x * 8 + wave, NGW = G * 8;
    LAS float* scr = (LAS float*)(lds + wave * 8448);
    constexpr int I1 = 144 * 16, I2 = 96 * 16, I3 = 3 * 32 * 8, I4 = 32 * 16, I5 = 128 * 16, I6 = 32 * 64, IL = I1 + I2 + I3 + I4 + I5 + I6;
    for (int it = gw; it < 2 * IL; it += NGW) {
        const int L = it / IL; int r = it % IL;
        unsigned char* wl = ws + OFF_W + (size_t)L * W_LAYER;
        const float* w_in = a->in[8] + (size_t)L * DM * INDIM;
        if (r < I1) { const int lb = r % 144, kb = r / 144; int nv; const int src = inproj_src(lb * 32, nv);
            transpose_item(w_in, INDIM, kb * 64, src, nv, (bf16_t*)(wl + W_P), DM, lb * 32, nullptr, scr, lane); continue; } r -= I1;
        if (r < I2) { const int lb = r % 96, kb = r / 96;
            transpose_item(w_in, INDIM, kb * 64, 4368 + lb * 32, 32, (bf16_t*)(wl + W_G), DM, lb * 32, nullptr, scr, lane); continue; } r -= I2;
        if (r < I3) { const int i = r / 256, q = r % 256, lb = q % 32, kb = q / 32;
            transpose_item(a->in[19] + ((size_t)L * 3 + i) * 512 * DM, DM, kb * 64, lb * 32, 32, (bf16_t*)(wl + W_B) + (size_t)i * DM * 512, 512, lb * 32,
                           i == 1 ? a->in[16] + L * 512 : nullptr, scr, lane); continue; } r -= I3;
        if (r < I4) { const int lb = r % 32, kb = r / 32;
            transpose_item(a->in[20] + (size_t)L * DM * DM, DM, kb * 64, lb * 32, 32, (bf16_t*)(wl + W_O), DM, lb * 32, nullptr, scr, lane); continue; } r -= I4;
        if (r < I5) { const int lb = r % 128, kb = r / 128;
            transpose_item(a->in[21] + (size_t)L * DM * HID, HID, kb * 64, lb * 32, 32, (bf16_t*)(wl + W_1), DM, lb * 32, nullptr, scr, lane); continue; } r -= I5;
        { const int lb = r % 32, kb = r / 32;
            transpose_item(a->in[22] + (size_t)L * HID * DM, DM, kb * 64, lb * 32, 32, (bf16_t*)(wl + W_2), HID, lb * 32, nullptr, scr, lane); }
    }
    { f32x2* atab = (f32x2*)(ws + OFF_ATAB); f32x2* rtab = (f32x2*)(ws + OFF_RTAB);
      const int gt = blockIdx.x * 512 + tid, NT_ = G * 512;
      for (int i = gt; i < NLAT * 32; i += NT_) { const int p = i >> 5, f = i & 31;
          const float inv = exp2f(-(float)(f & 15) * (13.287712379549449f / 16.f)); const float ang = (float)(f < 16 ? (p >> 6) : (p & 63)) * inv;
          const double rv = (double)ang * 0.15915494309189535; const float fr_ = (float)(rv - __builtin_rint(rv));
          atab[i] = (f32x2){__builtin_amdgcn_cosf(fr_), __builtin_amdgcn_sinf(fr_)}; }
      for (int i = gt; i < SA * 64; i += NT_) { const int p = i >> 6, f = i & 63;
          const float inv = exp2f(-((float)f / 63.f) * 13.287712379549449f); const float ang = (float)p * inv;
          const double rv = (double)ang * 0.15915494309189535; const float fr_ = (float)(rv - __builtin_rint(rv));
          rtab[i] = (f32x2){__builtin_amdgcn_cosf(fr_), __builtin_amdgcn_sinf(fr_)}; } }
    { LAS float* sc = (LAS float*)(lds + 73728);
      LAS float* red = (LAS float*)(lds + 98304);
      __syncthreads();
      for (int i = tid; i < 5 * DM; i += 512) { const int r = i >> 10, k = i & 1023; const float x = r < 4 ? a->in[1][r * DM + k] : a->in[3][k]; sc[i] = siluf(x); }
      __syncthreads();
      float* mod = (float*)(ws + OFF_MOD);
      for (int it = blockIdx.x; it < 2 * 96; it += G) { const int L = it / 96, cb = (it % 96) * 64;
          const float* wm = a->in[4] + (size_t)L * DM * MODW + cb + lane;
          float acc[5] = {0.f, 0.f, 0.f, 0.f, 0.f};
#pragma unroll 32
          for (int k = wave * 128; k < wave * 128 + 128; ++k) { const float wv = wm[(size_t)k * MODW];
#pragma unroll
              for (int r = 0; r < 5; ++r) acc[r] += sc[r * DM + k] * wv; }
#pragma unroll
          for (int r = 0; r < 5; ++r) red[(wave * 5 + r) * 64 + lane] = acc[r];
          __syncthreads();
          if (tid < 320) { const int r = tid >> 6, l = tid & 63; float s = 0.f;
#pragma unroll
              for (int w = 0; w < 8; ++w) s += red[(w * 5 + r) * 64 + l];
              mod[((size_t)L * 5 + r) * MODW + cb + l] = s + a->in[5][L * MODW + cb + l]; }
          __syncthreads();
      } }
}

constexpr int NRF = 4;
__device__ __forceinline__ void norm_mod_phase(const float* hlat, const float* hctx, const float* w, const float* modL, int shift_idx, int scale_idx, bf16_t* U, int lane, int wave,
                                               const float* part = nullptr, int nparts = 0, const float* pgate = nullptr, float* wb = nullptr) {
    const int gw = blockIdx.x * 8 + wave, NGW = gridDim.x * 8;
    f32x4 wv[4];
#pragma unroll
    for (int j = 0; j < 4; ++j) wv[j] = *(const f32x4*)(w + 4 * lane + 256 * j);
    for (int row0 = gw; row0 < T; row0 += NRF * NGW) {
        f32x4 v[NRF][4]; float s[NRF]; const float* mrow[NRF]; bool ok[NRF];
#pragma unroll
        for (int q = 0; q < NRF; ++q) { const int row = row0 + q * NGW; ok[q] = row < T; const int rr = ok[q] ? row : row0;
            const int b = rr / SA, pos = rr % SA; const bool isctx = pos < NCTX;
            const float* src = isctx ? hctx + (size_t)(b * NCTX + pos) * DM : hlat + (size_t)(b * NLAT + pos - NCTX) * DM;
            mrow[q] = modL + (size_t)(isctx ? 4 : b) * MODW; s[q] = 0.f;
#pragma unroll
            for (int j = 0; j < 4; ++j) v[q][j] = *(const f32x4*)(src + 4 * lane + 256 * j);
            if (part && isctx) {
                const float* pp = part + (size_t)(b * NCTX + pos) * DM + 4 * lane;
#pragma unroll
                for (int j = 0; j < 4; ++j) { f32x4 acc = {0.f, 0.f, 0.f, 0.f};
                    for (int p = 0; p < nparts; ++p) acc += *(const f32x4*)(pp + (size_t)p * (NB * NCTX) * DM + 256 * j);
                    v[q][j] += *(const f32x4*)(pgate + 4 * lane + 256 * j) * acc;
                    if (wb && ok[q]) *(f32x4*)(wb + (size_t)(b * NCTX + pos) * DM + 4 * lane + 256 * j) = v[q][j]; } } }
#pragma unroll
        for (int q = 0; q < NRF; ++q) {
#pragma unroll
            for (int j = 0; j < 4; ++j) s[q] += (v[q][j][0] * v[q][j][0] + v[q][j][1] * v[q][j][1]) + (v[q][j][2] * v[q][j][2] + v[q][j][3] * v[q][j][3]);
            const float rstd = rsqrtf(wave_sum(s[q], lane) * (1.f / DM) + EPS);
            if (ok[q]) {
#pragma unroll
                for (int j = 0; j < 4; ++j) { const f32x4 sh = *(const f32x4*)(mrow[q] + shift_idx * DM + 4 * lane + 256 * j), scl = *(const f32x4*)(mrow[q] + scale_idx * DM + 4 * lane + 256 * j);
                    f32x4 y = v[q][j] * rstd * wv[j]; y = y * (scl + 1.f) + sh;
                    u32x2 o; o.x = pk2(y[0], y[1]); o.y = pk2(y[2], y[3]); *(u32x2*)(U + (size_t)(row0 + q * NGW) * DM + 4 * lane + 256 * j) = o; } } }
    }
}
__device__ __forceinline__ void final_norm_phase(float* hlat, const float* w, int lane, int wave) {
    const int gw = blockIdx.x * 8 + wave, NGW = gridDim.x * 8;
    f32x4 wv[4];
#pragma unroll
    for (int j = 0; j < 4; ++j) wv[j] = *(const f32x4*)(w + 4 * lane + 256 * j);
    for (int row0 = gw; row0 < NB * NLAT; row0 += NRF * NGW) {
        f32x4 v[NRF][4]; bool ok[NRF];
#pragma unroll
        for (int q = 0; q < NRF; ++q) { const int row = row0 + q * NGW; ok[q] = row < NB * NLAT; const float* src = hlat + (size_t)(ok[q] ? row : row0) * DM;
#pragma unroll
            for (int j = 0; j < 4; ++j) v[q][j] = *(const f32x4*)(src + 4 * lane + 256 * j); }
#pragma unroll
        for (int q = 0; q < NRF; ++q) { float s = 0.f;
#pragma unroll
            for (int j = 0; j < 4; ++j) s += (v[q][j][0] * v[q][j][0] + v[q][j][1] * v[q][j][1]) + (v[q][j][2] * v[q][j][2] + v[q][j][3] * v[q][j][3]);
            const float rstd = rsqrtf(wave_sum(s, lane) * (1.f / DM) + EPS);
            if (ok[q]) { float* dst = hlat + (size_t)(row0 + q * NGW) * DM;
#pragma unroll
                for (int j = 0; j < 4; ++j) *(f32x4*)(dst + 4 * lane + 256 * j) = v[q][j] * rstd * wv[j]; } }
    }
}
__device__ __forceinline__ void postproj_phase(const bf16_t* __restrict__ XBC, bf16_t* __restrict__ CONV, const float* cw, const float* cb, float* DT, float* Gc, float* CD, const float* a_log, const bf16_t* U, const bf16_t* Wdt, const float* dtb, int tid, int lane, int wave) {
    const int gw = blockIdx.x * 8 + wave, NGW = gridDim.x * 8;
    f32x4 w0[2][2], w1[2][2], w2[2][2], wb[2][2];
#pragma unroll
    for (int j = 0; j < 2; ++j)
#pragma unroll
        for (int h = 0; h < 2; ++h) { const int c = 8 * (lane + 64 * j) + 4 * h;
            w0[j][h] = *(const f32x4*)(cw + c); w1[j][h] = *(const f32x4*)(cw + 1024 + c); w2[j][h] = *(const f32x4*)(cw + 2048 + c); wb[j][h] = *(const f32x4*)(cb + c); }
#pragma unroll 4
    for (int row = gw; row < T; row += NGW) {
        const int pos = row % SA;
        const bool hasp = (pos != 0 && pos != NCTX), hasn = (pos != NCTX - 1 && pos != SA - 1);
#pragma unroll
        for (int j = 0; j < 2; ++j) { const int c0 = 8 * (lane + 64 * j);
            const bf16_t* p = XBC + (size_t)row * 1024 + c0;
            const u32x4 xc = *(const u32x4*)p; u32x4 xp = {0u, 0u, 0u, 0u}, xn = {0u, 0u, 0u, 0u};
            if (hasp) xp = *(const u32x4*)(p - 1024);
            if (hasn) xn = *(const u32x4*)(p + 1024);
            float o[8];
#pragma unroll
            for (int t = 0; t < 4; ++t) {
#pragma unroll
                for (int hh = 0; hh < 2; ++hh) { const int e = 2 * t + hh;
                    const float a = hh ? bf2f(xp[t] >> 16) : bf2f(xp[t] & 0xffffu), b = hh ? bf2f(xc[t] >> 16) : bf2f(xc[t] & 0xffffu), d = hh ? bf2f(xn[t] >> 16) : bf2f(xn[t] & 0xffffu);
                    const float y = w0[j][e >> 2][e & 3] * a + w1[j][e >> 2][e & 3] * b + w2[j][e >> 2][e & 3] * d + wb[j][e >> 2][e & 3];
                    o[e] = siluf(y); } }
            u32x4 w; w.x = pk2(o[0], o[1]); w.y = pk2(o[2], o[3]); w.z = pk2(o[4], o[5]); w.w = pk2(o[6], o[7]);
            *(u32x4*)(CONV + (size_t)row * 1024 + c0) = w; }
    }
    for (int u = blockIdx.x; u < NB * NCH; u += gridDim.x) {
        {
            const int fr = lane & 15, fq = lane >> 4; const size_t r0 = (size_t)(u / NCH) * SA + 128 * (u % NCH) + 16 * wave;
            const bf16_t* ap = U + (r0 + fr) * DM + 8 * fq; const bf16_t* bp = Wdt + (size_t)fr * 64 + 8 * fq;
            f32x4 acc = {0.f, 0.f, 0.f, 0.f};
#pragma unroll 8
            for (int kk = 0; kk < 32; ++kk) acc = __builtin_amdgcn_mfma_f32_16x16x32_bf16(*(const bf16x8*)(ap + 32 * kk), *(const bf16x8*)(bp + (size_t)(kk >> 1) * (256 * 64) + 32 * (kk & 1)), acc, 0, 0, 0);
            const float bias = dtb[fr];
#pragma unroll
            for (int r = 0; r < 4; ++r) { const float x = acc[r] + bias; DT[(r0 + 4 * fq + r) * 16 + fr] = x > 20.f ? x : log1pf(__expf(x)); }
        }
        __syncthreads();
        if (tid < 16) { const int b = u / NCH, c = u % NCH, dir = tid >> 3, h = tid & 7; const size_t row0 = (size_t)b * SA + 128 * c;
            const float an = -__expf(a_log[tid]); float g = 0.f;
            for (int l0 = 0; l0 < 128; l0 += 16) { float v[16];
#pragma unroll
                for (int j = 0; j < 16; ++j) { const int l = dir ? 127 - (l0 + j) : l0 + j; v[j] = __hip_atomic_load(DT + (row0 + l) * 16 + tid, __ATOMIC_RELAXED, __HIP_MEMORY_SCOPE_AGENT); }
#pragma unroll
                for (int j = 0; j < 16; ++j) { const int l = dir ? 127 - (l0 + j) : l0 + j; g += an * v[j]; Gc[(row0 + l) * 16 + tid] = g; } }
            CD[(((size_t)b * 2 + dir) * NCH + c) * 8 + h] = __expf(g); }
    }
}

constexpr int LP = 136;
struct LinArgs {
    const bf16_t* Qn; const bf16_t* Kn; const bf16_t* Vn; int ld;
    bf16_t* ST;
    const float* Gc; const float* DT; const float* CD;
    const float* rld;
};
__device__ __forceinline__ f32x4 mfma16(bf16x8 a, bf16x8 b, f32x4 c) { return __builtin_amdgcn_mfma_f32_16x16x32_bf16(a, b, c, 0, 0, 0); }

template <bool SSD> __device__ __forceinline__ void lin_gdt(const LinArgs& A, size_t row0, int dir, int h, int s, float& g, float& glast, float& dt) {
    if (SSD) { g = A.Gc[(row0 + s) * 16 + dir * 8 + h]; glast = A.Gc[(row0 + (dir ? 0 : 127)) * 16 + dir * 8 + h]; dt = A.DT[(row0 + s) * 16 + dir * 8 + h]; }
    else { const float lg = -__expf(A.rld[dir * 4 + h]);
        g = (float)(dir ? 128 - s : s + 1) * lg; glast = 128.f * lg; dt = 1.f; }
}
template <bool SCALE> __device__ __forceinline__ void stage_T(LAS bf16_t* dst, const bf16_t* src, int ld, size_t row0, int col0, int ncols, const LAS float* wts, int dvw, int tid) {
    const int nch = ncols >> 3;
    for (int id = tid; id < 128 * nch; id += 512) { const int s = id & 127, q = id >> 7;
        const u32x4 x = *(const u32x4*)(src + (row0 + s) * ld + col0 + 8 * q);
        float wv = 1.f; if (SCALE) wv = wts[((8 * q) / dvw) * 128 + s];
#pragma unroll
        for (int t = 0; t < 4; ++t) { float lo = bf2f(x[t] & 0xffffu), hi = bf2f(x[t] >> 16);
            if (SCALE) { lo *= wv; hi *= wv; dst[(8 * q + 2 * t) * LP + s] = (bf16_t)f2bf(lo); dst[(8 * q + 2 * t + 1) * LP + s] = (bf16_t)f2bf(hi); }
            else { dst[(8 * q + 2 * t) * LP + s] = (bf16_t)(x[t] & 0xffffu); dst[(8 * q + 2 * t + 1) * LP + s] = (bf16_t)(x[t] >> 16); } } }
}
__device__ __forceinline__ void stage_N(LAS bf16_t* dst, const bf16_t* src, int ld, size_t row0, int col0, int tid) {
    for (int id = tid; id < 128 * 16; id += 512) { const int q = id & 15, s = id >> 4;
        *(LAS u32x4*)(dst + s * LP + 8 * q) = *(const u32x4*)(src + (row0 + s) * ld + col0 + 8 * q); }
}

typedef short s16x4_t __attribute__((ext_vector_type(4)));
__device__ __forceinline__ bf16x8 frag_tr(const LAS bf16_t* base, int pitch, int krow0, int ncol0, int fr, int fq) {
    const LAS bf16_t* p = base + (krow0 + 8 * fq + (fr >> 2)) * pitch + ncol0 + 4 * (fr & 3);
    const s16x4_t lo = __builtin_bit_cast(s16x4_t, __builtin_amdgcn_ds_read_tr16_b64_v4i16((LAS s16x4_t*)p));
    const s16x4_t hi = __builtin_bit_cast(s16x4_t, __builtin_amdgcn_ds_read_tr16_b64_v4i16((LAS s16x4_t*)(p + 4 * pitch)));
    return (bf16x8){lo[0], lo[1], lo[2], lo[3], hi[0], hi[1], hi[2], hi[3]};
}
__device__ __forceinline__ void stage_NS(LAS bf16_t* dst, int pitch, const bf16_t* src, int ld, size_t row0, int col0, int ncols, const LAS float* wts, int dvw, int tid) {
    const int nch = ncols >> 3;
    for (int id = tid; id < 128 * nch; id += 512) { const int q = id % nch, s = id / nch;
        const u32x4 x = *(const u32x4*)(src + (row0 + s) * ld + col0 + 8 * q); const float wv = wts[((8 * q) / dvw) * 128 + s]; u32x4 o;
#pragma unroll
        for (int t = 0; t < 4; ++t) o[t] = pk2(bf2f(x[t] & 0xffffu) * wv, bf2f(x[t] >> 16) * wv);
        *(LAS u32x4*)(dst + s * pitch + 8 * q) = o; }
}
__device__ __forceinline__ void stage_NW(LAS bf16_t* dst, int pitch, const bf16_t* src, int ld, size_t row0, int col0, int ncols, int tid) {
    const int nch = ncols >> 3;
    for (int id = tid; id < 128 * nch; id += 512) { const int q = id % nch, s = id / nch;
        *(LAS u32x4*)(dst + s * pitch + 8 * q) = *(const u32x4*)(src + (row0 + s) * ld + col0 + 8 * q); }
}

template <int DV, int NH, bool SSD> __device__ __forceinline__ void lin_s1_phase(const LinArgs& A, LAS unsigned char* lds, int tid, int lane, int wave) {
    constexpr int NHT = SSD ? 8 : 4, NG = NHT / NH, NSLAB = NH * DV / 16 / 8, PV = NH * DV + 8;
    LAS bf16_t* KN = (LAS bf16_t*)lds;
    LAS bf16_t* VN = (LAS bf16_t*)(lds + 128 * LP * 2);
    LAS float* wts = (LAS float*)(lds + 128 * LP * 2 + 128 * PV * 2);
    const int fr = lane & 15, fq = lane >> 4;
    for (int u = blockIdx.x; u < NB * NCH * NG; u += gridDim.x) {
        const int grp = u % NG, c = (u / NG) % NCH, b = u / (NG * NCH); const size_t row0 = (size_t)b * SA + 128 * c;
        __syncthreads();
        for (int e = tid; e < 2 * NH * 128; e += 512) { const int dir = e / (NH * 128), hh = (e >> 7) % NH, s = e & 127; float g, gl, dt;
            lin_gdt<SSD>(A, row0, dir, grp * NH + hh, s, g, gl, dt); wts[e] = dt * __expf(gl - g); }
        stage_NW(KN, LP, A.Kn, A.ld, row0, grp * 128, 128, tid);
        stage_NW(VN, PV, A.Vn, A.ld, row0, grp * NH * DV, NH * DV, tid);
        __syncthreads();
#pragma unroll 1
        for (int dir = 0; dir < 2; ++dir) {
#pragma unroll
            for (int sl = 0; sl < NSLAB; ++sl) { const int slab = wave * NSLAB + sl;
                const int hh = (slab * 16) / DV, v0 = (slab * 16) % DV;
                const LAS float* wp = wts + (dir * NH + hh) * 128 + 8 * fq;
                f32x4 acc[8];
#pragma unroll
                for (int nt = 0; nt < 8; ++nt) acc[nt] = (f32x4){0.f, 0.f, 0.f, 0.f};
#pragma unroll
                for (int kk = 0; kk < 4; ++kk) { const bf16x8 vr = frag_tr(VN, PV, 32 * kk, slab * 16, fr, fq);
                    const f32x4 wa = *(const LAS f32x4*)(wp + 32 * kk), wb = *(const LAS f32x4*)(wp + 32 * kk + 4);
                    u32x4 vw;
#pragma unroll
                    for (int t = 0; t < 4; ++t) { const float w0 = t < 2 ? wa[2 * t] : wb[2 * t - 4], w1 = t < 2 ? wa[2 * t + 1] : wb[2 * t - 3];
                        vw[t] = pk2(bf2f((unsigned short)vr[2 * t]) * w0, bf2f((unsigned short)vr[2 * t + 1]) * w1); }
                    const bf16x8 vf = __builtin_bit_cast(bf16x8, vw);
#pragma unroll
                    for (int nt = 0; nt < 8; ++nt) acc[nt] = mfma16(frag_tr(KN, LP, 32 * kk, 16 * nt, fr, fq), vf, acc[nt]); }
                bf16_t* sp = A.ST + ((((size_t)b * 2 + dir) * NCH + c) * NHT + grp * NH + hh) * (size_t)(DV * 128) + (size_t)(v0 + fr) * 128 + 4 * fq;
#pragma unroll
                for (int nt = 0; nt < 8; ++nt) { u32x2 o; o.x = pk2(acc[nt][0], acc[nt][1]); o.y = pk2(acc[nt][2], acc[nt][3]); *(u32x2*)(sp + 16 * nt) = o; }
            }
        }
    }
}

template <int DV, bool SSD> __device__ __forceinline__ void lin_s2_phase(const LinArgs& A, int tid) {
    constexpr int NHT = SSD ? 8 : 4, PER = NHT * DV * 128;
    const int gt = blockIdx.x * 512 + tid, NT_ = gridDim.x * 512;
    for (int it = gt; it < 8 * (PER / 4); it += NT_) {
        const int bd = it / (PER / 4), e = (it % (PER / 4)) * 4, h = e / (DV * 128), dir = bd & 1;
        float run[4] = {0.f, 0.f, 0.f, 0.f};
        float dec_r = 1.f; if (!SSD) dec_r = __expf(-128.f * __expf(A.rld[dir * 4 + (h & 3)]));
        for (int s0 = 0; s0 < NCH; s0 += 11) {
            u32x2 x[11]; float dec[11]; bf16_t* pp[11];
#pragma unroll
            for (int j = 0; j < 11; ++j) { const int st = s0 + j; const int c = dir ? (st < 2 ? 1 - st : NCH + 1 - st) : st;
                pp[j] = A.ST + ((size_t)bd * NCH + c) * PER + e; x[j] = *(const u32x2*)pp[j];
                dec[j] = SSD ? A.CD[((size_t)bd * NCH + c) * 8 + h] : dec_r; }
#pragma unroll
            for (int j = 0; j < 11; ++j) {
                u32x2 o; o.x = pk2(run[0], run[1]); o.y = pk2(run[2], run[3]); *(u32x2*)pp[j] = o;
                run[0] = run[0] * dec[j] + bf2f(x[j].x & 0xffffu); run[1] = run[1] * dec[j] + bf2f(x[j].x >> 16);
                run[2] = run[2] * dec[j] + bf2f(x[j].y & 0xffffu); run[3] = run[3] * dec[j] + bf2f(x[j].y >> 16); }
        }
    }
}
template <int DV, int NH, bool SSD> struct LinEpi;
template <int DV, int NH, int NHU, bool SSD, class Epi> __device__ __forceinline__ void lin_s3_phase(const LinArgs& A, const Epi& E, int cmin, LAS unsigned char* lds, int tid, int lane, int wave) {
    constexpr int NHT = SSD ? 8 : 4, NG = NHT / NH, NSUB = NH / NHU, NVT = DV / 16, NSTD = SSD ? 2 : 1, NDG = 2 / NSTD, TILEB = 128 * LP * 2, NGE = 2 * NHU * 128;
    static_assert(NHU * DV == 128 && NGE <= 512, "unit output tile is 128 x 128");
    LAS bf16_t* KN = (LAS bf16_t*)lds;
    LAS bf16_t* VT = (LAS bf16_t*)(lds + TILEB);
    LAS bf16_t* WL = (LAS bf16_t*)(lds + 2 * TILEB) + wave * 16 * LP;
    LAS bf16_t* STL = (LAS bf16_t*)(lds + 3 * TILEB);
    LAS float* gsm = (LAS float*)(lds + 4 * TILEB);
    LAS float* dsm = gsm + NGE;
    const int fr = lane & 15, fq = lane >> 4, l0 = wave * 16;
    const int nunits = NB * NCH * NG * NSUB, G = gridDim.x;
#define S3_DECODE(uu, sub, grp, c, b) const int sub = (uu) % NSUB, grp = ((uu) / NSUB) % NG, c = ((uu) / (NSUB * NG)) % NCH, b = (uu) / (NSUB * NG * NCH)
    int u = blockIdx.x;
    while (u < nunits && ((u / (NSUB * NG)) % NCH) < cmin) u += G;
    u32x4 kreg[4], vreg[4]; bf16x8 qfn[4]; float gvn = 0.f, dvn = 0.f;
#define S3_LOAD_UNIT(uu) do { S3_DECODE(uu, sub_, grp_, c_, b_); const size_t row0_ = (size_t)b_ * SA + 128 * c_; const int h0_ = grp_ * NH + sub_ * NHU; \
        _Pragma("unroll") for (int i = 0; i < 4; ++i) { const int id = tid + 512 * i, q = id & 15, s_ = id >> 4; \
            kreg[i] = *(const u32x4*)(A.Kn + (row0_ + s_) * A.ld + grp_ * 128 + 8 * q); vreg[i] = *(const u32x4*)(A.Vn + (row0_ + s_) * A.ld + h0_ * DV + 8 * q); } \
        _Pragma("unroll") for (int kk = 0; kk < 4; ++kk) qfn[kk] = *(const bf16x8*)(A.Qn + (row0_ + l0 + fr) * A.ld + grp_ * 128 + 32 * kk + 8 * fq); \
        if (tid < NGE) { const int dir = tid / (NHU * 128), hh_ = (tid >> 7) % NHU, s_ = tid & 127; float gl_; lin_gdt<SSD>(A, row0_, dir, h0_ + hh_, s_, gvn, gl_, dvn); } } while (0)
    while (u < nunits) {
        S3_LOAD_UNIT(u);
        S3_DECODE(u, sub, grp, c, b); const size_t row0 = (size_t)b * SA + 128 * c; const int h0 = grp * NH + sub * NHU;
        int un = u + G; while (un < nunits && ((un / (NSUB * NG)) % NCH) < cmin) un += G;
        __syncthreads();
#pragma unroll
        for (int i = 0; i < 4; ++i) { const int id = tid + 512 * i, q = id & 15, s_ = id >> 4; *(LAS u32x4*)(KN + s_ * LP + 8 * q) = kreg[i]; *(LAS u32x4*)(VT + s_ * LP + 8 * q) = vreg[i]; }
        if (tid < NGE) { gsm[tid] = gvn; dsm[tid] = dvn; }
        bf16x8 qf[4];
#pragma unroll
        for (int kk = 0; kk < 4; ++kk) qf[kk] = qfn[kk];
        u32x4 zreg[4], sreg[4];
#pragma unroll
        for (int i = 0; i < 4; ++i) { const int id = tid + 512 * i, q = id & 15, s_ = id >> 4; zreg[i] = *(const u32x4*)(E.buf + (row0 + s_) * 512 + h0 * DV + 8 * q); }
#define S3_LOAD_ST(stage) do { const int hh_ = (stage) / NDG, dg_ = (stage) % NDG; \
        _Pragma("unroll") for (int i = 0; i < 4; ++i) { const int id = tid + 512 * i, q = id & 15, v = id >> 4, d = v / DV, dir = dg_ * NSTD + d; \
            sreg[i] = *(const u32x4*)(A.ST + ((((size_t)b * 2 + dir) * NCH + c) * NHT + h0 + hh_) * (size_t)(DV * 128) + (size_t)(v - d * DV) * 128 + 8 * q); } } while (0)
        S3_LOAD_ST(0);
        __syncthreads();
        f32x4 P[8];
#pragma unroll
        for (int nt = 0; nt < 8; ++nt) { P[nt] = (f32x4){0.f, 0.f, 0.f, 0.f};
#pragma unroll
            for (int kk = 0; kk < 4; ++kk) P[nt] = mfma16(qf[kk], *(const LAS bf16x8*)(KN + (16 * nt + fr) * LP + 32 * kk + 8 * fq), P[nt]); }
        __syncthreads();
#pragma unroll
        for (int i = 0; i < 4; ++i) { const int id = tid + 512 * i, q = id & 15, s_ = id >> 4; *(LAS u32x4*)(KN + s_ * LP + 8 * q) = zreg[i]; }
#pragma unroll 1
        for (int hh = 0; hh < NHU; ++hh) {
            const int h = h0 + hh;
            const LAS float* gf = gsm + hh * 128; const LAS float* gb = gsm + (NHU + hh) * 128;
            const LAS float* df = dsm + hh * 128; const LAS float* db = dsm + (NHU + hh) * 128;
            float gfl[4], gbl[4];
#pragma unroll
            for (int r = 0; r < 4; ++r) { gfl[r] = gf[l0 + 4 * fq + r]; gbl[r] = gb[l0 + 4 * fq + r]; }
#pragma unroll
            for (int nt = 0; nt < 8; ++nt) { const int s = 16 * nt + fr;
                if (16 * nt + 15 < l0) {
                    const float gfs = gf[s], dfs = df[s];
#pragma unroll
                    for (int r = 0; r < 4; ++r) WL[(4 * fq + r) * LP + s] = (bf16_t)f2bf(P[nt][r] * (__expf(fminf(gfl[r] - gfs, 0.f)) * dfs));
                } else if (16 * nt > l0 + 15) {
                    const float gbs = gb[s], dbs = db[s];
#pragma unroll
                    for (int r = 0; r < 4; ++r) WL[(4 * fq + r) * LP + s] = (bf16_t)f2bf(P[nt][r] * (__expf(fminf(gbl[r] - gbs, 0.f)) * dbs));
                } else {
                    const float gfs = gf[s], gbs = gb[s], dfs = df[s], dbs = db[s];
#pragma unroll
                    for (int r = 0; r < 4; ++r) { const int l = l0 + 4 * fq + r;
                        const float mf = (s <= l) ? __expf(fminf(gfl[r] - gfs, 0.f)) * dfs : 0.f;
                        const float mb = (s >= l) ? __expf(fminf(gbl[r] - gbs, 0.f)) * dbs : 0.f;
                        WL[(4 * fq + r) * LP + s] = (bf16_t)f2bf(P[nt][r] * (mf + mb)); } } }
            asm volatile("s_waitcnt lgkmcnt(0)" ::: "memory");
            bf16x8 af[4];
#pragma unroll
            for (int kk = 0; kk < 4; ++kk) af[kk] = *(const LAS bf16x8*)(WL + fr * LP + 32 * kk + 8 * fq);
            f32x4 y[NVT];
#pragma unroll
            for (int vt = 0; vt < NVT; ++vt) { f32x4 ay = {0.f, 0.f, 0.f, 0.f};
#pragma unroll
                for (int kk = 0; kk < 4; ++kk) ay = mfma16(af[kk], frag_tr(VT, LP, 32 * kk, hh * DV + 16 * vt, fr, fq), ay);
                y[vt] = ay; }
#pragma unroll 1
            for (int dg = 0; dg < NDG; ++dg) {
                __syncthreads();
#pragma unroll
                for (int i = 0; i < 4; ++i) { const int id = tid + 512 * i, q = id & 15, v = id >> 4; *(LAS u32x4*)(STL + v * LP + 8 * q) = sreg[i]; }
                { const int nst = hh * NDG + dg + 1; if (nst < NHU * NDG) S3_LOAD_ST(nst); }
                __syncthreads();
#pragma unroll
                for (int d = 0; d < NSTD; ++d) { const int dir = dg * NSTD + d; float ed[4];
#pragma unroll
                    for (int r = 0; r < 4; ++r) ed[r] = __expf((dir ? gb : gf)[l0 + 4 * fq + r]);
#pragma unroll
                    for (int vt = 0; vt < NVT; ++vt) { f32x4 a0 = {0.f, 0.f, 0.f, 0.f};
#pragma unroll
                        for (int kk = 0; kk < 4; ++kk) a0 = mfma16(qf[kk], *(const LAS bf16x8*)(STL + (d * DV + 16 * vt + fr) * LP + 32 * kk + 8 * fq), a0);
#pragma unroll
                        for (int r = 0; r < 4; ++r) y[vt][r] += ed[r] * a0[r]; } }
            }
            E(y, l0 + 4 * fq, row0 + l0 + 4 * fq, h, hh, fr, VT, KN, lane);
        }
        __syncthreads();
        for (int id = tid; id < 128 * 16; id += 512) { const int q = id & 15, s = id >> 4;
            *(u32x4*)(E.buf + (row0 + s) * 512 + h0 * DV + 8 * q) = *(const LAS u32x4*)(KN + s * LP + 8 * q); }
        u = un;
    }
#undef S3_DECODE
#undef S3_LOAD_UNIT
#undef S3_LOAD_ST
}
struct SsdEpi {
    bf16_t* buf; float* SSQ; const float* dskip;
    __device__ __forceinline__ void operator()(f32x4 (&y)[4], int lb, size_t rowb, int h, int hh, int fr, const LAS bf16_t* VT, LAS bf16_t* ZT, int lane) const {
        const float dsk = dskip[h]; float ss[4] = {0.f, 0.f, 0.f, 0.f};
#pragma unroll
        for (int vt = 0; vt < 4; ++vt)
#pragma unroll
            for (int r = 0; r < 4; ++r) { const int v = 16 * vt + fr; LAS bf16_t* zp = ZT + (lb + r) * LP + hh * 64 + v;
                const float x = bf2f(VT[(lb + r) * LP + hh * 64 + v]);
                const float val = (y[vt][r] + dsk * x) * siluf(bf2f(*zp)); ss[r] += val * val; *zp = (bf16_t)f2bf(val); }
#pragma unroll
        for (int r = 0; r < 4; ++r) { float s = ss[r]; s += shx(s, 1, lane); s += shx(s, 2, lane); s += shx(s, 4, lane); s += shx(s, 8, lane);
            if (fr == 0) SSQ[(rowb + r) * 8 + h] = s; }
    }
};
struct RetEpi {
    bf16_t* buf; const float* gnw;
    __device__ __forceinline__ void operator()(f32x4 (&y)[8], int lb, size_t rowb, int h, int hh, int fr, const LAS bf16_t* VT, LAS bf16_t* ZT, int lane) const {
#pragma unroll
        for (int r = 0; r < 4; ++r) { float s = 0.f;
#pragma unroll
            for (int vt = 0; vt < 8; ++vt) s += y[vt][r];
            s += shx(s, 1, lane); s += shx(s, 2, lane); s += shx(s, 4, lane); s += shx(s, 8, lane);
            const float mu = s * (1.f / 128.f); float q = 0.f;
#pragma unroll
            for (int vt = 0; vt < 8; ++vt) { const float d = y[vt][r] - mu; q += d * d; }
            q += shx(q, 1, lane); q += shx(q, 2, lane); q += shx(q, 4, lane); q += shx(q, 8, lane);
            const float rstd = rsqrtf(q * (1.f / 128.f) + EPS);
#pragma unroll
            for (int vt = 0; vt < 8; ++vt) { const int v = 16 * vt + fr; LAS bf16_t* gp = ZT + (lb + r) * LP + v;
                *gp = (bf16_t)f2bf((y[vt][r] - mu) * rstd * gnw[h * 128 + v] * siluf(bf2f(*gp))); } }
    }
};
#ifdef ONLY_PH
#define EN(x) ((x) == ONLY_PH)
#elif defined(SKIP_PH)
#define EN(x) ((x) != SKIP_PH)
#else
#define EN(x) (MODE == 0 || (MODE == 1 && (x) != 15) || (MODE == 2 && (x) == 15))
#endif
#define XB_TMO      128
#define XB_XCNT(j)  (256  + 64 * (j))
#define XB_XSUB(j)  (1280 + 64 * (j))
#define XB_XGEN(j)  (2304 + 64 * (j))
#define XB_TOP      3328
#define XB_TOPGEN   3392
#define XCD_BAR_WORDS 3456
#define XB_SPIN_CAP (1u << 18)

__device__ __forceinline__ unsigned xb_ld(unsigned* p)              { return __hip_atomic_load(p, __ATOMIC_RELAXED, __HIP_MEMORY_SCOPE_AGENT); }
__device__ __forceinline__ unsigned xb_add(unsigned* p, unsigned v) { return __hip_atomic_fetch_add(p, v, __ATOMIC_RELAXED, __HIP_MEMORY_SCOPE_AGENT); }
__device__ __forceinline__ unsigned xb_xcc_id() { return (unsigned)__builtin_amdgcn_s_getreg((3 << 11) | 20) & 0xFu; }
#define XB_SPIN(cond, bar) do { unsigned _sp = 0; while (cond) { __builtin_amdgcn_s_sleep(1); \
    if ((++_sp & 255u) == 0u) { if (xb_ld(&(bar)[XB_TMO])) break; if (_sp > XB_SPIN_CAP) { atomicAdd(&(bar)[XB_TMO], 1u); break; } } } } while (0)

struct XcdBarrier {
    unsigned* bar; unsigned x;
    volatile LAS unsigned* st;
};

__device__ __forceinline__ XcdBarrier xcd_barrier_post(unsigned* bar, volatile LAS unsigned* st) {
    XcdBarrier b; b.bar = bar; b.x = xb_xcc_id(); b.st = st;
    if (threadIdx.x == 0) (void)xb_add(&bar[XB_XCNT(b.x)], 1u);
    return b;
}
__device__ __forceinline__ void xcd_barrier_complete(unsigned* bar, unsigned x, unsigned& nloc, unsigned& nx) {
    const unsigned G = gridDim.x * gridDim.y * gridDim.z;
    unsigned sum, cnt, mine, sp = 0u;
    for (;;) {
        sum = 0u; cnt = 0u; mine = 0u;
#pragma unroll
        for (unsigned j = 0; j < 16; ++j) { const unsigned c = xb_ld(&bar[XB_XCNT(j)]); sum += c; cnt += (c > 0u) ? 1u : 0u; mine = (j == x) ? c : mine; }
        if (sum == G) break;
        __builtin_amdgcn_s_sleep(1);
        if ((++sp & 255u) == 0u) { if (xb_ld(&bar[XB_TMO])) break; if (sp > XB_SPIN_CAP) { atomicAdd(&bar[XB_TMO], 1u); break; } }
    }
    nloc = mine > 0u ? mine : 1u; nx = cnt > 0u ? cnt : 1u;
}

__device__ __forceinline__ void xcd_barrier(const XcdBarrier& b, const int tid_) {
    asm volatile("s_waitcnt vmcnt(0)" ::: "memory");
    __syncthreads();
    if (tid_ == 0) {
        unsigned* bar = b.bar;
        __builtin_amdgcn_s_waitcnt(0);
        unsigned nloc = b.st[0], nx = b.st[1];
        if (nloc == 0u) { xcd_barrier_complete(bar, b.x, nloc, nx); b.st[0] = nloc; b.st[1] = nx; }
        const unsigned old = xb_add(&bar[XB_XSUB(b.x)], 1u);
        const unsigned gen = old / nloc;
        if (old + 1u == (gen + 1u) * nloc) {
            __builtin_amdgcn_fence(__ATOMIC_RELEASE, "agent");
            asm volatile("s_waitcnt vmcnt(0)" ::: "memory");
            const unsigned og = xb_add(&bar[XB_TOP], 1u);
            const unsigned tg = og / nx;
            if (og + 1u == (tg + 1u) * nx) xb_add(&bar[XB_TOPGEN], 1u);
            else XB_SPIN(xb_ld(&bar[XB_TOPGEN]) == tg, bar);
            __builtin_amdgcn_fence(__ATOMIC_ACQUIRE, "agent");
            xb_add(&bar[XB_XGEN(b.x)], 1u);
            asm volatile("s_waitcnt vmcnt(0)" ::: "memory");
        } else {
            XB_SPIN(xb_ld(&bar[XB_XGEN(b.x)]) == gen, bar);
            __builtin_amdgcn_fence(__ATOMIC_ACQUIRE, "agent");
            asm volatile("s_waitcnt vmcnt(0)" ::: "memory");
        }
    }
    __syncthreads();
}

constexpr size_t OFF_PART = 424 * MiB;
constexpr size_t OFF_BAR = 13 * MiB;
constexpr int MISC_OFF = LDS_BYTES - 64;
constexpr int PH_PER_LAYER = 15, N_PHASES = 2 + DEPTH * PH_PER_LAYER;
#define EN(x) (MODE == 0 || (MODE == 1 && (x) != 15) || (MODE == 2 && (x) == 15))
__device__ __forceinline__ int mk_tid(int wave_id) { unsigned m_ = ~0u; asm volatile("" : "+s"(m_)); int t = wave_id * 64 + (int)__builtin_amdgcn_mbcnt_hi(m_, __builtin_amdgcn_mbcnt_lo(m_, 0u)); asm volatile("" : "+v"(t)); return t; }
#define PHASE_BEGIN(p) if (ph_lo <= (p) && (p) < ph_hi) { int tid = mk_tid(wave_id); const int lane = tid & 63, wave = __builtin_amdgcn_readfirstlane(tid >> 6); \
    CArgsP ap = (CArgsP)__builtin_amdgcn_kernarg_segment_ptr(); asm volatile("" : "+s"(ap)); unsigned char* ws = ap->ws; float* hlat = ap->out; (void)lane; (void)wave; (void)hlat;
#define PHASE_END(p) if ((p) + 1 < ph_hi) { if (ph_hi < 0) grid.sync();   else xcd_barrier(xbar, mk_tid(wave_id)); } }

template <int MODE, int L> __device__ __forceinline__ void layer_phases(cg::grid_group& grid, const XcdBarrier& xbar, const int wave_id, LAS unsigned char* lds, unsigned char* lds_raw, const int ph_lo, const int ph_hi) {
    constexpr int P0 = 1 + L * PH_PER_LAYER;
#define LAYER_COMMON const float* modL = (const float*)(ws + OFF_MOD) + (size_t)L * 5 * MODW; unsigned char* wl = ws + OFF_W + (size_t)L * W_LAYER; \
    const float* bl = L == 0 ? ap->in[0] : hlat; const float* bc = L == 0 ? ap->in[2] : (const float*)(ws + OFF_HCTX);     (void)modL; (void)wl; (void)bl; (void)bc;
    PHASE_BEGIN(P0 + 0) LAYER_COMMON
        if (EN(0)) { if (L == 0) norm_mod_phase(bl, bc, ap->in[6] + L * DM, modL, 0, 1, (bf16_t*)(ws + OFF_U), lane, wave);
                     else norm_mod_phase(bl, bc, ap->in[6] + L * DM, modL, 0, 1, (bf16_t*)(ws + OFF_U), lane, wave, (const float*)(ws + OFF_PART), 16, modL - 5 * MODW + 4 * MODW + 5 * DM, nullptr); }
    PHASE_END(P0 + 0)
    PHASE_BEGIN(P0 + 1) LAYER_COMMON
        if (EN(1)) { pg8::Gemm g{(bf16_t*)(ws + OFF_U), (const bf16_t*)(wl + W_P), 0, 0, T, N1, DM, DM, 0, 1};
            pg8::StaticOrder S; S.init(T, N1, gridDim.x, blockIdx.x);
            pg8::EpiInProj E{ws, (float*)(ws + OFF_DT), ap->in[9] + L * 64, ap->in[10] + L * 64, ap->in[13] + L * 16, (const f32x2*)(ws + OFF_ATAB), (const f32x2*)(ws + OFF_RTAB)};
            pg8::gemm_phase<pg8::EpiInProj, pg8::StaticOrder, true, true>(lds, g, S, E, tid); }
    PHASE_END(P0 + 1)
    PHASE_BEGIN(P0 + 2) LAYER_COMMON
        if (EN(2)) postproj_phase((bf16_t*)(ws + OFF_XBC), (bf16_t*)(ws + OFF_CONV), ap->in[11] + L * 3 * 1024, ap->in[12] + L * 1024, (float*)(ws + OFF_DT), (float*)(ws + OFF_G), (float*)(ws + OFF_CD), ap->in[14] + L * 16, (const bf16_t*)(ws + OFF_U), (const bf16_t*)(wl + W_P) + (size_t)N1 * DM, ap->in[13] + L * 16, tid, lane, wave);
    PHASE_END(P0 + 2)
#define SSD_ARGS LinArgs A{(bf16_t*)(ws + OFF_CONV) + 768, (bf16_t*)(ws + OFF_CONV) + 512, (bf16_t*)(ws + OFF_CONV), 1024, (bf16_t*)(ws + OFF_ST), (float*)(ws + OFF_G), (float*)(ws + OFF_DT), (float*)(ws + OFF_CD), nullptr};
#define RET_ARGS LinArgs A{(bf16_t*)(ws + OFF_RQ), (bf16_t*)(ws + OFF_RK), (bf16_t*)(ws + OFF_RV), 512, (bf16_t*)(ws + OFF_ST), nullptr, nullptr, nullptr, ap->in[17] + L * 8};
    PHASE_BEGIN(P0 + 3) SSD_ARGS if (EN(3)) lin_s1_phase<64, 4, true>(A, lds, tid, lane, wave); PHASE_END(P0 + 3)
    PHASE_BEGIN(P0 + 4) SSD_ARGS if (EN(4)) lin_s2_phase<64, true>(A, tid); PHASE_END(P0 + 4)
    PHASE_BEGIN(P0 + 5) SSD_ARGS if (EN(5)) { SsdEpi E{(bf16_t*)(ws + OFF_Z), (float*)(ws + OFF_SSQ), ap->in[15] + L * 8}; lin_s3_phase<64, 4, 2, true, SsdEpi>(A, E, L == DEPTH - 1 ? 2 : 0, lds, tid, lane, wave); } PHASE_END(P0 + 5)
    PHASE_BEGIN(P0 + 6) RET_ARGS if (EN(6)) lin_s1_phase<128, 1, false>(A, lds, tid, lane, wave); PHASE_END(P0 + 6)
    PHASE_BEGIN(P0 + 7) RET_ARGS if (EN(7)) lin_s2_phase<128, false>(A, tid); PHASE_END(P0 + 7)
    PHASE_BEGIN(P0 + 8) RET_ARGS
        if (EN(8)) { RetEpi E{(bf16_t*)(ws + OFF_RG), ap->in[18] + L * 512}; lin_s3_phase<128, 1, 1, false, RetEpi>(A, E, L == DEPTH - 1 ? 2 : 0, lds, tid, lane, wave); __syncthreads(); }
        if (EN(15)) {
            typedef attn_body::bf16 abf; const abf* Qp = (const abf*)(ws + OFF_Q); const abf* KVp = (const abf*)(ws + OFF_KV);
            if (L < DEPTH - 1) for (int u = (int)((blockIdx.x + gridDim.x - 32u) % gridDim.x); u < NB * 8; u += gridDim.x) { const int b = u >> 3, h = u & 7;     const long r0 = (long)b * SA;
                attn_body::attn_unit<8>(r0, r0, 4, Qp + h * 64, KVp + (h >> 2) * 64, KVp + 128 + (h >> 2) * 64, (abf*)Qp + h * 64, (char*)lds_raw, tid); }
            for (int u = blockIdx.x; u < NB * 8 * 32; u += gridDim.x) { const int x = u & 7, qb = (u >> 3) & 31, i = u >> 8; const int b = x >> 1, h = (x & 1) * 4 + i; const long r0 = (long)b * SA;
                attn_body::attn_unit<8>(r0 + NCTX + 256 * qb, r0, SA / 64, Qp + h * 64, KVp + (h >> 2) * 64, KVp + 128 + (h >> 2) * 64, (abf*)Qp + h * 64, (char*)lds_raw, tid); }
        }
    PHASE_END(P0 + 8)
    PHASE_BEGIN(P0 + 9) LAYER_COMMON
        if (EN(9)) { pg8::Gemm g{(bf16_t*)(ws + OFF_U), (const bf16_t*)(wl + W_G), 0, 0, T, NGATE, DM, DM, 0, 1};
            pg8::StaticOrder S; S.init(T, NGATE, gridDim.x, blockIdx.x, L == DEPTH - 1);
            pg8::EpiBf16<2> E{(bf16_t*)(ws + OFF_GATE), NGATE, 0};
            pg8::gemm_phase<pg8::EpiBf16<2>, pg8::StaticOrder, true, true>(lds, g, S, E, tid); }
    PHASE_END(P0 + 9)
    PHASE_BEGIN(P0 + 10) LAYER_COMMON
        if (EN(10)) { pg8::Gemm g{(bf16_t*)(ws + OFF_Q), (const bf16_t*)(wl + W_B), SZ512, (size_t)DM * 512 * 2, T, DM, 512, 512, 0, 1};
            pg8::MergeOrder S; S.S.init(T, DM, gridDim.x, blockIdx.x, L == DEPTH - 1);
            pg8::EpiMerge E{(bf16_t*)(ws + OFF_GATE), (float*)(ws + OFF_SSQ), (bf16_t*)(ws + OFF_U)};
            pg8::gemm_phase<pg8::EpiMerge, pg8::MergeOrder, true, true>(lds, g, S, E, tid); }
    PHASE_END(P0 + 10)
    PHASE_BEGIN(P0 + 11) LAYER_COMMON
        if (EN(11)) { pg8::Gemm g{(bf16_t*)(ws + OFF_U), (const bf16_t*)(wl + W_O), 0, 0, T, DM, DM, DM, 0, 1};
            pg8::StaticOrder S; S.init(T, DM, gridDim.x, blockIdx.x, 1);
            pg8::EpiResid E{bl, bc, hlat, (float*)(ws + OFF_HCTX), modL + 2 * DM};
            pg8::gemm_phase<pg8::EpiResid, pg8::StaticOrder, true, true>(lds, g, S, E, tid);
            if (L < DEPTH - 1) { pg8::Gemm g2{(bf16_t*)(ws + OFF_U), (const bf16_t*)(wl + W_O), 512, 131072, T, DM, 256, DM, 0, 1};
                pg8::CtxSplitOrder S2{4, (int)gridDim.x, (int)blockIdx.x}; pg8::EpiPartial E2{(float*)(ws + OFF_PART)};
                pg8::gemm_phase<pg8::EpiPartial, pg8::CtxSplitOrder, true, true>(lds, g2, S2, E2, mk_tid(wave_id)); } }
    PHASE_END(P0 + 11)
    PHASE_BEGIN(P0 + 12) LAYER_COMMON
        if (EN(12)) { if (L == 0) norm_mod_phase(hlat, ap->in[2], ap->in[7] + L * DM, modL, 3, 4, (bf16_t*)(ws + OFF_U), lane, wave, (const float*)(ws + OFF_PART), 4, modL + 4 * MODW + 2 * DM, (float*)(ws + OFF_HCTX));
                      else norm_mod_phase(hlat, (const float*)(ws + OFF_HCTX), ap->in[7] + L * DM, modL, 3, 4, (bf16_t*)(ws + OFF_U), lane, wave); }
    PHASE_END(P0 + 12)
    PHASE_BEGIN(P0 + 13) LAYER_COMMON
        if (EN(13)) { pg8::Gemm g{(bf16_t*)(ws + OFF_U), (const bf16_t*)(wl + W_1), 0, 0, T, HID, DM, DM, 0, 1};
            pg8::StaticOrder S; S.init(T, HID, gridDim.x, blockIdx.x, L == DEPTH - 1);
            pg8::EpiBf16<1> E{(bf16_t*)(ws + OFF_HID), HID, 1};
            pg8::gemm_phase<pg8::EpiBf16<1>, pg8::StaticOrder, true, true>(lds, g, S, E, tid); }
    PHASE_END(P0 + 13)
    PHASE_BEGIN(P0 + 14) LAYER_COMMON
        if (EN(14)) { pg8::Gemm g{(bf16_t*)(ws + OFF_HID), (const bf16_t*)(wl + W_2), 0, 0, T, DM, HID, HID, 1, 1};
            pg8::StaticOrder S; S.init(T, DM, gridDim.x, blockIdx.x, 1);
            pg8::EpiResid E{hlat, (const float*)(ws + OFF_HCTX), hlat, (float*)(ws + OFF_HCTX), modL + 5 * DM};
            pg8::gemm_phase<pg8::EpiResid, pg8::StaticOrder, true, true>(lds, g, S, E, tid);
            if (L < DEPTH - 1) { pg8::Gemm g2{(bf16_t*)(ws + OFF_HID), (const bf16_t*)(wl + W_2), 131072, 131072, T, DM, 256, HID, 1, 1};
                pg8::CtxSplitOrder S2{16, (int)gridDim.x, (int)blockIdx.x}; pg8::EpiPartial E2{(float*)(ws + OFF_PART)};
                pg8::gemm_phase<pg8::EpiPartial, pg8::CtxSplitOrder, true, true>(lds, g2, S2, E2, mk_tid(wave_id)); } }
    PHASE_END(P0 + 14)
}

template <int MODE> __global__ void __launch_bounds__(512, 2) mega_fwd(Args args) {
    extern __shared__ __attribute__((aligned(16))) unsigned char lds_raw[];
    LAS unsigned char* lds = (LAS unsigned char*)lds_raw;
    cg::grid_group grid = cg::this_grid();
    const int ph_lo = args.ph_lo, ph_hi = args.ph_hi;
    if (threadIdx.x < 16) ((LAS unsigned*)(lds + MISC_OFF))[threadIdx.x] = 0u;
    __syncthreads();
    const int wave_id = __builtin_amdgcn_readfirstlane((int)threadIdx.x >> 6);
    XcdBarrier xbar; xbar.bar = (unsigned*)(args.ws + OFF_BAR); xbar.x = 0; xbar.st = nullptr;
    if (ph_hi - ph_lo > 1) xbar = xcd_barrier_post((unsigned*)(args.ws + OFF_BAR), (volatile LAS unsigned*)(lds + MISC_OFF));
    PHASE_BEGIN(0) if (EN(100)) prologue_phase(ap, lds, tid, lane, wave); PHASE_END(0)
    layer_phases<MODE, 0>(grid, xbar, wave_id, lds, lds_raw, ph_lo, ph_hi);
    layer_phases<MODE, 1>(grid, xbar, wave_id, lds, lds_raw, ph_lo, ph_hi);
    PHASE_BEGIN(N_PHASES - 1) if (EN(101)) final_norm_phase(hlat, ap->in[23], lane, wave); PHASE_END(N_PHASES - 1)
}

extern "C" void kernel_launch(void* const* d_in, const int* in_sizes, int n_in, void* d_out, int out_size, void* d_ws, size_t ws_size, hipStream_t stream) {
    static int grid = 0;
    if (grid == 0) {
        if (n_in != 24 || ws_size < OFF_END) { fprintf(stderr, "kernel_launch: unexpected problem (n_in %d, ws %zu)\n", n_in, ws_size); grid = -1; return; }
        int dev = 0, cus = 0, per_cu = 0;
        (void)hipGetDevice(&dev); (void)hipDeviceGetAttribute(&cus, hipDeviceAttributeMultiprocessorCount, dev);
        #if MK_ONE_LAUNCH
        (void)hipFuncSetAttribute((const void*)mega_fwd<0>, hipFuncAttributeMaxDynamicSharedMemorySize, LDS_BYTES);
#else
        (void)hipFuncSetAttribute((const void*)mega_fwd<1>, hipFuncAttributeMaxDynamicSharedMemorySize, LDS_BYTES); (void)hipFuncSetAttribute((const void*)mega_fwd<2>, hipFuncAttributeMaxDynamicSharedMemorySize, LDS_BYTES);
#endif
        (void)hipOccupancyMaxActiveBlocksPerMultiprocessor(&per_cu, (const void*)mega_fwd<MK_ONE_LAUNCH ? 0 : 1>, 512, LDS_BYTES);
        if (per_cu < 1) { fprintf(stderr, "kernel_launch: occupancy query says %d\n", per_cu); per_cu = 1; }
        (void)hipGetLastError();
        grid = cus * 1;
    }
    if (grid < 0) return;
    Args a{};
    for (int i = 0; i < 24; ++i) a.in[i] = (const float*)d_in[i];
    a.out = (float*)d_out; a.ws = (unsigned char*)d_ws;
#if MK_ONE_LAUNCH
    (void)hipMemsetAsync((char*)d_ws + OFF_BAR, 0, 16384, stream);
    a.ph_lo = 0; a.ph_hi = N_PHASES;
    { void* kargs[] = {&a}; hipError_t e = hipLaunchCooperativeKernel((const void*)mega_fwd<0>, dim3(grid), dim3(512), kargs, LDS_BYTES, stream);
      if (e != hipSuccess) fprintf(stderr, "cooperative launch failed: %s\n", hipGetErrorString(e)); }
#ifdef PROBE_LO
    (void)hipMemsetAsync((char*)d_ws + OFF_BAR, 0, 16384, stream);
    a.ph_lo = PROBE_LO; a.ph_hi = PROBE_HI;
    { void* kargs[] = {&a}; (void)hipLaunchCooperativeKernel((const void*)mega_fwd<0>, dim3(grid), dim3(512), kargs, LDS_BYTES, stream); }
#endif
#else
    for (int ph = 0; ph < N_PHASES; ++ph) { a.ph_lo = ph; a.ph_hi = ph + 1; void* kargs[] = {&a};
        hipError_t e = hipLaunchCooperativeKernel((const void*)mega_fwd<1>, dim3(grid), dim3(512), kargs, LDS_BYTES, stream);
        if (e != hipSuccess) { fprintf(stderr, "launch %d failed: %s\n", ph, hipGetErrorString(e)); break; }
        if (ph >= 1 && ph < N_PHASES - 1 && (ph - 1) % PH_PER_LAYER == 8) { e = hipLaunchCooperativeKernel((const void*)mega_fwd<2>, dim3(grid), dim3(512), kargs, LDS_BYTES, stream);
            if (e != hipSuccess) { fprintf(stderr, "attn launch %d failed: %s\n", ph, hipGetErrorString(e)); break; } } }
#endif
}
```

```cpp
#include <hip/hip_runtime.h>
#include <hip/hip_cooperative_groups.h>
#include <hip/hip_bf16.h>
#include <cstdint>
#include <cstdio>
#include <cmath>
namespace cg = cooperative_groups;

#ifndef MK_ONE_LAUNCH
#define MK_ONE_LAUNCH 1
#endif

constexpr int NB = 4, NLAT = 8192, NCTX = 256, SA = NLAT + NCTX  , T = NB * SA  , DM = 1024, DEPTH = 2;
constexpr int NCH = SA / 128;
constexpr int N1 = 4352, N1W = 4608  , NGATE = 3072, HID = 4096, INDIM = 7440, MODW = 6144;
constexpr float EPS = 1e-6f;
constexpr float QC2 = 0.125f * 1.4426950408889634f;

constexpr size_t KiB = 1024, MiB = 1u << 20;
constexpr size_t OFF_MOD = 0;
constexpr size_t OFF_DT = 256 * KiB;
constexpr size_t OFF_G = OFF_DT + 2304 * KiB;
constexpr size_t OFF_CD = OFF_G + 2304 * KiB;
constexpr size_t OFF_SSQ = OFF_CD + 64 * KiB;
constexpr size_t OFF_ATAB = 6 * MiB;
constexpr size_t OFF_RTAB = 8 * MiB;
constexpr size_t OFF_HCTX = 16 * MiB;
constexpr size_t OFF_W = 20 * MiB;
constexpr size_t W_LAYER = 36 * MiB, W_P = 0, W_G = 9 * MiB, W_B = 15 * MiB, W_O = 18 * MiB, W_1 = 20 * MiB, W_2 = 28 * MiB;
constexpr size_t OFF_U = 92 * MiB;
constexpr size_t SZ512 = (size_t)T * 512 * 2;
constexpr size_t OFF_Q = 158 * MiB, OFF_Z = OFF_Q + SZ512, OFF_RG = OFF_Z + SZ512, OFF_KV = OFF_RG + SZ512;
constexpr size_t OFF_XBC = OFF_KV + SZ512 / 2, OFF_ST = OFF_XBC, OFF_CONV = OFF_XBC + 2 * SZ512;
constexpr size_t OFF_RQ = OFF_CONV + 2 * SZ512, OFF_RK = OFF_RQ + SZ512, OFF_RV = OFF_RK + SZ512, OFF_END = OFF_RV + SZ512;
constexpr size_t OFF_GATE = OFF_KV;
constexpr size_t OFF_HID = OFF_Q;
static_assert(OFF_END <= 512 * MiB, "ws map");
static_assert(OFF_GATE + (size_t)T * 3072 * 2 <= OFF_END && OFF_HID + (size_t)T * 4096 * 2 <= OFF_END, "overlays");
static_assert(OFF_SSQ + (size_t)T * 8 * 4 <= OFF_ATAB && OFF_RTAB + 8448 * 64 * 8 <= OFF_HCTX, "misc map");

constexpr int LDS_BYTES = 155648;

typedef unsigned short bf16_t;
__device__ __forceinline__ unsigned f2bf(float f) { unsigned u = __builtin_bit_cast(unsigned, f); return (u + 0x7fffu + ((u >> 16) & 1u)) >> 16; }
__device__ __forceinline__ unsigned pk2(float lo, float hi) { return f2bf(lo) | (f2bf(hi) << 16); }
__device__ __forceinline__ float bf2f(unsigned h) { return __builtin_bit_cast(float, h << 16); }
__device__ __forceinline__ float siluf(float x) { return x * __builtin_amdgcn_rcpf(1.f + __expf(-x)); }

__device__ __forceinline__ float shx(float v, int m, int lane) { return __builtin_bit_cast(float, __builtin_amdgcn_ds_bpermute((lane ^ m) << 2, __builtin_bit_cast(int, v))); }

namespace pg8 {
#define PG8_LAS __attribute__((address_space(3)))
typedef unsigned short bf16_t;
typedef short bf16x8 __attribute__((ext_vector_type(8)));
typedef float f32x4 __attribute__((ext_vector_type(4)));
typedef unsigned u32x4 __attribute__((ext_vector_type(4)));
constexpr int BM = 256, BK = 64, HALF = 128, HTB = HALF * BK * 2  , STAGE_BYTES = 8 * HTB, NXCD = 8, WGM = 8;

__host__ __device__ __forceinline__ int lds_byte(int r, int c) { const int st = (r >> 4) * 2 + (c >> 5), rr = r & 15, cc = c & 31, ob = rr * 64 + cc * 2; return st * 1024 + (ob ^ (((ob >> 9) & 1) << 5)); }
__host__ __device__ __forceinline__ void stage_rc(int b, int& R, int& C) { const int st = b / 1024, sb = b % 1024, swz = sb ^ (((sb >> 9) & 1) << 5); R = (st >> 1) * 16 + swz / 64; C = (st & 1) * 32 + (swz % 64) / 2; }
__host__ __device__ __forceinline__ int perm32(int rho) { const int n = rho >> 4, i = rho & 15; return 8 * (i >> 2) + 4 * n + (i & 3); }

struct Unit { int pm, pn, sel; };
struct Gemm { const bf16_t* A; const bf16_t* Bt; size_t strideA, strideB; int M, N, K, ld, packA, packB;
    __device__ __forceinline__ const char* a(int s) const { return (const char*)A + (size_t)s * strideA; }
    __device__ __forceinline__ const char* b(int s) const { return (const char*)Bt + (size_t)s * strideB; } };

struct StaticOrder {
    int nM, nN, nwg, G, c, skipctx;
    __device__ __forceinline__ void init(int M, int N, int G_, int c_, int skip_ = 0) { nM = M / BM; if (skip_) nM = 128; nN = N / BM; nwg = nM * nN; G = G_; c = c_; skipctx = skip_; }
    __device__ __forceinline__ bool tile(long L, Unit& u) const {
        if (L >= nwg) return false;
        int wgid = (int)L; { const int q = nwg / NXCD, r = nwg % NXCD, xcd = wgid % NXCD, off = wgid / NXCD; wgid = (xcd < r ? xcd * (q + 1) : r * (q + 1) + (xcd - r) * q) + off; }
        const int nig = WGM * nN, gid = wgid / nig, fm = gid * WGM, gsz = (nM - fm) < WGM ? (nM - fm) : WGM;
        u.pm = fm + ((wgid % nig) % gsz); if (skipctx) u.pm += (u.pm >> 5) + 1; u.pn = (wgid % nig) / gsz; u.sel = 0; return true;
    }
    __device__ __forceinline__ bool next(int i, Unit& u) const { return tile((long)i * G + c, u); }
    __device__ __forceinline__ void a_ready(const Unit&) const {}
};
struct MergeOrder {
    StaticOrder S;
    __device__ __forceinline__ bool next(int i, Unit& u) const { const int t = i / 3; if (!S.tile((long)t * S.G + S.c, u)) return false; u.sel = i - 3 * t; return true; }
    __device__ __forceinline__ void a_ready(const Unit&) const {}
};


struct CtxSplitOrder {
    int parts, G, c;
    __device__ __forceinline__ bool next(int i, Unit& u) const { const int L = i * G + c; if (L >= 16 * parts) return false; const int t = L & 15; u.pm = 33 * (t >> 2); u.pn = t & 3; u.sel = L >> 4; return true; }
    __device__ __forceinline__ void a_ready(const Unit&) const {}
};
typedef float f32x2 __attribute__((ext_vector_type(2)));
typedef unsigned u32x2 __attribute__((ext_vector_type(2)));

template <int ACT  > struct EpiBf16 {
    static constexpr bool PERM = true;
    bf16_t* O; int ldc, pack;
    __device__ __forceinline__ bool keep(const Unit&) const { return false; }
    __device__ __forceinline__ void operator()(f32x4 (&acc)[2][2][4][2], const Unit& u, int wr, int wc, int fr, int fq) const {
        const int row0 = u.pm * BM + wr * 64 + fr, col0 = u.pn * BM + wc * 32 + 8 * fq;
#pragma unroll
        for (int ai = 0; ai < 2; ++ai)
#pragma unroll
            for (int m = 0; m < 4; ++m) { const int rr = wr * 64 + fr + ai * HALF + m * 16;
                bf16_t* rowp = pack ? O + (((size_t)u.pm * (ldc >> 6) + (col0 >> 6)) * 256 + rr) * 64 + (col0 & 63) : O + (size_t)(row0 + ai * HALF + m * 16) * ldc + col0;
#pragma unroll
                for (int bj = 0; bj < 2; ++bj) { f32x4 v0 = acc[ai][bj][m][0], v1 = acc[ai][bj][m][1];
#pragma unroll
                    for (int e = 0; e < 4; ++e) {
                        if (ACT == 1) { float a = fmaxf(v0[e], 0.f), b = fmaxf(v1[e], 0.f); v0[e] = a * a; v1[e] = b * b; }
                        if (ACT == 2) { float a = fminf(fmaxf(v0[e], -30.f), 30.f), b = fminf(fmaxf(v1[e], -30.f), 30.f); v0[e] = __builtin_amdgcn_rcpf(1.f + __expf(-a)); v1[e] = __builtin_amdgcn_rcpf(1.f + __expf(-b)); } }
                    u32x4 w; w.x = pk2(v0[0], v0[1]); w.y = pk2(v0[2], v0[3]); w.z = pk2(v1[0], v1[1]); w.w = pk2(v1[2], v1[3]);
                    *(u32x4*)(rowp + (pack ? bj * (2 * 256 * 64) : bj * HALF)) = w; } }
    }
};

struct EpiResid {
    static constexpr bool PERM = true;
    const float* base_lat; const float* base_ctx; float* out_lat; float* out_ctx; const float* gate;
    __device__ __forceinline__ bool keep(const Unit&) const { return false; }
    __device__ __forceinline__ void operator()(f32x4 (&acc)[2][2][4][2], const Unit& u, int wr, int wc, int fr, int fq) const {
        const int b = u.pm / 33, j = u.pm % 33; const bool isctx = (j == 0);
        const float* gv = gate + (size_t)(isctx ? 4 : b) * MODW;
        const int col0 = u.pn * BM + wc * 32 + 8 * fq;
        f32x4 g[2][2];
#pragma unroll
        for (int bj = 0; bj < 2; ++bj) { g[bj][0] = *(const f32x4*)(gv + col0 + bj * HALF); g[bj][1] = *(const f32x4*)(gv + col0 + bj * HALF + 4); }
        const size_t rbase = isctx ? (size_t)(b * NCTX) : (size_t)(b * NLAT + (j - 1) * 256);
        const float* bp = isctx ? base_ctx : base_lat; float* op = isctx ? out_ctx : out_lat;
#pragma unroll
        for (int ai = 0; ai < 2; ++ai)
#pragma unroll
            for (int m = 0; m < 4; ++m) { const size_t off = (rbase + ai * HALF + wr * 64 + m * 16 + fr) * DM + col0;
#pragma unroll
                for (int bj = 0; bj < 2; ++bj)
#pragma unroll
                    for (int n = 0; n < 2; ++n) { const f32x4 bs = *(const f32x4*)(bp + off + bj * HALF + 4 * n);
                        *(f32x4*)(op + off + bj * HALF + 4 * n) = bs + g[bj][n] * acc[ai][bj][m][n]; } }
    }
};


struct EpiPartial {
    static constexpr bool PERM = true;
    float* part;
    __device__ __forceinline__ bool keep(const Unit&) const { return false; }
    __device__ __forceinline__ void operator()(f32x4 (&acc)[2][2][4][2], const Unit& u, int wr, int wc, int fr, int fq) const {
        { unsigned m_ = ~0u; asm volatile("" : "+s"(m_)); const int ln = (int)__builtin_amdgcn_mbcnt_hi(m_, __builtin_amdgcn_mbcnt_lo(m_, 0u)); fr = ln & 15; fq = ln >> 4; }
        const int b = u.pm / 33; const int col0 = u.pn * BM + wc * 32 + 8 * fq;
        float* pb = part + (size_t)u.sel * (NB * NCTX) * DM;
#pragma unroll
        for (int ai = 0; ai < 2; ++ai)
#pragma unroll
            for (int m = 0; m < 4; ++m) { float* p = pb + ((size_t)(b * NCTX) + ai * HALF + wr * 64 + m * 16 + fr) * DM + col0;
#pragma unroll
                for (int bj = 0; bj < 2; ++bj)
#pragma unroll
                    for (int n = 0; n < 2; ++n) *(f32x4*)(p + bj * HALF + 4 * n) = acc[ai][bj][m][n]; }
    }
};

struct EpiMerge {
    static constexpr bool PERM = true;
    const bf16_t* G; const float* SSQ; bf16_t* O;
    __device__ __forceinline__ bool keep(const Unit& u) const { return u.sel < 2; }
    __device__ __forceinline__ void operator()(f32x4 (&acc)[2][2][4][2], const Unit& u, int wr, int wc, int fr, int fq) const {
        const int row0 = u.pm * BM + wr * 64 + fr, col0 = u.pn * BM + wc * 32 + 8 * fq; const int sel = u.sel;
#pragma unroll
        for (int ai = 0; ai < 2; ++ai)
#pragma unroll
            for (int m = 0; m < 4; ++m) { const size_t row = (size_t)(row0 + ai * HALF + m * 16);
                const f32x4 q0 = *(const f32x4*)(SSQ + row * 8), q1 = *(const f32x4*)(SSQ + row * 8 + 4);
                const float s1 = rsqrtf(((q0[0] + q0[1]) + (q0[2] + q0[3]) + (q1[0] + q1[1]) + (q1[2] + q1[3])) * (1.f / 512.f) + EPS);
#pragma unroll
                for (int bj = 0; bj < 2; ++bj) { const bf16_t* gp = G + row * NGATE + col0 + bj * HALF;
                    float f[8];
                    if (sel == 0) { const u32x4 a = *(const u32x4*)(gp), b = *(const u32x4*)(gp + 1024);
#pragma unroll
                        for (int t = 0; t < 4; ++t) { f[2 * t] = bf2f(a[t] & 0xffffu) * __builtin_amdgcn_rcpf(s1 * bf2f(b[t] & 0xffffu)); f[2 * t + 1] = bf2f(a[t] >> 16) * __builtin_amdgcn_rcpf(s1 * bf2f(b[t] >> 16)); } }
                    else if (sel == 1) { const u32x4 a = *(const u32x4*)(gp + 1024), b = *(const u32x4*)(gp + 2048);
#pragma unroll
                        for (int t = 0; t < 4; ++t) { f[2 * t] = s1 * bf2f(a[t] & 0xffffu) * __builtin_amdgcn_rcpf(bf2f(b[t] & 0xffffu)); f[2 * t + 1] = s1 * bf2f(a[t] >> 16) * __builtin_amdgcn_rcpf(bf2f(b[t] >> 16)); } }
                    else { const u32x4 a = *(const u32x4*)(gp + 2048);
#pragma unroll
                        for (int t = 0; t < 4; ++t) { f[2 * t] = bf2f(a[t] & 0xffffu); f[2 * t + 1] = bf2f(a[t] >> 16); } }
                    f32x4 v0 = acc[ai][bj][m][0], v1 = acc[ai][bj][m][1];
#pragma unroll
                    for (int e = 0; e < 4; ++e) { v0[e] *= f[e]; v1[e] *= f[4 + e]; }
                    if (sel == 2) { u32x4 w; w.x = pk2(v0[0], v0[1]); w.y = pk2(v0[2], v0[3]); w.z = pk2(v1[0], v1[1]); w.w = pk2(v1[2], v1[3]);
                        *(u32x4*)(O + row * DM + col0 + bj * HALF) = w; }
                    else { acc[ai][bj][m][0] = v0; acc[ai][bj][m][1] = v1; } } }
    }
};
struct EpiInProj {
    static constexpr bool PERM = true;
    unsigned char* ws; float* DT;
    const float *qnw, *knw, *dtb; const f32x2 *atab, *rtab;
    __device__ __forceinline__ bool keep(const Unit&) const { return false; }
    __device__ __forceinline__ void store8(bf16_t* p, const float* v) const { u32x4 w; w.x = pk2(v[0], v[1]); w.y = pk2(v[2], v[3]); w.z = pk2(v[4], v[5]); w.w = pk2(v[6], v[7]); *(u32x4*)p = w; }
    __device__ __forceinline__ void operator()(f32x4 (&acc)[2][2][4][2], const Unit& u, int wr, int wc, int fr, int fq) const {
        const int pn = u.pn, j = u.pm % 33; const bool isctx = (j == 0);
        const int rowt = u.pm * BM + wr * 64 + fr, post = j * 256 + wr * 64 + fr;
        if (pn <= 2) {
            const bool isv = (pn == 2 && wc >= 2), isk = (pn == 2 && wc < 2);
            const float* nw = isk ? knw : qnw;
#pragma unroll
            for (int ai = 0; ai < 2; ++ai)
#pragma unroll
                for (int m = 0; m < 4; ++m) {
                    const size_t row = (size_t)(rowt + ai * HALF + m * 16); const int pos = post + ai * HALF + m * 16;
                    float v[2][8];
#pragma unroll
                    for (int bj = 0; bj < 2; ++bj)
#pragma unroll
                        for (int t = 0; t < 8; ++t) v[bj][t] = acc[ai][bj][m][t >> 2][t & 3];
                    if (!isv) {
                        float ss = 0.f;
#pragma unroll
                        for (int bj = 0; bj < 2; ++bj)
#pragma unroll
                            for (int t = 0; t < 8; ++t) ss += v[bj][t] * v[bj][t];
                        ss += shx(ss, 16, fq * 16 + fr); ss += shx(ss, 32, fq * 16 + fr);
                        const float rstd = rsqrtf(ss * (1.f / 64.f) + EPS);
#pragma unroll
                        for (int bj = 0; bj < 2; ++bj) { const f32x4 wa = *(const f32x4*)(nw + 32 * bj + 8 * fq), wb = *(const f32x4*)(nw + 32 * bj + 8 * fq + 4);
#pragma unroll
                            for (int t = 0; t < 4; ++t) { v[bj][t] = v[bj][t] * rstd * wa[t]; v[bj][4 + t] = v[bj][4 + t] * rstd * wb[t]; } }
                        if (!isctx) {
                            const f32x4* tp = (const f32x4*)(atab + (size_t)(pos - NCTX) * 32 + 8 * fq);
#pragma unroll
                            for (int t2 = 0; t2 < 4; ++t2) { const f32x4 cs = tp[t2];
                                { const float x1 = v[0][2 * t2], x2 = v[1][2 * t2]; v[0][2 * t2] = x1 * cs[0] - x2 * cs[1]; v[1][2 * t2] = x1 * cs[1] + x2 * cs[0]; }
                                { const float x1 = v[0][2 * t2 + 1], x2 = v[1][2 * t2 + 1]; v[0][2 * t2 + 1] = x1 * cs[2] - x2 * cs[3]; v[1][2 * t2 + 1] = x1 * cs[3] + x2 * cs[2]; } }
                        }
                        if (pn < 2) {
#pragma unroll
                            for (int bj = 0; bj < 2; ++bj)
#pragma unroll
                                for (int t = 0; t < 8; ++t) v[bj][t] *= QC2;
                        }
                    }
                    const size_t doff = (pn < 2) ? OFF_Q + (row * 512 + 64 * (4 * pn + wc) + 8 * fq) * 2
                                                 : OFF_KV + (row * 256 + (isk ? 64 * wc : 128 + 64 * (wc - 2)) + 8 * fq) * 2;
                    bf16_t* dst = (bf16_t*)(ws + doff);
                    store8(dst, v[0]); store8(dst + 32, v[1]);
                    asm volatile("" ::: "memory");
                }
        } else if (pn >= 9 && pn <= 12) {
            const bool isk = pn >= 11; const int head = 2 * ((pn - 9) & 1) + (wc >> 1);
            bf16_t* dbase = (bf16_t*)(ws + (isk ? OFF_RK : OFF_RQ)) + 128 * head + 32 * (wc & 1) + 8 * fq;
            const float sc = isk ? 0.08838834764831845f : 1.f;
#pragma unroll
            for (int ai = 0; ai < 2; ++ai)
#pragma unroll
                for (int m = 0; m < 4; ++m) {
                    const size_t row = (size_t)(rowt + ai * HALF + m * 16); const int pos = post + ai * HALF + m * 16;
                    const f32x4* tp = (const f32x4*)(rtab + (size_t)pos * 64 + 32 * (wc & 1) + 8 * fq);
                    float o1[8], o2[8];
#pragma unroll
                    for (int t2 = 0; t2 < 4; ++t2) { const f32x4 cs = tp[t2];
                        { const int t = 2 * t2; const float x1 = acc[ai][0][m][t >> 2][t & 3], x2 = acc[ai][1][m][t >> 2][t & 3]; o1[t] = (x1 * cs[0] - x2 * cs[1]) * sc; o2[t] = (x1 * cs[1] + x2 * cs[0]) * sc; }
                        { const int t = 2 * t2 + 1; const float x1 = acc[ai][0][m][t >> 2][t & 3], x2 = acc[ai][1][m][t >> 2][t & 3]; o1[t] = (x1 * cs[2] - x2 * cs[3]) * sc; o2[t] = (x1 * cs[3] + x2 * cs[2]) * sc; } }
                    store8(dbase + row * 512, o1); store8(dbase + row * 512 + 64, o2);
                    asm volatile("" ::: "memory");
                }
        } else if (pn == 17) {
            if (wc == 0 && fq < 2) {
                float bb[8];
#pragma unroll
                for (int t = 0; t < 8; ++t) bb[t] = dtb[8 * fq + t];
#pragma unroll
                for (int ai = 0; ai < 2; ++ai)
#pragma unroll
                    for (int m = 0; m < 4; ++m) { const size_t row = (size_t)(rowt + ai * HALF + m * 16); f32x4 o[2];
#pragma unroll
                        for (int t = 0; t < 8; ++t) { const float x = acc[ai][0][m][t >> 2][t & 3] + bb[t]; o[t >> 2][t & 3] = x > 20.f ? x : log1pf(__expf(x)); }
                        *(f32x4*)(DT + row * 16 + 8 * fq) = o[0]; *(f32x4*)(DT + row * 16 + 8 * fq + 4) = o[1]; }
            }
        } else {
            size_t doff; int ld, cb;
            if (pn <= 4) { doff = OFF_Z; ld = 512; cb = (pn - 3) * 256; } else if (pn <= 8) { doff = OFF_XBC; ld = 1024; cb = (pn - 5) * 256; }
            else if (pn <= 14) { doff = OFF_RV; ld = 512; cb = (pn - 13) * 256; } else { doff = OFF_RG; ld = 512; cb = (pn - 15) * 256; }
            bf16_t* dst = (bf16_t*)(ws + doff);
            cb += wc * 32 + 8 * fq;
#pragma unroll
            for (int ai = 0; ai < 2; ++ai)
#pragma unroll
                for (int m = 0; m < 4; ++m) { bf16_t* rowp = dst + (size_t)(rowt + ai * HALF + m * 16) * ld + cb;
#pragma unroll
                    for (int bj = 0; bj < 2; ++bj) { const f32x4 v0 = acc[ai][bj][m][0], v1 = acc[ai][bj][m][1];
                        u32x4 w; w.x = pk2(v0[0], v0[1]); w.y = pk2(v0[2], v0[3]); w.z = pk2(v1[0], v1[1]); w.w = pk2(v1[2], v1[3]);
                        *(u32x4*)(rowp + bj * HALF) = w; } }
        }
    }
};
template <class Epi, class Sched, bool ALIGN_EPI = false, bool SP2 = false>
__device__ __forceinline__ void gemm_phase(PG8_LAS unsigned char* lds, const Gemm g, const Sched& S, const Epi& E, const int tid_in) {
    const int tid = tid_in, wid = __builtin_amdgcn_readfirstlane(tid >> 6), lane = tid & 63, wr = wid >> 2, wc = wid & 3, fr = lane & 15, fq = lane >> 4;
    const int K = g.K, nt = K / BK;
    unsigned voffA[2], voffB[2];
#pragma unroll
    for (int i = 0; i < 2; ++i) { int R, C; stage_rc(tid * 16 + i * 8192, R, C); const int Rb = Epi::PERM ? ((R & ~31) + perm32(R & 31)) : R;
        voffA[i] = (unsigned)(R * (g.packA ? BK : g.ld) + C) * 2u; voffB[i] = (unsigned)(Rb * (g.packB ? BK : g.ld) + C) * 2u; }
    const size_t kstep = g.packA ? (size_t)(BM * BK * 2) : (size_t)(BK * 2), kstepB = g.packB ? (size_t)(BM * BK * 2) : (size_t)(BK * 2);
    const size_t hstep = g.packA ? (size_t)(HALF * BK * 2) : (size_t)HALF * g.ld * 2, hstepB = g.packB ? (size_t)(HALF * BK * 2) : (size_t)HALF * g.ld * 2;
    const size_t tstep = (size_t)BM * g.ld * 2, tstepB = tstep;
    const unsigned ldsw = (unsigned)wid * 1024u;
    const int aoff = lds_byte(wr * 64 + fr, fq * 8), boff = lds_byte(wc * 32 + fr, fq * 8);
#define PG8_SA(b, h) (((b) * 2 + (h)) * HTB)
#define PG8_SB(b, h) ((4 + (b) * 2 + (h)) * HTB)
#define PG8_STAGE(bufoff, gbase, voff) do { _Pragma("unroll") for (int _i = 0; _i < 2; ++_i) \
        __builtin_amdgcn_global_load_lds((const unsigned*)((const char*)(gbase) + (voff)[_i]), (PG8_LAS unsigned*)(lds + (bufoff) + ldsw + _i * 8192), 16, 0, 0); } while (0)
#define PG8_LDA(dst, b, h) do { _Pragma("unroll") for (int m = 0; m < 4; ++m) _Pragma("unroll") for (int k = 0; k < 2; ++k) dst[m][k] = *(const PG8_LAS bf16x8*)(lds + PG8_SA(b, h) + aoff + m * 2048 + k * 1024); } while (0)
#define PG8_LDB(dst, b, h) do { _Pragma("unroll") for (int n = 0; n < 2; ++n) _Pragma("unroll") for (int k = 0; k < 2; ++k) dst[n][k] = *(const PG8_LAS bf16x8*)(lds + PG8_SB(b, h) + boff + n * 2048 + k * 1024); } while (0)
#define PG8_MMA(ai, bj, At, Bt) do { __builtin_amdgcn_s_setprio(1); _Pragma("unroll") for (int m = 0; m < 4; ++m) _Pragma("unroll") for (int n = 0; n < 2; ++n) _Pragma("unroll") for (int k = 0; k < 2; ++k) \
        acc[ai][bj][m][n] = __builtin_amdgcn_mfma_f32_16x16x32_bf16(Bt[n][k], At[m][k], acc[ai][bj][m][n], 0, 0, 0); __builtin_amdgcn_s_setprio(0); } while (0)
#define PG8_WAIT_V(n) asm volatile("s_waitcnt vmcnt(" #n ")" ::: "memory")
#define PG8_WAIT_L(n) asm volatile("s_waitcnt lgkmcnt(" #n ")" ::: "memory")
#define PG8_BAR __builtin_amdgcn_s_barrier()
#define PG8_SCHED __builtin_amdgcn_sched_barrier(0)
    Unit cur, nxt; int ui = 0;
    if (!S.next(0, cur)) return;
    f32x4 acc[2][2][4][2];
#pragma unroll
    for (int a = 0; a < 2; ++a)
#pragma unroll
        for (int b = 0; b < 2; ++b)
#pragma unroll
            for (int m = 0; m < 4; ++m)
#pragma unroll
                for (int n = 0; n < 2; ++n) acc[a][b][m][n] = (f32x4){0.f, 0.f, 0.f, 0.f};
    bf16x8 At[4][2], B0[2][2], B1[2][2];
    const char* cA = g.a(cur.sel) + (size_t)cur.pm * tstep; const char* cB = g.b(cur.sel) + (size_t)cur.pn * tstepB;
    S.a_ready(cur);
    if constexpr (SP2) {
        PG8_STAGE(PG8_SB(0, 0), cB, voffB); PG8_STAGE(PG8_SB(0, 1), cB + hstepB, voffB); PG8_STAGE(PG8_SA(0, 0), cA, voffA); PG8_STAGE(PG8_SA(0, 1), cA + hstep, voffA);
        if (wr == 1) PG8_BAR;
        PG8_WAIT_V(2); PG8_BAR;
        PG8_STAGE(PG8_SB(1, 0), cB + kstepB, voffB); PG8_STAGE(PG8_SA(1, 0), cA + kstep, voffA); PG8_STAGE(PG8_SB(1, 1), cB + hstepB + kstepB, voffB);
        PG8_WAIT_V(6); PG8_BAR;
    } else {
        PG8_STAGE(PG8_SB(0, 0), cB, voffB); PG8_STAGE(PG8_SA(0, 0), cA, voffA); PG8_STAGE(PG8_SB(0, 1), cB + hstepB, voffB); PG8_STAGE(PG8_SA(0, 1), cA + hstep, voffA);
        if (wr == 1) PG8_BAR;
        PG8_WAIT_V(4); PG8_BAR;
        PG8_STAGE(PG8_SB(1, 0), cB + kstepB, voffB); PG8_STAGE(PG8_SA(1, 0), cA + kstep, voffA); PG8_STAGE(PG8_SB(1, 1), cB + hstepB + kstepB, voffB);
        PG8_WAIT_V(6); PG8_BAR;
    }
    for (;;) {
        const bool has_next = S.next(ui + 1, nxt);
        const char* nA = has_next ? g.a(nxt.sel) + (size_t)nxt.pm * tstep : cA; const char* nB = has_next ? g.b(nxt.sel) + (size_t)nxt.pn * tstepB : cB;
        for (int t = 0; t < nt; t += 2) {
            const bool last = (t == nt - 2);
            const char* a1 = cA + (size_t)(t + 1) * kstep;
            const char* a2 = last ? nA : cA + (size_t)(t + 2) * kstep; const char* b2 = last ? nB : cB + (size_t)(t + 2) * kstepB;
            const char* a3 = a2 + kstep; const char* b3 = b2 + kstepB;
            if (last && has_next) S.a_ready(nxt);
            if constexpr (SP2) {
            PG8_LDB(B0, 0, 0); PG8_LDB(B1, 0, 1); PG8_SCHED; PG8_LDA(At, 0, 0); PG8_STAGE(PG8_SA(1, 1), a1 + hstep, voffA);
            PG8_WAIT_V(8); PG8_WAIT_L(0); PG8_BAR; PG8_MMA(0, 0, At, B0); PG8_MMA(0, 1, At, B1); PG8_BAR; PG8_SCHED;
            PG8_LDA(At, 0, 1); PG8_STAGE(PG8_SB(0, 0), b2, voffB); PG8_STAGE(PG8_SB(0, 1), b2 + hstepB, voffB); PG8_STAGE(PG8_SA(0, 0), a2, voffA);
            PG8_WAIT_V(8); PG8_WAIT_L(0); PG8_BAR; PG8_MMA(1, 0, At, B0); PG8_MMA(1, 1, At, B1); PG8_BAR; PG8_SCHED;
            PG8_LDB(B0, 1, 0); PG8_LDB(B1, 1, 1); PG8_SCHED; PG8_LDA(At, 1, 0); PG8_STAGE(PG8_SA(0, 1), a2 + hstep, voffA);
            PG8_WAIT_V(8); PG8_WAIT_L(0); PG8_BAR; PG8_MMA(0, 0, At, B0); PG8_MMA(0, 1, At, B1); PG8_BAR; PG8_SCHED;
            PG8_LDA(At, 1, 1); PG8_STAGE(PG8_SB(1, 0), b3, voffB); PG8_STAGE(PG8_SB(1, 1), b3 + hstepB, voffB); PG8_STAGE(PG8_SA(1, 0), a3, voffA);
            PG8_WAIT_V(8); PG8_WAIT_L(0); PG8_BAR; PG8_MMA(1, 0, At, B0); PG8_MMA(1, 1, At, B1); PG8_BAR; PG8_SCHED;
            } else {
            PG8_LDB(B0, 0, 0); PG8_SCHED; PG8_LDA(At, 0, 0); PG8_STAGE(PG8_SA(1, 1), a1 + hstep, voffA);
            PG8_WAIT_L(8); PG8_BAR; PG8_WAIT_L(0); PG8_MMA(0, 0, At, B0); PG8_BAR; PG8_SCHED;
            PG8_LDB(B1, 0, 1); PG8_STAGE(PG8_SB(0, 0), b2, voffB);
            PG8_BAR; PG8_WAIT_L(0); PG8_MMA(0, 1, At, B1); PG8_BAR;
            PG8_LDA(At, 0, 1); PG8_STAGE(PG8_SA(0, 0), a2, voffA);
            PG8_BAR; PG8_WAIT_L(0); PG8_MMA(1, 0, At, B0); PG8_BAR; PG8_SCHED;
            PG8_STAGE(PG8_SB(0, 1), b2 + hstepB, voffB);
            PG8_WAIT_V(6); PG8_BAR; PG8_MMA(1, 1, At, B1); PG8_BAR;
            PG8_LDB(B0, 1, 0); PG8_SCHED; PG8_LDA(At, 1, 0); PG8_STAGE(PG8_SA(0, 1), a2 + hstep, voffA);
            PG8_WAIT_L(8); PG8_BAR; PG8_WAIT_L(0); PG8_MMA(0, 0, At, B0); PG8_BAR; PG8_SCHED;
            PG8_LDB(B1, 1, 1); PG8_STAGE(PG8_SB(1, 0), b3, voffB);
            PG8_BAR; PG8_WAIT_L(0); PG8_MMA(0, 1, At, B1); PG8_BAR;
            PG8_LDA(At, 1, 1); PG8_STAGE(PG8_SA(1, 0), a3, voffA);
            PG8_BAR; PG8_WAIT_L(0); PG8_MMA(1, 0, At, B0); PG8_BAR; PG8_SCHED;
            PG8_STAGE(PG8_SB(1, 1), b3 + hstepB, voffB);
            PG8_WAIT_V(6); PG8_BAR; PG8_MMA(1, 1, At, B1); PG8_BAR;
            }
        }
        if constexpr (ALIGN_EPI) { if (wr == 0) PG8_BAR; }
        E(acc, cur, wr, wc, fr, fq);
        if (!has_next) break;
        if (!E.keep(cur)) {
#pragma unroll
        for (int a = 0; a < 2; ++a)
#pragma unroll
            for (int b = 0; b < 2; ++b)
#pragma unroll
                for (int m = 0; m < 4; ++m)
#pragma unroll
                    for (int n = 0; n < 2; ++n) acc[a][b][m][n] = (f32x4){0.f, 0.f, 0.f, 0.f}; }
        cur = nxt; cA = nA; cB = nB; ++ui;
        if constexpr (ALIGN_EPI) { if (wr == 1) PG8_BAR; }
    }
    PG8_WAIT_V(0);
    if constexpr (!ALIGN_EPI) { if (wr == 0) PG8_BAR; }
    PG8_BAR;

#undef PG8_SA
#undef PG8_SB
#undef PG8_STAGE
#undef PG8_LDA
#undef PG8_LDB
#undef PG8_MMA
#undef PG8_WAIT_V
#undef PG8_WAIT_L
#undef PG8_BAR
#undef PG8_SCHED
}
}
#include <hip/hip_bf16.h>
namespace attn_body {
using bf16=__hip_bfloat16;
using bf16x8=__attribute__((ext_vector_type(8)))short;
using s16x4=__attribute__((ext_vector_type(4)))short;
using f32x16=__attribute__((ext_vector_type(16)))float;
using u32x4=__attribute__((ext_vector_type(4)))unsigned;
constexpr int BATCH=2,NHEAD=16,SEQ=8192,D=64,DM=NHEAD*D;
constexpr int NW=8,QBLK=32,QB=QBLK*NW,KVBLK=64,NQB=SEQ/QB;
constexpr int ATTN_PITCH=DM, ATTN_UNIT_ROWS=QB;
__device__ __forceinline__ int crow(int r,int hi){return (r&3)+8*(r>>2)+4*hi;}
#define SBAR() __builtin_amdgcn_sched_barrier(0)
constexpr int NSLOT=3, SLOTB=8192;
constexpr int LDS_K=0, LDS_V=NSLOT*SLOTB, LDS_WS=2*NSLOT*SLOTB, LDS_OST=LDS_WS+NW*64*4, LDS_BYTES=LDS_OST+NW*4096;
constexpr float C2=0.125f*1.4426950408889634f;
__device__ __forceinline__ void glds16(const void*gsrc,unsigned lds_dst){unsigned keep;
  asm volatile("s_mov_b32 %0, m0\n\ts_mov_b32 m0, %2\n\ts_nop 0\n\tglobal_load_lds_dwordx4 %1, off\n\ts_mov_b32 m0, %0":"=&s"(keep):"v"(gsrc),"s"(lds_dst):"memory");}
__device__ __forceinline__ float max3f(float a,float b,float c){float r;asm("v_max3_f32 %0, %1, %2, %3":"=v"(r):"v"(a),"v"(b),"v"(c));return r;}
__device__ __forceinline__ float max2f(float a,float b){float r;asm("v_max_f32_e32 %0, %1, %2":"=v"(r):"v"(a),"v"(b));return r;}
__device__ __forceinline__ float fadd_s(float a,float b){float r;asm("v_add_f32_e32 %0, %1, %2":"=v"(r):"v"(a),"v"(b));return r;}
__device__ __forceinline__ float fsub_s(float a,float b){float r;asm("v_sub_f32_e32 %0, %1, %2":"=v"(r):"v"(a),"v"(b));return r;}
typedef float f32x2_t __attribute__((ext_vector_type(2))); typedef __bf16 bf16x2_t __attribute__((ext_vector_type(2)));
__device__ __forceinline__ unsigned cvtpk_s(float lo,float hi){f32x2_t v={lo,hi};bf16x2_t b=__builtin_convertvector(v,bf16x2_t);return __builtin_bit_cast(unsigned,b);}
#define WAIT_BAR(N) asm volatile("s_waitcnt vmcnt(" #N ") lgkmcnt(0)\n\ts_barrier":::"memory")

__device__ __forceinline__ void qkt(f32x16&p0,f32x16&p1,const char*Kslot,const bf16x8*qr,const f32x16&negm,int r32,int hi){
  const char*kb=Kslot+hi*1024+r32*16;
  #pragma unroll
  for(int d0=0;d0<4;++d0){
    const bf16x8 b0=*reinterpret_cast<const bf16x8*>(kb+d0*2048);
    const bf16x8 b1=*reinterpret_cast<const bf16x8*>(kb+d0*2048+512);
    if(d0==0){p0=__builtin_amdgcn_mfma_f32_32x32x16_bf16(b0,qr[0],negm,0,0,0);p1=__builtin_amdgcn_mfma_f32_32x32x16_bf16(b1,qr[0],negm,0,0,0);}
    else{p0=__builtin_amdgcn_mfma_f32_32x32x16_bf16(b0,qr[d0],p0,0,0,0);p1=__builtin_amdgcn_mfma_f32_32x32x16_bf16(b1,qr[d0],p1,0,0,0);}}
}
typedef __attribute__((address_space(3))) const char* lds_cptr;
typedef short v4i16_t __attribute__((ext_vector_type(4)));
__device__ __forceinline__ void kload8(bf16x8*kf,lds_cptr kp){
  kf[0]=*(const __attribute__((address_space(3))) bf16x8*)(kp);      kf[1]=*(const __attribute__((address_space(3))) bf16x8*)(kp+512);
  kf[2]=*(const __attribute__((address_space(3))) bf16x8*)(kp+2048); kf[3]=*(const __attribute__((address_space(3))) bf16x8*)(kp+2560);
  kf[4]=*(const __attribute__((address_space(3))) bf16x8*)(kp+4096); kf[5]=*(const __attribute__((address_space(3))) bf16x8*)(kp+4608);
  kf[6]=*(const __attribute__((address_space(3))) bf16x8*)(kp+6144); kf[7]=*(const __attribute__((address_space(3))) bf16x8*)(kp+6656);
}
__device__ __forceinline__ void kload2(bf16x8*kf,lds_cptr kp,int j){ kf[2*j]=*(const __attribute__((address_space(3))) bf16x8*)(kp+j*2048); kf[2*j+1]=*(const __attribute__((address_space(3))) bf16x8*)(kp+j*2048+512); }
__device__ __forceinline__ s16x4 vtr(lds_cptr p){ return __builtin_bit_cast(s16x4,__builtin_amdgcn_ds_read_tr16_b64_v4i16((__attribute__((address_space(3))) v4i16_t*)p)); }
__device__ __forceinline__ float rowmax(const f32x16&p0,const f32x16&p1){
  float a=max3f(p0[0],p0[1],p1[0]),b=max3f(p0[2],p0[3],p1[1]);a=max3f(a,p1[2],p1[3]);
  #pragma unroll
  for(int r=4;r<16;r+=4){a=max3f(a,p0[r],p0[r+1]);b=max3f(b,p0[r+2],p0[r+3]);a=max3f(a,p1[r],p1[r+1]);b=max3f(b,p1[r+2],p1[r+3]);}
  const float m=max2f(a,b);
  auto rr=__builtin_amdgcn_permlane32_swap(__float_as_uint(m),__float_as_uint(m),false,false);
  return max2f(__uint_as_float(rr[0]),__uint_as_float(rr[1]));
}
__device__ __forceinline__ void pv(f32x16*o,int vb,bf16x8 pa0,bf16x8 pa1,bf16x8 pa2,bf16x8 pa3){
  #pragma unroll
  for(int d0=0;d0<2;++d0){s16x4 lo[4],hi[4];
    #pragma unroll
    for(int ks=0;ks<4;++ks){
      asm volatile("ds_read_b64_tr_b16 %0,%1 offset:%c2":"=&v"(lo[ks]):"v"(vb),"i"(d0*4096+ks*1024):"memory");
      asm volatile("ds_read_b64_tr_b16 %0,%1 offset:%c2":"=&v"(hi[ks]):"v"(vb),"i"(d0*4096+ks*1024+512):"memory");}
    asm volatile("s_waitcnt lgkmcnt(0)":::"memory");SBAR();
    #define PK(k) (bf16x8){lo[k][0],lo[k][1],lo[k][2],lo[k][3],hi[k][0],hi[k][1],hi[k][2],hi[k][3]}
    o[d0]=__builtin_amdgcn_mfma_f32_32x32x16_bf16(pa0,PK(0),o[d0],0,0,0);
    o[d0]=__builtin_amdgcn_mfma_f32_32x32x16_bf16(pa1,PK(1),o[d0],0,0,0);
    o[d0]=__builtin_amdgcn_mfma_f32_32x32x16_bf16(pa2,PK(2),o[d0],0,0,0);
    o[d0]=__builtin_amdgcn_mfma_f32_32x32x16_bf16(pa3,PK(3),o[d0],0,0,0);
    #undef PK
  }
}
#define ATTN_STORE16(p,v) (*(u32x4*)(p)=(v))
template<int THRL> __device__ __forceinline__ void attn_unit(long qrow0,long krow0,int NT,const bf16*Q,const bf16*__restrict__ K,const bf16*__restrict__ V,bf16*O,char*shm,const int tid_in){
  const int tid=tid_in,lane=tid&63,r32=lane&31,hi=lane>>5; const int wid=__builtin_amdgcn_readfirstlane(tid>>6);
  constexpr int PQ=512,PK=256;
  const bf16*Qw=Q+(qrow0+wid*QBLK)*PQ;
  const bf16*Kh=K+krow0*PK,*Vh=V+krow0*PK;
  const unsigned lds0=(unsigned)(uintptr_t)shm;
  float*wsf=(float*)(shm+LDS_WS)+wid*64;
  const bf16*ksrc=Kh+(long)lane*PK+wid*8;
  const bf16*vsrc=Vh+(long)(16*(wid&3)+(lane>>2))*PK+(wid>>2)*32+(lane&3)*8;
  const unsigned kdst=lds0+LDS_K+wid*1024, vdst=lds0+LDS_V+wid*1024;
  #define DMA_K(t,slot) glds16(ksrc+(long)(t)*KVBLK*PK,(unsigned)__builtin_amdgcn_readfirstlane(kdst+(slot)))
  #define DMA_V(t,slot) glds16(vsrc+(long)(t)*KVBLK*PK,(unsigned)__builtin_amdgcn_readfirstlane(vdst+(slot)))
  const int vb0=(int)(lds0+LDS_V)+((lane>>4)&1)*32+(lane&3)*8+(4*hi+((lane&15)>>2))*64;
  const char*Kbase=shm+LDS_K; bf16x8 kf[8];
  const lds_cptr shm3=(lds_cptr)shm; const lds_cptr kp0=shm3+LDS_K+hi*1024+r32*16; const lds_cptr vp0=shm3+LDS_V+((lane>>4)&1)*32+(lane&3)*8+(4*hi+((lane&15)>>2))*64;

  DMA_K(0,0);DMA_V(0,0);DMA_K(1,SLOTB);
  bf16x8 qr[4];
  #pragma unroll
  for(int d0=0;d0<4;++d0)qr[d0]=*reinterpret_cast<const bf16x8*>(&Qw[(long)r32*PQ+d0*16+hi*8]);
  float mhat=0.f,l_reg=0.f;f32x16 o[2];o[0]=f32x16{};o[1]=f32x16{};f32x16 negm=f32x16{};asm volatile("":"+v"(negm));

  #define CMASK(P0,P1,t) do{}while(0)
  bool resc=false;
  #define START(P0,P1) do{ const float rm=rowmax(P0,P1); resc=false; \
    { const float dl=rm; mhat=fadd_s(mhat,dl); \
      _Pragma("unroll") for(int r=0;r<16;++r){P0[r]=fsub_s(P0[r],dl);P1[r]=fsub_s(P1[r],dl);} \
      _Pragma("unroll") for(int r=0;r<16;++r)negm[r]=-mhat; asm volatile("":"+v"(negm)); } \
    _Pragma("unroll") for(int r=0;r<16;++r)P0[r]=__builtin_amdgcn_exp2f(P0[r]); }while(0)
  #define RESC() do{ if(resc){ asm volatile("s_waitcnt lgkmcnt(0)":::"memory"); \
      _Pragma("unroll") for(int d_=0;d_<2;++d_) _Pragma("unroll") for(int r=0;r<16;++r)o[d_][r]*=wsf[crow(r,hi)]; } }while(0)
  f32x16 pA0,pA1,pB0,pB1;
  int sl_prev=0,sl_cur=0,sl_next=SLOTB;
  #define ROT() do{sl_prev=sl_cur;sl_cur=sl_next;sl_next=(sl_next==(NSLOT-1)*SLOTB)?0:sl_next+SLOTB;}while(0)
  DMA_K(2,2*SLOTB);
  WAIT_BAR(3);
  qkt(pA0,pA1,Kbase,qr,negm,r32,hi);asm volatile("s_nop 15\n\ts_nop 7":"+v"(pA0),"+v"(pA1));CMASK(pA0,pA1,0);
  START(pA0,pA1);
  _Pragma("unroll") for(int r=0;r<16;++r)pA1[r]=__builtin_amdgcn_exp2f(pA1[r]);
  WAIT_BAR(0);
  DMA_K(3,0);DMA_V(1,SLOTB);
  ROT();
  kload8(kf,kp0+sl_cur);
  WAIT_BAR(2);
  s16x4 vlo[8],vhi[8]; u32x4 pw0,pw1,pw2,pw3;
  #define PKW(P,B) cvtpk_s(P[B],P[B+1])
  #define PAF(k) __builtin_bit_cast(bf16x8,pw##k)
  #define VFR(i) (bf16x8){vlo[i][0],vlo[i][1],vlo[i][2],vlo[i][3],vhi[i][0],vhi[i][1],vhi[i][2],vhi[i][3]}
  #define PIN(x) asm volatile("":"+v"(x))
  #define MX3(a,b,c) __builtin_fmaxf(__builtin_fmaxf((a),(b)),(c))
  #define GAPA(MF,A0,A1,A2,A3,W0,W1,PW) do{ MF; sacc+=A0; sacc+=A1; sacc+=A2; sacc+=A3; PIN(sacc); W0; W1; PIN(PW); SBAR(); }while(0)
  #define EX(v) __builtin_amdgcn_exp2f(v)
  #define GAPB(MF,X,B) do{ MF; X[B]=EX(X[B]); X[B+1]=EX(X[B+1]); X[B+2]=EX(X[B+2]); X[B+3]=EX(X[B+3]); PIN(X); SBAR(); }while(0)
  #define VRD(i) do{ vlo[i]=vtr(vp_+(((i)>>2)*4096+((i)&3)*1024)); vhi[i]=vtr(vp_+(((i)>>2)*4096+((i)&3)*1024+512)); }while(0)
  #define KRD(G,j) do{ if(G){ kload2(kf,kp0+sl_next,j); SBAR(); } }while(0)
  #define STEP(C0,C1,P0,P1,t,GK,GV,GL) do{ SBAR(); \
    const lds_cptr vp_=vp0+sl_prev; \
    VRD(0); SBAR(); float sacc=(P0[0]+P0[1]); \
    GAPA(C0=__builtin_amdgcn_mfma_f32_32x32x16_bf16(kf[0],qr[0],negm,0,0,0), P0[2],P0[3],P0[4],P0[5],     pw0[0]=PKW(P0,0), pw0[1]=PKW(P0,2), pw0); \
    VRD(4); SBAR(); GAPA(C1=__builtin_amdgcn_mfma_f32_32x32x16_bf16(kf[1],qr[0],negm,0,0,0), P0[6],P0[7],P0[8],P0[9],     pw0[2]=PKW(P0,4), pw0[3]=PKW(P0,6), pw0); \
    VRD(1); SBAR(); GAPA(C0=__builtin_amdgcn_mfma_f32_32x32x16_bf16(kf[2],qr[1],C0,0,0,0),   P0[10],P0[11],P0[12],P0[13], pw1[0]=PKW(P0,8), pw1[1]=PKW(P0,10), pw1); \
    VRD(5); SBAR(); GAPA(C1=__builtin_amdgcn_mfma_f32_32x32x16_bf16(kf[3],qr[1],C1,0,0,0),   P0[14],P0[15],P1[0],P1[1],   pw1[2]=PKW(P0,12),pw1[3]=PKW(P0,14), pw1); \
    VRD(2); SBAR(); GAPA(C0=__builtin_amdgcn_mfma_f32_32x32x16_bf16(kf[4],qr[2],C0,0,0,0),   P1[2],P1[3],P1[4],P1[5],     pw2[0]=PKW(P1,0), pw2[1]=PKW(P1,2), pw2); \
    VRD(6); SBAR(); GAPA(C1=__builtin_amdgcn_mfma_f32_32x32x16_bf16(kf[5],qr[2],C1,0,0,0),   P1[6],P1[7],P1[8],P1[9],     pw2[2]=PKW(P1,4), pw2[3]=PKW(P1,6), pw2); \
    VRD(3); SBAR(); GAPA(C0=__builtin_amdgcn_mfma_f32_32x32x16_bf16(kf[6],qr[3],C0,0,0,0),   P1[10],P1[11],P1[12],P1[13], pw3[0]=PKW(P1,8), pw3[1]=PKW(P1,10), pw3); \
    VRD(7); SBAR(); GAPA(C1=__builtin_amdgcn_mfma_f32_32x32x16_bf16(kf[7],qr[3],C1,0,0,0),   P1[14],P1[15],0.f,0.f,       pw3[2]=PKW(P1,12),pw3[3]=PKW(P1,14), pw3); \
    l_reg+=sacc; \
    if(GK){DMA_K((t)+3,sl_cur);} if(GV){DMA_V((t)+1,sl_next);} \
    CMASK(C0,C1,t); \
    { float a=MX3(C0[0],C0[1],C1[0]),b=MX3(C0[2],C0[3],C1[1]); a=MX3(a,C1[2],C1[3]); \
      _Pragma("unroll") for(int r=4;r<16;r+=4){a=MX3(a,C0[r],C0[r+1]);b=MX3(b,C0[r+2],C0[r+3]);a=MX3(a,C1[r],C1[r+1]);b=MX3(b,C1[r+2],C1[r+3]);} \
      float rm=__builtin_fmaxf(a,b); { auto rr=__builtin_amdgcn_permlane32_swap(__float_as_uint(rm),__float_as_uint(rm),false,false); rm=__builtin_fmaxf(__uint_as_float(rr[0]),__uint_as_float(rr[1])); } \
      resc=false; \
      if(__builtin_expect(__any(rm>(float)THRL),0)){ const float dl=__builtin_fmaxf(rm,0.f); mhat+=dl; \
        _Pragma("unroll") for(int r=0;r<16;++r){C0[r]-=dl;C1[r]-=dl;} \
        _Pragma("unroll") for(int r=0;r<16;++r)negm[r]=-mhat; asm volatile("":"+v"(negm)); \
        const float f=__builtin_amdgcn_exp2f(-dl); l_reg*=f; if(hi==0)wsf[r32]=f; resc=true; } } \
    SBAR(); \
    GAPB(o[0]=__builtin_amdgcn_mfma_f32_32x32x16_bf16(PAF(0),VFR(0),o[0],0,0,0), C0,0); \
    GAPB(o[1]=__builtin_amdgcn_mfma_f32_32x32x16_bf16(PAF(0),VFR(4),o[1],0,0,0), C0,4); \
    KRD(GL,0); GAPB(o[0]=__builtin_amdgcn_mfma_f32_32x32x16_bf16(PAF(1),VFR(1),o[0],0,0,0), C0,8); \
    KRD(GL,1); GAPB(o[1]=__builtin_amdgcn_mfma_f32_32x32x16_bf16(PAF(1),VFR(5),o[1],0,0,0), C0,12); \
    KRD(GL,2); GAPB(o[0]=__builtin_amdgcn_mfma_f32_32x32x16_bf16(PAF(2),VFR(2),o[0],0,0,0), C1,0); \
    KRD(GL,3); GAPB(o[1]=__builtin_amdgcn_mfma_f32_32x32x16_bf16(PAF(2),VFR(6),o[1],0,0,0), C1,4); \
    GAPB(o[0]=__builtin_amdgcn_mfma_f32_32x32x16_bf16(PAF(3),VFR(3),o[0],0,0,0), C1,8); \
    GAPB(o[1]=__builtin_amdgcn_mfma_f32_32x32x16_bf16(PAF(3),VFR(7),o[1],0,0,0), C1,12); \
    }while(0)
  int t=1;
  #undef CMASK
  #define CMASK(P0,P1,t) do{}while(0)
  for(;t+5<NT;t+=2){
    STEP(pB0,pB1,pA0,pA1,t,true,true,true);     WAIT_BAR(2); RESC(); ROT();
    STEP(pA0,pA1,pB0,pB1,t+1,true,true,true);   WAIT_BAR(2); RESC(); ROT();
  }
  #undef CMASK
  #define CMASK(P0,P1,t) do{}while(0)
  #define ENDW(tt) do{ if((tt)+3<NT){WAIT_BAR(2);} else if((tt)+2<NT){WAIT_BAR(1);} else {WAIT_BAR(0);} }while(0)
  for(;t+1<NT;t+=2){
    STEP(pB0,pB1,pA0,pA1,t,(t+3<NT),(t+1<NT),(t+1<NT));       ENDW(t);   RESC(); ROT();
    STEP(pA0,pA1,pB0,pB1,t+1,(t+4<NT),(t+2<NT),(t+2<NT));     ENDW(t+1); RESC(); ROT();
  }
  STEP(pB0,pB1,pA0,pA1,NT-1,false,false,false); RESC();
  { float sacc=pB0[0]+pB0[1]; _Pragma("unroll") for(int r=2;r<16;++r)sacc+=pB0[r]; _Pragma("unroll") for(int r=0;r<16;++r)sacc+=pB1[r]; l_reg+=sacc;
    pw0=(u32x4){PKW(pB0,0),PKW(pB0,2),PKW(pB0,4),PKW(pB0,6)};pw1=(u32x4){PKW(pB0,8),PKW(pB0,10),PKW(pB0,12),PKW(pB0,14)};pw2=(u32x4){PKW(pB1,0),PKW(pB1,2),PKW(pB1,4),PKW(pB1,6)};pw3=(u32x4){PKW(pB1,8),PKW(pB1,10),PKW(pB1,12),PKW(pB1,14)};
    SBAR(); pv(o,vb0+sl_cur,PAF(0),PAF(1),PAF(2),PAF(3)); }
  #undef PKW
  #undef PAF
  #undef VFR
  #undef PIN
  #undef MX3
  #undef GAPA
  #undef GAPB
  #undef EX
  #undef VRD
  #undef KRD
  #undef STEP
  #undef ENDW
  {auto rr=__builtin_amdgcn_permlane32_swap(__float_as_uint(l_reg),__float_as_uint(l_reg),false,false);l_reg=__uint_as_float(rr[0])+__uint_as_float(rr[1]);}
  if(hi==0)wsf[32+r32]=l_reg;asm volatile("s_waitcnt lgkmcnt(0)":::"memory");
  float rli[16];
  #pragma unroll
  for(int r=0;r<16;++r)rli[r]=__builtin_amdgcn_rcpf(wsf[32+crow(r,hi)]);
  bf16*Ow=O+(qrow0+wid*QBLK)*PQ;
  { bf16*stg=(bf16*)(shm+LDS_OST)+wid*2048;
    #pragma unroll
    for(int r=0;r<16;++r){const int orow=crow(r,hi);
      #pragma unroll
      for(int d0=0;d0<2;++d0)stg[orow*64+d0*32+r32]=__float2bfloat16(o[d0][r]*rli[r]);}
    asm volatile("s_waitcnt lgkmcnt(0)":::"memory");
    #pragma unroll
    for(int i=0;i<4;++i){const int row=i*8+(lane>>3),ch=lane&7; const u32x4 v=*(const u32x4*)(stg+row*64+ch*8); ATTN_STORE16(Ow+(long)row*PQ+ch*8,v);} }
  asm volatile("s_waitcnt lgkmcnt(0)\n\ts_barrier":::"memory");
  #undef DMA_K
  #undef DMA_V
  #undef CMASK
  #undef START
  #undef RESC
  #undef ROT
}
#undef SBAR
#undef WAIT_BAR
}
#define LAS __attribute__((address_space(3)))
typedef short bf16x8 __attribute__((ext_vector_type(8)));
typedef float f32x4 __attribute__((ext_vector_type(4)));
typedef float f32x2 __attribute__((ext_vector_type(2)));
typedef unsigned u32x4 __attribute__((ext_vector_type(4)));
typedef unsigned u32x2 __attribute__((ext_vector_type(2)));

struct Args {
    const float* in[24]; float* out; unsigned char* ws; int ph_lo, ph_hi;
};

__device__ __forceinline__ float wave_sum(float v, int lane) {
#pragma unroll
    for (int o = 1; o < 64; o <<= 1) v += shx(v, o, lane);
    return v;
}

__device__ __forceinline__ void transpose_item(const float* W, int ldw, int k0, int src0, int nvalid, bf16_t* WT, int K, int dst0, const float* kscale, LAS float* scr, int lane) {
#pragma unroll
    for (int i = 0; i < 32; ++i) { const int kk = 2 * i + (lane >> 5), c = lane & 31;
        float v = (c < nvalid) ? W[(size_t)(k0 + kk) * ldw + src0 + c] : 0.f; if (kscale) v *= kscale[k0 + kk];
        scr[kk * 33 + c] = v; }
    asm volatile("s_waitcnt lgkmcnt(0)" ::: "memory");
    const int c = lane & 7;
#pragma unroll
    for (int j = 0; j < 4; ++j) { const int n = (lane >> 3) + 8 * j; const LAS float* s = scr + (8 * c) * 33 + n;
        u32x4 o; o.x = pk2(s[0 * 33], s[1 * 33]); o.y = pk2(s[2 * 33], s[3 * 33]); o.z = pk2(s[4 * 33], s[5 * 33]); o.w = pk2(s[6 * 33], s[7 * 33]);
        const int row = dst0 + n; *(u32x4*)(WT + ((((size_t)(row >> 8) * (K >> 6) + (k0 >> 6)) * 256 + (row & 255)) * 64) + 8 * c) = o; }
    asm volatile("s_waitcnt lgkmcnt(0)" ::: "memory");
}
__device__ __forceinline__ int inproj_src(int lam0, int& nvalid) {
    nvalid = 32;
    const int t = lam0 >> 8, loc = lam0 & 255, bj = loc >> 7, wc = (loc >> 5) & 3;
    if (t < 2) return 64 * (4 * t + wc) + 32 * bj;
    if (t == 2) return wc < 2 ? 512 + 64 * wc + 32 * bj : 640 + 64 * (wc - 2) + 32 * bj;
    if (t < 9) return lam0;
    if (t < 13) { const int base = t < 11 ? 2320 : 2832, head = 2 * ((t - 9) & 1) + (wc >> 1); return base + 128 * head + 64 * bj + 32 * (wc & 1); }
    if (t < 17) return lam0 + 16;
    if (loc == 0) { nvalid = 16; return 2304; }
    nvalid = 0; return 0;
}

typedef const __attribute__((address_space(4))) Args* CArgsP;
__device__ __forceinline__ void prologue_phase(CArgsP a, LAS unsigned char* lds, int tid, int lane, int wave) {
    unsigned char* ws = a->ws;
    const int G = gridDim.x, gw = blockIdx.x * 8 + wave, NGW = G * 8;
    LAS float* scr = (LAS float*)(lds + wave * 8448);
    constexpr int I1 = 144 * 16, I2 = 96 * 16, I3 = 3 * 32 * 8, I4 = 32 * 16, I5 = 128 * 16, I6 = 32 * 64, IL = I1 + I2 + I3 + I4 + I5 + I6;
    for (int it = gw; it < 2 * IL; it += NGW) {
        const int L = it / IL; int r = it % IL;
        unsigned char* wl = ws + OFF_W + (size_t)L * W_LAYER;
        const float* w_in = a->in[8] + (size_t)L * DM * INDIM;
        if (r < I1) { const int lb = r % 144, kb = r / 144; int nv; const int src = inproj_src(lb * 32, nv);
            transpose_item(w_in, INDIM, kb * 64, src, nv, (bf16_t*)(wl + W_P), DM, lb * 32, nullptr, scr, lane); continue; } r -= I1;
        if (r < I2) { const int lb = r % 96, kb = r / 96;
            transpose_item(w_in, INDIM, kb * 64, 4368 + lb * 32, 32, (bf16_t*)(wl + W_G), DM, lb * 32, nullptr, scr, lane); continue; } r -= I2;
        if (r < I3) { const int i = r / 256, q = r % 256, lb = q % 32, kb = q / 32;
            transpose_item(a->in[19] + ((size_t)L * 3 + i) * 512 * DM, DM, kb * 64, lb * 32, 32, (bf16_t*)(wl + W_B) + (size_t)i * DM * 512, 512, lb * 32,
                           i == 1 ? a->in[16] + L * 512 : nullptr, scr, lane); continue; } r -= I3;
        if (r < I4) { const int lb = r % 32, kb = r / 32;
            transpose_item(a->in[20] + (size_t)L * DM * DM, DM, kb * 64, lb * 32, 32, (bf16_t*)(wl + W_O), DM, lb * 32, nullptr, scr, lane); continue; } r -= I4;
        if (r < I5) { const int lb = r % 128, kb = r / 128;
            transpose_item(a->in[21] + (size_t)L * DM * HID, HID, kb * 64, lb * 32, 32, (bf16_t*)(wl + W_1), DM, lb * 32, nullptr, scr, lane); continue; } r -= I5;
        { const int lb = r % 32, kb = r / 32;
            transpose_item(a->in[22] + (size_t)L * HID * DM, DM, kb * 64, lb * 32, 32, (bf16_t*)(wl + W_2), HID, lb * 32, nullptr, scr, lane); }
    }
    { f32x2* atab = (f32x2*)(ws + OFF_ATAB); f32x2* rtab = (f32x2*)(ws + OFF_RTAB);
      const int gt = blockIdx.x * 512 + tid, NT_ = G * 512;
      for (int i = gt; i < NLAT * 32; i += NT_) { const int p = i >> 5, f = i & 31;
          const float inv = exp2f(-(float)(f & 15) * (13.287712379549449f / 16.f)); const float ang = (float)(f < 16 ? (p >> 6) : (p & 63)) * inv;
          const double rv = (double)ang * 0.15915494309189535; const float fr_ = (float)(rv - __builtin_rint(rv));
          atab[i] = (f32x2){__builtin_amdgcn_cosf(fr_), __builtin_amdgcn_sinf(fr_)}; }
      for (int i = gt; i < SA * 64; i += NT_) { const int p = i >> 6, f = i & 63;
          const float inv = exp2f(-((float)f / 63.f) * 13.287712379549449f); const float ang = (float)p * inv;
          const double rv = (double)ang * 0.15915494309189535; const float fr_ = (float)(rv - __builtin_rint(rv));
          rtab[i] = (f32x2){__builtin_amdgcn_cosf(fr_), __builtin_amdgcn_sinf(fr_)}; } }
    { LAS float* sc = (LAS float*)(lds + 73728);
      LAS float* red = (LAS float*)(lds + 98304);
      __syncthreads();
      for (int i = tid; i < 5 * DM; i += 512) { const int r = i >> 10, k = i & 1023; const float x = r < 4 ? a->in[1][r * DM + k] : a->in[3][k]; sc[i] = siluf(x); }
      __syncthreads();
      float* mod = (float*)(ws + OFF_MOD);
      for (int it = blockIdx.x; it < 2 * 96; it += G) { const int L = it / 96, cb = (it % 96) * 64;
          const float* wm = a->in[4] + (size_t)L * DM * MODW + cb + lane;
          float acc[5] = {0.f, 0.f, 0.f, 0.f, 0.f};
#pragma unroll 32
          for (int k = wave * 128; k < wave * 128 + 128; ++k) { const float wv = wm[(size_t)k * MODW];
#pragma unroll
              for (int r = 0; r < 5; ++r) acc[r] += sc[r * DM + k] * wv; }
#pragma unroll
          for (int r = 0; r < 5; ++r) red[(wave * 5 + r) * 64 + lane] = acc[r];
          __syncthreads();
          if (tid < 320) { const int r = tid >> 6, l = tid & 63; float s = 0.f;
#pragma unroll
              for (int w = 0; w < 8; ++w) s += red[(w * 5 + r) * 64 + l];
              mod[((size_t)L * 5 + r) * MODW + cb + l] = s + a->in[5][L * MODW + cb + l]; }
          __syncthreads();
      } }
}

__device__ __forceinline__ void norm_mod_phase(const float* hlat, const float* hctx, const float* w, const float* modL, int shift_idx, int scale_idx, bf16_t* U, int lane, int wave,
                                               const float* part = nullptr, int nparts = 0, const float* pgate = nullptr, float* wb = nullptr) {
    const int gw = blockIdx.x * 8 + wave, NGW = gridDim.x * 8;
    f32x4 wv[4];
#pragma unroll
    for (int j = 0; j < 4; ++j) wv[j] = *(const f32x4*)(w + 4 * lane + 256 * j);
    for (int row0 = gw; row0 < T; row0 += 2 * NGW) {
        f32x4 v[2][4]; float s[2]; const float* mrow[2]; bool ok[2];
#pragma unroll
        for (int q = 0; q < 2; ++q) { const int row = row0 + q * NGW; ok[q] = row < T; const int rr = ok[q] ? row : row0;
            const int b = rr / SA, pos = rr % SA; const bool isctx = pos < NCTX;
            const float* src = isctx ? hctx + (size_t)(b * NCTX + pos) * DM : hlat + (size_t)(b * NLAT + pos - NCTX) * DM;
            mrow[q] = modL + (size_t)(isctx ? 4 : b) * MODW; s[q] = 0.f;
#pragma unroll
            for (int j = 0; j < 4; ++j) v[q][j] = *(const f32x4*)(src + 4 * lane + 256 * j);
            if (part && isctx) {
                const float* pp = part + (size_t)(b * NCTX + pos) * DM + 4 * lane;
#pragma unroll
                for (int j = 0; j < 4; ++j) { f32x4 acc = {0.f, 0.f, 0.f, 0.f};
                    for (int p = 0; p < nparts; ++p) acc += *(const f32x4*)(pp + (size_t)p * (NB * NCTX) * DM + 256 * j);
                    v[q][j] += *(const f32x4*)(pgate + 4 * lane + 256 * j) * acc;
                    if (wb && ok[q]) *(f32x4*)(wb + (size_t)(b * NCTX + pos) * DM + 4 * lane + 256 * j) = v[q][j]; } } }
#pragma unroll
        for (int q = 0; q < 2; ++q) {
#pragma unroll
            for (int j = 0; j < 4; ++j) s[q] += (v[q][j][0] * v[q][j][0] + v[q][j][1] * v[q][j][1]) + (v[q][j][2] * v[q][j][2] + v[q][j][3] * v[q][j][3]);
            const float rstd = rsqrtf(wave_sum(s[q], lane) * (1.f / DM) + EPS);
            if (ok[q]) {
#pragma unroll
                for (int j = 0; j < 4; ++j) { const f32x4 sh = *(const f32x4*)(mrow[q] + shift_idx * DM + 4 * lane + 256 * j), scl = *(const f32x4*)(mrow[q] + scale_idx * DM + 4 * lane + 256 * j);
                    f32x4 y = v[q][j] * rstd * wv[j]; y = y * (scl + 1.f) + sh;
                    u32x2 o; o.x = pk2(y[0], y[1]); o.y = pk2(y[2], y[3]); *(u32x2*)(U + (size_t)(row0 + q * NGW) * DM + 4 * lane + 256 * j) = o; } } }
    }
}
__device__ __forceinline__ void final_norm_phase(float* hlat, const float* w, int lane, int wave) {
    const int gw = blockIdx.x * 8 + wave, NGW = gridDim.x * 8;
    f32x4 wv[4];
#pragma unroll
    for (int j = 0; j < 4; ++j) wv[j] = *(const f32x4*)(w + 4 * lane + 256 * j);
    for (int row0 = gw; row0 < NB * NLAT; row0 += 2 * NGW) {
        f32x4 v[2][4]; bool ok[2];
#pragma unroll
        for (int q = 0; q < 2; ++q) { const int row = row0 + q * NGW; ok[q] = row < NB * NLAT; const float* src = hlat + (size_t)(ok[q] ? row : row0) * DM;
#pragma unroll
            for (int j = 0; j < 4; ++j) v[q][j] = *(const f32x4*)(src + 4 * lane + 256 * j); }
#pragma unroll
        for (int q = 0; q < 2; ++q) { float s = 0.f;
#pragma unroll
            for (int j = 0; j < 4; ++j) s += (v[q][j][0] * v[q][j][0] + v[q][j][1] * v[q][j][1]) + (v[q][j][2] * v[q][j][2] + v[q][j][3] * v[q][j][3]);
            const float rstd = rsqrtf(wave_sum(s, lane) * (1.f / DM) + EPS);
            if (ok[q]) { float* dst = hlat + (size_t)(row0 + q * NGW) * DM;
#pragma unroll
                for (int j = 0; j < 4; ++j) *(f32x4*)(dst + 4 * lane + 256 * j) = v[q][j] * rstd * wv[j]; } }
    }
}
__device__ __forceinline__ void postproj_phase(const bf16_t* __restrict__ XBC, bf16_t* __restrict__ CONV, const float* cw, const float* cb, float* DT, float* Gc, float* CD, const float* a_log, const bf16_t* U, const bf16_t* Wdt, const float* dtb, int tid, int lane, int wave) {
    const int gw = blockIdx.x * 8 + wave, NGW = gridDim.x * 8;
    f32x4 w0[2][2], w1[2][2], w2[2][2], wb[2][2];
#pragma unroll
    for (int j = 0; j < 2; ++j)
#pragma unroll
        for (int h = 0; h < 2; ++h) { const int c = 8 * (lane + 64 * j) + 4 * h;
            w0[j][h] = *(const f32x4*)(cw + c); w1[j][h] = *(const f32x4*)(cw + 1024 + c); w2[j][h] = *(const f32x4*)(cw + 2048 + c); wb[j][h] = *(const f32x4*)(cb + c); }
#pragma unroll 2
    for (int row = gw; row < T; row += NGW) {
        const int pos = row % SA;
        const bool hasp = (pos != 0 && pos != NCTX), hasn = (pos != NCTX - 1 && pos != SA - 1);
#pragma unroll
        for (int j = 0; j < 2; ++j) { const int c0 = 8 * (lane + 64 * j);
            const bf16_t* p = XBC + (size_t)row * 1024 + c0;
            const u32x4 xc = *(const u32x4*)p; u32x4 xp = {0u, 0u, 0u, 0u}, xn = {0u, 0u, 0u, 0u};
            if (hasp) xp = *(const u32x4*)(p - 1024);
            if (hasn) xn = *(const u32x4*)(p + 1024);
            float o[8];
#pragma unroll
            for (int t = 0; t < 4; ++t) {
#pragma unroll
                for (int hh = 0; hh < 2; ++hh) { const int e = 2 * t + hh;
                    const float a = hh ? bf2f(xp[t] >> 16) : bf2f(xp[t] & 0xffffu), b = hh ? bf2f(xc[t] >> 16) : bf2f(xc[t] & 0xffffu), d = hh ? bf2f(xn[t] >> 16) : bf2f(xn[t] & 0xffffu);
                    const float y = w0[j][e >> 2][e & 3] * a + w1[j][e >> 2][e & 3] * b + w2[j][e >> 2][e & 3] * d + wb[j][e >> 2][e & 3];
                    o[e] = siluf(y); } }
            u32x4 w; w.x = pk2(o[0], o[1]); w.y = pk2(o[2], o[3]); w.z = pk2(o[4], o[5]); w.w = pk2(o[6], o[7]);
            *(u32x4*)(CONV + (size_t)row * 1024 + c0) = w; }
    }
    for (int u = blockIdx.x; u < NB * NCH; u += gridDim.x) {
        {
            const int fr = lane & 15, fq = lane >> 4; const size_t r0 = (size_t)(u / NCH) * SA + 128 * (u % NCH) + 16 * wave;
            const bf16_t* ap = U + (r0 + fr) * DM + 8 * fq; const bf16_t* bp = Wdt + (size_t)fr * 64 + 8 * fq;
            f32x4 acc = {0.f, 0.f, 0.f, 0.f};
#pragma unroll 8
            for (int kk = 0; kk < 32; ++kk) acc = __builtin_amdgcn_mfma_f32_16x16x32_bf16(*(const bf16x8*)(ap + 32 * kk), *(const bf16x8*)(bp + (size_t)(kk >> 1) * (256 * 64) + 32 * (kk & 1)), acc, 0, 0, 0);
            const float bias = dtb[fr];
#pragma unroll
            for (int r = 0; r < 4; ++r) { const float x = acc[r] + bias; DT[(r0 + 4 * fq + r) * 16 + fr] = x > 20.f ? x : log1pf(__expf(x)); }
        }
        __syncthreads();
        if (tid < 16) { const int b = u / NCH, c = u % NCH, dir = tid >> 3, h = tid & 7; const size_t row0 = (size_t)b * SA + 128 * c;
            const float an = -__expf(a_log[tid]); float g = 0.f;
            for (int l0 = 0; l0 < 128; l0 += 64) { float v[64];
#pragma unroll
                for (int j = 0; j < 64; ++j) { const int l = dir ? 127 - (l0 + j) : l0 + j; v[j] = __hip_atomic_load(DT + (row0 + l) * 16 + tid, __ATOMIC_RELAXED, __HIP_MEMORY_SCOPE_AGENT); }
#pragma unroll
                for (int j = 0; j < 64; ++j) { const int l = dir ? 127 - (l0 + j) : l0 + j; g += an * v[j]; Gc[(row0 + l) * 16 + tid] = g; } }
            CD[(((size_t)b * 2 + dir) * NCH + c) * 8 + h] = __expf(g); }
    }
}

constexpr int LP = 136;
struct LinArgs {
    const bf16_t* Qn; const bf16_t* Kn; const bf16_t* Vn; int ld;
    bf16_t* ST;
    const float* Gc; const float* DT; const float* CD;
    const float* rld;
};
__device__ __forceinline__ f32x4 mfma16(bf16x8 a, bf16x8 b, f32x4 c) { return __builtin_amdgcn_mfma_f32_16x16x32_bf16(a, b, c, 0, 0, 0); }

template <bool SSD> __device__ __forceinline__ void lin_gdt(const LinArgs& A, size_t row0, int dir, int h, int s, float& g, float& glast, float& dt) {
    if (SSD) { g = A.Gc[(row0 + s) * 16 + dir * 8 + h]; glast = A.Gc[(row0 + (dir ? 0 : 127)) * 16 + dir * 8 + h]; dt = A.DT[(row0 + s) * 16 + dir * 8 + h]; }
    else { const float lg = -__expf(A.rld[dir * 4 + h]);
        g = (float)(dir ? 128 - s : s + 1) * lg; glast = 128.f * lg; dt = 1.f; }
}
template <bool SCALE> __device__ __forceinline__ void stage_T(LAS bf16_t* dst, const bf16_t* src, int ld, size_t row0, int col0, int ncols, const LAS float* wts, int dvw, int tid) {
    const int nch = ncols >> 3;
    for (int id = tid; id < 128 * nch; id += 512) { const int s = id & 127, q = id >> 7;
        const u32x4 x = *(const u32x4*)(src + (row0 + s) * ld + col0 + 8 * q);
        float wv = 1.f; if (SCALE) wv = wts[((8 * q) / dvw) * 128 + s];
#pragma unroll
        for (int t = 0; t < 4; ++t) { float lo = bf2f(x[t] & 0xffffu), hi = bf2f(x[t] >> 16);
            if (SCALE) { lo *= wv; hi *= wv; dst[(8 * q + 2 * t) * LP + s] = (bf16_t)f2bf(lo); dst[(8 * q + 2 * t + 1) * LP + s] = (bf16_t)f2bf(hi); }
            else { dst[(8 * q + 2 * t) * LP + s] = (bf16_t)(x[t] & 0xffffu); dst[(8 * q + 2 * t + 1) * LP + s] = (bf16_t)(x[t] >> 16); } } }
}
__device__ __forceinline__ void stage_N(LAS bf16_t* dst, const bf16_t* src, int ld, size_t row0, int col0, int tid) {
    for (int id = tid; id < 128 * 16; id += 512) { const int q = id & 15, s = id >> 4;
        *(LAS u32x4*)(dst + s * LP + 8 * q) = *(const u32x4*)(src + (row0 + s) * ld + col0 + 8 * q); }
}

typedef short s16x4_t __attribute__((ext_vector_type(4)));
__device__ __forceinline__ bf16x8 frag_tr(const LAS bf16_t* base, int pitch, int krow0, int ncol0, int fr, int fq) {
    const LAS bf16_t* p = base + (krow0 + 8 * fq + (fr >> 2)) * pitch + ncol0 + 4 * (fr & 3);
    const s16x4_t lo = __builtin_bit_cast(s16x4_t, __builtin_amdgcn_ds_read_tr16_b64_v4i16((LAS s16x4_t*)p));
    const s16x4_t hi = __builtin_bit_cast(s16x4_t, __builtin_amdgcn_ds_read_tr16_b64_v4i16((LAS s16x4_t*)(p + 4 * pitch)));
    return (bf16x8){lo[0], lo[1], lo[2], lo[3], hi[0], hi[1], hi[2], hi[3]};
}
__device__ __forceinline__ void stage_NS(LAS bf16_t* dst, int pitch, const bf16_t* src, int ld, size_t row0, int col0, int ncols, const LAS float* wts, int dvw, int tid) {
    const int nch = ncols >> 3;
    for (int id = tid; id < 128 * nch; id += 512) { const int q = id % nch, s = id / nch;
        const u32x4 x = *(const u32x4*)(src + (row0 + s) * ld + col0 + 8 * q); const float wv = wts[((8 * q) / dvw) * 128 + s]; u32x4 o;
#pragma unroll
        for (int t = 0; t < 4; ++t) o[t] = pk2(bf2f(x[t] & 0xffffu) * wv, bf2f(x[t] >> 16) * wv);
        *(LAS u32x4*)(dst + s * pitch + 8 * q) = o; }
}
__device__ __forceinline__ void stage_NW(LAS bf16_t* dst, int pitch, const bf16_t* src, int ld, size_t row0, int col0, int ncols, int tid) {
    const int nch = ncols >> 3;
    for (int id = tid; id < 128 * nch; id += 512) { const int q = id % nch, s = id / nch;
        *(LAS u32x4*)(dst + s * pitch + 8 * q) = *(const u32x4*)(src + (row0 + s) * ld + col0 + 8 * q); }
}

template <int DV, int NH, bool SSD> __device__ __forceinline__ void lin_s1_phase(const LinArgs& A, LAS unsigned char* lds, int tid, int lane, int wave) {
    constexpr int NHT = SSD ? 8 : 4, NG = NHT / NH, NSLAB = NH * DV / 16 / 8, PV = NH * DV + 8;
    LAS bf16_t* KN = (LAS bf16_t*)lds;
    LAS bf16_t* VN = (LAS bf16_t*)(lds + 128 * LP * 2);
    LAS float* wts = (LAS float*)(lds + 128 * LP * 2 + 128 * PV * 2);
    const int fr = lane & 15, fq = lane >> 4;
    for (int u = blockIdx.x; u < NB * NCH * NG; u += gridDim.x) {
        const int grp = u % NG, c = (u / NG) % NCH, b = u / (NG * NCH); const size_t row0 = (size_t)b * SA + 128 * c;
        __syncthreads();
        for (int e = tid; e < 2 * NH * 128; e += 512) { const int dir = e / (NH * 128), hh = (e >> 7) % NH, s = e & 127; float g, gl, dt;
            lin_gdt<SSD>(A, row0, dir, grp * NH + hh, s, g, gl, dt); wts[e] = dt * __expf(gl - g); }
        stage_NW(KN, LP, A.Kn, A.ld, row0, grp * 128, 128, tid);
        stage_NW(VN, PV, A.Vn, A.ld, row0, grp * NH * DV, NH * DV, tid);
        __syncthreads();
#pragma unroll 1
        for (int dir = 0; dir < 2; ++dir) {
#pragma unroll
            for (int sl = 0; sl < NSLAB; ++sl) { const int slab = wave * NSLAB + sl;
                const int hh = (slab * 16) / DV, v0 = (slab * 16) % DV;
                const LAS float* wp = wts + (dir * NH + hh) * 128 + 8 * fq;
                f32x4 acc[8];
#pragma unroll
                for (int nt = 0; nt < 8; ++nt) acc[nt] = (f32x4){0.f, 0.f, 0.f, 0.f};
#pragma unroll
                for (int kk = 0; kk < 4; ++kk) { const bf16x8 vr = frag_tr(VN, PV, 32 * kk, slab * 16, fr, fq);
                    const f32x4 wa = *(const LAS f32x4*)(wp + 32 * kk), wb = *(const LAS f32x4*)(wp + 32 * kk + 4);
                    u32x4 vw;
#pragma unroll
                    for (int t = 0; t < 4; ++t) { const float w0 = t < 2 ? wa[2 * t] : wb[2 * t - 4], w1 = t < 2 ? wa[2 * t + 1] : wb[2 * t - 3];
                        vw[t] = pk2(bf2f((unsigned short)vr[2 * t]) * w0, bf2f((unsigned short)vr[2 * t + 1]) * w1); }
                    const bf16x8 vf = __builtin_bit_cast(bf16x8, vw);
#pragma unroll
                    for (int nt = 0; nt < 8; ++nt) acc[nt] = mfma16(frag_tr(KN, LP, 32 * kk, 16 * nt, fr, fq), vf, acc[nt]); }
                bf16_t* sp = A.ST + ((((size_t)b * 2 + dir) * NCH + c) * NHT + grp * NH + hh) * (size_t)(DV * 128) + (size_t)(v0 + fr) * 128 + 4 * fq;
#pragma unroll
                for (int nt = 0; nt < 8; ++nt) { u32x2 o; o.x = pk2(acc[nt][0], acc[nt][1]); o.y = pk2(acc[nt][2], acc[nt][3]); *(u32x2*)(sp + 16 * nt) = o; }
            }
        }
    }
}

template <int DV, bool SSD> __device__ __forceinline__ void lin_s2_phase(const LinArgs& A, int tid) {
    constexpr int NHT = SSD ? 8 : 4, PER = NHT * DV * 128;
    const int gt = blockIdx.x * 512 + tid, NT_ = gridDim.x * 512;
    for (int it = gt; it < 8 * (PER / 4); it += NT_) {
        const int bd = it / (PER / 4), e = (it % (PER / 4)) * 4, h = e / (DV * 128), dir = bd & 1;
        float run[4] = {0.f, 0.f, 0.f, 0.f};
        float dec_r = 1.f; if (!SSD) dec_r = __expf(-128.f * __expf(A.rld[dir * 4 + (h & 3)]));
        for (int s0 = 0; s0 < NCH; s0 += 11) {
            u32x2 x[11]; float dec[11]; bf16_t* pp[11];
#pragma unroll
            for (int j = 0; j < 11; ++j) { const int st = s0 + j; const int c = dir ? (st < 2 ? 1 - st : NCH + 1 - st) : st;
                pp[j] = A.ST + ((size_t)bd * NCH + c) * PER + e; x[j] = *(const u32x2*)pp[j];
                dec[j] = SSD ? A.CD[((size_t)bd * NCH + c) * 8 + h] : dec_r; }
#pragma unroll
            for (int j = 0; j < 11; ++j) {
                u32x2 o; o.x = pk2(run[0], run[1]); o.y = pk2(run[2], run[3]); *(u32x2*)pp[j] = o;
                run[0] = run[0] * dec[j] + bf2f(x[j].x & 0xffffu); run[1] = run[1] * dec[j] + bf2f(x[j].x >> 16);
                run[2] = run[2] * dec[j] + bf2f(x[j].y & 0xffffu); run[3] = run[3] * dec[j] + bf2f(x[j].y >> 16); }
        }
    }
}
template <int DV, int NH, bool SSD> struct LinEpi;
template <int DV, int NH, int NHU, bool SSD, class Epi> __device__ __forceinline__ void lin_s3_phase(const LinArgs& A, const Epi& E, int cmin, LAS unsigned char* lds, int tid, int lane, int wave) {
    constexpr int NHT = SSD ? 8 : 4, NG = NHT / NH, NSUB = NH / NHU, NVT = DV / 16, NSTD = SSD ? 2 : 1, NDG = 2 / NSTD, TILEB = 128 * LP * 2, NGE = 2 * NHU * 128;
    static_assert(NHU * DV == 128 && NGE <= 512, "unit output tile is 128 x 128");
    LAS bf16_t* KN = (LAS bf16_t*)lds;
    LAS bf16_t* VT = (LAS bf16_t*)(lds + TILEB);
    LAS bf16_t* WL = (LAS bf16_t*)(lds + 2 * TILEB) + wave * 16 * LP;
    LAS bf16_t* STL = (LAS bf16_t*)(lds + 3 * TILEB);
    LAS float* gsm = (LAS float*)(lds + 4 * TILEB);
    LAS float* dsm = gsm + NGE;
    const int fr = lane & 15, fq = lane >> 4, l0 = wave * 16;
    const int nunits = NB * NCH * NG * NSUB, G = gridDim.x;
#define S3_DECODE(uu, sub, grp, c, b) const int sub = (uu) % NSUB, grp = ((uu) / NSUB) % NG, c = ((uu) / (NSUB * NG)) % NCH, b = (uu) / (NSUB * NG * NCH)
    int u = blockIdx.x;
    while (u < nunits && ((u / (NSUB * NG)) % NCH) < cmin) u += G;
    u32x4 kreg[4], vreg[4]; bf16x8 qfn[4]; float gvn = 0.f, dvn = 0.f;
#define S3_LOAD_UNIT(uu) do { S3_DECODE(uu, sub_, grp_, c_, b_); const size_t row0_ = (size_t)b_ * SA + 128 * c_; const int h0_ = grp_ * NH + sub_ * NHU; \
        _Pragma("unroll") for (int i = 0; i < 4; ++i) { const int id = tid + 512 * i, q = id & 15, s_ = id >> 4; \
            kreg[i] = *(const u32x4*)(A.Kn + (row0_ + s_) * A.ld + grp_ * 128 + 8 * q); vreg[i] = *(const u32x4*)(A.Vn + (row0_ + s_) * A.ld + h0_ * DV + 8 * q); } \
        _Pragma("unroll") for (int kk = 0; kk < 4; ++kk) qfn[kk] = *(const bf16x8*)(A.Qn + (row0_ + l0 + fr) * A.ld + grp_ * 128 + 32 * kk + 8 * fq); \
        if (tid < NGE) { const int dir = tid / (NHU * 128), hh_ = (tid >> 7) % NHU, s_ = tid & 127; float gl_; lin_gdt<SSD>(A, row0_, dir, h0_ + hh_, s_, gvn, gl_, dvn); } } while (0)
    while (u < nunits) {
        S3_LOAD_UNIT(u);
        S3_DECODE(u, sub, grp, c, b); const size_t row0 = (size_t)b * SA + 128 * c; const int h0 = grp * NH + sub * NHU;
        int un = u + G; while (un < nunits && ((un / (NSUB * NG)) % NCH) < cmin) un += G;
        __syncthreads();
#pragma unroll
        for (int i = 0; i < 4; ++i) { const int id = tid + 512 * i, q = id & 15, s_ = id >> 4; *(LAS u32x4*)(KN + s_ * LP + 8 * q) = kreg[i]; *(LAS u32x4*)(VT + s_ * LP + 8 * q) = vreg[i]; }
        if (tid < NGE) { gsm[tid] = gvn; dsm[tid] = dvn; }
        bf16x8 qf[4];
#pragma unroll
        for (int kk = 0; kk < 4; ++kk) qf[kk] = qfn[kk];
        u32x4 zreg[4], sreg[4];
#pragma unroll
        for (int i = 0; i < 4; ++i) { const int id = tid + 512 * i, q = id & 15, s_ = id >> 4; zreg[i] = *(const u32x4*)(E.buf + (row0 + s_) * 512 + h0 * DV + 8 * q); }
#define S3_LOAD_ST(stage) do { const int hh_ = (stage) / NDG, dg_ = (stage) % NDG; \
        _Pragma("unroll") for (int i = 0; i < 4; ++i) { const int id = tid + 512 * i, q = id & 15, v = id >> 4, d = v / DV, dir = dg_ * NSTD + d; \
            sreg[i] = *(const u32x4*)(A.ST + ((((size_t)b * 2 + dir) * NCH + c) * NHT + h0 + hh_) * (size_t)(DV * 128) + (size_t)(v - d * DV) * 128 + 8 * q); } } while (0)
        S3_LOAD_ST(0);
        __syncthreads();
        f32x4 P[8];
#pragma unroll
        for (int nt = 0; nt < 8; ++nt) { P[nt] = (f32x4){0.f, 0.f, 0.f, 0.f};
#pragma unroll
            for (int kk = 0; kk < 4; ++kk) P[nt] = mfma16(qf[kk], *(const LAS bf16x8*)(KN + (16 * nt + fr) * LP + 32 * kk + 8 * fq), P[nt]); }
        __syncthreads();
#pragma unroll
        for (int i = 0; i < 4; ++i) { const int id = tid + 512 * i, q = id & 15, s_ = id >> 4; *(LAS u32x4*)(KN + s_ * LP + 8 * q) = zreg[i]; }
#pragma unroll 1
        for (int hh = 0; hh < NHU; ++hh) {
            const int h = h0 + hh;
            const LAS float* gf = gsm + hh * 128; const LAS float* gb = gsm + (NHU + hh) * 128;
            const LAS float* df = dsm + hh * 128; const LAS float* db = dsm + (NHU + hh) * 128;
            float gfl[4], gbl[4];
#pragma unroll
            for (int r = 0; r < 4; ++r) { gfl[r] = gf[l0 + 4 * fq + r]; gbl[r] = gb[l0 + 4 * fq + r]; }
#pragma unroll
            for (int nt = 0; nt < 8; ++nt) { const int s = 16 * nt + fr;
                if (16 * nt + 15 < l0) {
                    const float gfs = gf[s], dfs = df[s];
#pragma unroll
                    for (int r = 0; r < 4; ++r) WL[(4 * fq + r) * LP + s] = (bf16_t)f2bf(P[nt][r] * (__expf(fminf(gfl[r] - gfs, 0.f)) * dfs));
                } else if (16 * nt > l0 + 15) {
                    const float gbs = gb[s], dbs = db[s];
#pragma unroll
                    for (int r = 0; r < 4; ++r) WL[(4 * fq + r) * LP + s] = (bf16_t)f2bf(P[nt][r] * (__expf(fminf(gbl[r] - gbs, 0.f)) * dbs));
                } else {
                    const float gfs = gf[s], gbs = gb[s], dfs = df[s], dbs = db[s];
#pragma unroll
                    for (int r = 0; r < 4; ++r) { const int l = l0 + 4 * fq + r;
                        const float mf = (s <= l) ? __expf(fminf(gfl[r] - gfs, 0.f)) * dfs : 0.f;
                        const float mb = (s >= l) ? __expf(fminf(gbl[r] - gbs, 0.f)) * dbs : 0.f;
                        WL[(4 * fq + r) * LP + s] = (bf16_t)f2bf(P[nt][r] * (mf + mb)); } } }
            asm volatile("s_waitcnt lgkmcnt(0)" ::: "memory");
            bf16x8 af[4];
#pragma unroll
            for (int kk = 0; kk < 4; ++kk) af[kk] = *(const LAS bf16x8*)(WL + fr * LP + 32 * kk + 8 * fq);
            f32x4 y[NVT];
#pragma unroll
            for (int vt = 0; vt < NVT; ++vt) { f32x4 ay = {0.f, 0.f, 0.f, 0.f};
#pragma unroll
                for (int kk = 0; kk < 4; ++kk) ay = mfma16(af[kk], frag_tr(VT, LP, 32 * kk, hh * DV + 16 * vt, fr, fq), ay);
                y[vt] = ay; }
#pragma unroll 1
            for (int dg = 0; dg < NDG; ++dg) {
                __syncthreads();
#pragma unroll
                for (int i = 0; i < 4; ++i) { const int id = tid + 512 * i, q = id & 15, v = id >> 4; *(LAS u32x4*)(STL + v * LP + 8 * q) = sreg[i]; }
                { const int nst = hh * NDG + dg + 1; if (nst < NHU * NDG) S3_LOAD_ST(nst); }
                __syncthreads();
#pragma unroll
                for (int d = 0; d < NSTD; ++d) { const int dir = dg * NSTD + d; float ed[4];
#pragma unroll
                    for (int r = 0; r < 4; ++r) ed[r] = __expf((dir ? gb : gf)[l0 + 4 * fq + r]);
#pragma unroll
                    for (int vt = 0; vt < NVT; ++vt) { f32x4 a0 = {0.f, 0.f, 0.f, 0.f};
#pragma unroll
                        for (int kk = 0; kk < 4; ++kk) a0 = mfma16(qf[kk], *(const LAS bf16x8*)(STL + (d * DV + 16 * vt + fr) * LP + 32 * kk + 8 * fq), a0);
#pragma unroll
                        for (int r = 0; r < 4; ++r) y[vt][r] += ed[r] * a0[r]; } }
            }
            E(y, l0 + 4 * fq, row0 + l0 + 4 * fq, h, hh, fr, VT, KN, lane);
        }
        __syncthreads();
        for (int id = tid; id < 128 * 16; id += 512) { const int q = id & 15, s = id >> 4;
            *(u32x4*)(E.buf + (row0 + s) * 512 + h0 * DV + 8 * q) = *(const LAS u32x4*)(KN + s * LP + 8 * q); }
        u = un;
    }
#undef S3_DECODE
#undef S3_LOAD_UNIT
#undef S3_LOAD_ST
}
struct SsdEpi {
    bf16_t* buf; float* SSQ; const float* dskip;
    __device__ __forceinline__ void operator()(f32x4 (&y)[4], int lb, size_t rowb, int h, int hh, int fr, const LAS bf16_t* VT, LAS bf16_t* ZT, int lane) const {
        const float dsk = dskip[h]; float ss[4] = {0.f, 0.f, 0.f, 0.f};
#pragma unroll
        for (int vt = 0; vt < 4; ++vt)
#pragma unroll
            for (int r = 0; r < 4; ++r) { const int v = 16 * vt + fr; LAS bf16_t* zp = ZT + (lb + r) * LP + hh * 64 + v;
                const float x = bf2f(VT[(lb + r) * LP + hh * 64 + v]);
                const float val = (y[vt][r] + dsk * x) * siluf(bf2f(*zp)); ss[r] += val * val; *zp = (bf16_t)f2bf(val); }
#pragma unroll
        for (int r = 0; r < 4; ++r) { float s = ss[r]; s += shx(s, 1, lane); s += shx(s, 2, lane); s += shx(s, 4, lane); s += shx(s, 8, lane);
            if (fr == 0) SSQ[(rowb + r) * 8 + h] = s; }
    }
};
struct RetEpi {
    bf16_t* buf; const float* gnw;
    __device__ __forceinline__ void operator()(f32x4 (&y)[8], int lb, size_t rowb, int h, int hh, int fr, const LAS bf16_t* VT, LAS bf16_t* ZT, int lane) const {
#pragma unroll
        for (int r = 0; r < 4; ++r) { float s = 0.f;
#pragma unroll
            for (int vt = 0; vt < 8; ++vt) s += y[vt][r];
            s += shx(s, 1, lane); s += shx(s, 2, lane); s += shx(s, 4, lane); s += shx(s, 8, lane);
            const float mu = s * (1.f / 128.f); float q = 0.f;
#pragma unroll
            for (int vt = 0; vt < 8; ++vt) { const float d = y[vt][r] - mu; q += d * d; }
            q += shx(q, 1, lane); q += shx(q, 2, lane); q += shx(q, 4, lane); q += shx(q, 8, lane);
            const float rstd = rsqrtf(q * (1.f / 128.f) + EPS);
#pragma unroll
            for (int vt = 0; vt < 8; ++vt) { const int v = 16 * vt + fr; LAS bf16_t* gp = ZT + (lb + r) * LP + v;
                *gp = (bf16_t)f2bf((y[vt][r] - mu) * rstd * gnw[h * 128 + v] * siluf(bf2f(*gp))); } }
    }
};
#ifdef ONLY_PH
#define EN(x) ((x) == ONLY_PH)
#elif defined(SKIP_PH)
#define EN(x) ((x) != SKIP_PH)
#else
#define EN(x) (MODE == 0 || (MODE == 1 && (x) != 15) || (MODE == 2 && (x) == 15))
#endif
#define XB_TMO      128
#define XB_XCNT(j)  (256  + 64 * (j))
#define XB_XSUB(j)  (1280 + 64 * (j))
#define XB_XGEN(j)  (2304 + 64 * (j))
#define XB_TOP      3328
#define XB_TOPGEN   3392
#define XCD_BAR_WORDS 3456
#define XB_SPIN_CAP (1u << 18)

__device__ __forceinline__ unsigned xb_ld(unsigned* p)              { return __hip_atomic_load(p, __ATOMIC_RELAXED, __HIP_MEMORY_SCOPE_AGENT); }
__device__ __forceinline__ unsigned xb_add(unsigned* p, unsigned v) { return __hip_atomic_fetch_add(p, v, __ATOMIC_RELAXED, __HIP_MEMORY_SCOPE_AGENT); }
__device__ __forceinline__ unsigned xb_xcc_id() { return (unsigned)__builtin_amdgcn_s_getreg((3 << 11) | 20) & 0xFu; }
#define XB_SPIN(cond, bar) do { unsigned _sp = 0; while (cond) { __builtin_amdgcn_s_sleep(1); \
    if ((++_sp & 255u) == 0u) { if (xb_ld(&(bar)[XB_TMO])) break; if (_sp > XB_SPIN_CAP) { atomicAdd(&(bar)[XB_TMO], 1u); break; } } } } while (0)

struct XcdBarrier {
    unsigned* bar; unsigned x;
    volatile LAS unsigned* st;
};

__device__ __forceinline__ XcdBarrier xcd_barrier_post(unsigned* bar, volatile LAS unsigned* st) {
    XcdBarrier b; b.bar = bar; b.x = xb_xcc_id(); b.st = st;
    if (threadIdx.x == 0) (void)xb_add(&bar[XB_XCNT(b.x)], 1u);
    return b;
}
__device__ __forceinline__ void xcd_barrier_complete(unsigned* bar, unsigned x, unsigned& nloc, unsigned& nx) {
    const unsigned G = gridDim.x * gridDim.y * gridDim.z;
    unsigned sum, cnt, mine, sp = 0u;
    for (;;) {
        sum = 0u; cnt = 0u; mine = 0u;
#pragma unroll
        for (unsigned j = 0; j < 16; ++j) { const unsigned c = xb_ld(&bar[XB_XCNT(j)]); sum += c; cnt += (c > 0u) ? 1u : 0u; mine = (j == x) ? c : mine; }
        if (sum == G) break;
        __builtin_amdgcn_s_sleep(1);
        if ((++sp & 255u) == 0u) { if (xb_ld(&bar[XB_TMO])) break; if (sp > XB_SPIN_CAP) { atomicAdd(&bar[XB_TMO], 1u); break; } }
    }
    nloc = mine > 0u ? mine : 1u; nx = cnt > 0u ? cnt : 1u;
}

__device__ __forceinline__ void xcd_barrier(const XcdBarrier& b, const int tid_) {
    asm volatile("s_waitcnt vmcnt(0)" ::: "memory");
    __syncthreads();
    if (tid_ == 0) {
        unsigned* bar = b.bar;
        __builtin_amdgcn_s_waitcnt(0);
        unsigned nloc = b.st[0], nx = b.st[1];
        if (nloc == 0u) { xcd_barrier_complete(bar, b.x, nloc, nx); b.st[0] = nloc; b.st[1] = nx; }
        const unsigned old = xb_add(&bar[XB_XSUB(b.x)], 1u);
        const unsigned gen = old / nloc;
        if (old + 1u == (gen + 1u) * nloc) {
            __builtin_amdgcn_fence(__ATOMIC_RELEASE, "agent");
            asm volatile("s_waitcnt vmcnt(0)" ::: "memory");
            const unsigned og = xb_add(&bar[XB_TOP], 1u);
            const unsigned tg = og / nx;
            if (og + 1u == (tg + 1u) * nx) xb_add(&bar[XB_TOPGEN], 1u);
            else XB_SPIN(xb_ld(&bar[XB_TOPGEN]) == tg, bar);
            __builtin_amdgcn_fence(__ATOMIC_ACQUIRE, "agent");
            xb_add(&bar[XB_XGEN(b.x)], 1u);
            asm volatile("s_waitcnt vmcnt(0)" ::: "memory");
        } else {
            XB_SPIN(xb_ld(&bar[XB_XGEN(b.x)]) == gen, bar);
            __builtin_amdgcn_fence(__ATOMIC_ACQUIRE, "agent");
            asm volatile("s_waitcnt vmcnt(0)" ::: "memory");
        }
    }
    __syncthreads();
}

constexpr size_t OFF_PART = 424 * MiB;
constexpr size_t OFF_BAR = 13 * MiB;
constexpr int MISC_OFF = LDS_BYTES - 64;
constexpr int PH_PER_LAYER = 15, N_PHASES = 2 + DEPTH * PH_PER_LAYER;
#define EN(x) (MODE == 0 || (MODE == 1 && (x) != 15) || (MODE == 2 && (x) == 15))
__device__ __forceinline__ int mk_tid(int wave_id) { unsigned m_ = ~0u; asm volatile("" : "+s"(m_)); int t = wave_id * 64 + (int)__builtin_amdgcn_mbcnt_hi(m_, __builtin_amdgcn_mbcnt_lo(m_, 0u)); asm volatile("" : "+v"(t)); return t; }
#define PHASE_BEGIN(p) if (ph_lo <= (p) && (p) < ph_hi) { int tid = mk_tid(wave_id); const int lane = tid & 63, wave = __builtin_amdgcn_readfirstlane(tid >> 6); \
    CArgsP ap = (CArgsP)__builtin_amdgcn_kernarg_segment_ptr(); asm volatile("" : "+s"(ap)); unsigned char* ws = ap->ws; float* hlat = ap->out; (void)lane; (void)wave; (void)hlat;
#define PHASE_END(p) if ((p) + 1 < ph_hi) { if (ph_hi < 0) grid.sync();   else xcd_barrier(xbar, mk_tid(wave_id)); } }

template <int MODE, int L> __device__ __forceinline__ void layer_phases(cg::grid_group& grid, const XcdBarrier& xbar, const int wave_id, LAS unsigned char* lds, unsigned char* lds_raw, const int ph_lo, const int ph_hi) {
    constexpr int P0 = 1 + L * PH_PER_LAYER;
#define LAYER_COMMON const float* modL = (const float*)(ws + OFF_MOD) + (size_t)L * 5 * MODW; unsigned char* wl = ws + OFF_W + (size_t)L * W_LAYER; \
    const float* bl = L == 0 ? ap->in[0] : hlat; const float* bc = L == 0 ? ap->in[2] : (const float*)(ws + OFF_HCTX);     (void)modL; (void)wl; (void)bl; (void)bc;
    PHASE_BEGIN(P0 + 0) LAYER_COMMON
        if (EN(0)) { if (L == 0) norm_mod_phase(bl, bc, ap->in[6] + L * DM, modL, 0, 1, (bf16_t*)(ws + OFF_U), lane, wave);
                     else norm_mod_phase(bl, bc, ap->in[6] + L * DM, modL, 0, 1, (bf16_t*)(ws + OFF_U), lane, wave, (const float*)(ws + OFF_PART), 16, modL - 5 * MODW + 4 * MODW + 5 * DM, nullptr); }
    PHASE_END(P0 + 0)
    PHASE_BEGIN(P0 + 1) LAYER_COMMON
        if (EN(1)) { pg8::Gemm g{(bf16_t*)(ws + OFF_U), (const bf16_t*)(wl + W_P), 0, 0, T, N1, DM, DM, 0, 1};
            pg8::StaticOrder S; S.init(T, N1, gridDim.x, blockIdx.x);
            pg8::EpiInProj E{ws, (float*)(ws + OFF_DT), ap->in[9] + L * 64, ap->in[10] + L * 64, ap->in[13] + L * 16, (const f32x2*)(ws + OFF_ATAB), (const f32x2*)(ws + OFF_RTAB)};
            pg8::gemm_phase<pg8::EpiInProj, pg8::StaticOrder, true, true>(lds, g, S, E, tid); }
    PHASE_END(P0 + 1)
    PHASE_BEGIN(P0 + 2) LAYER_COMMON
        if (EN(2)) postproj_phase((bf16_t*)(ws + OFF_XBC), (bf16_t*)(ws + OFF_CONV), ap->in[11] + L * 3 * 1024, ap->in[12] + L * 1024, (float*)(ws + OFF_DT), (float*)(ws + OFF_G), (float*)(ws + OFF_CD), ap->in[14] + L * 16, (const bf16_t*)(ws + OFF_U), (const bf16_t*)(wl + W_P) + (size_t)N1 * DM, ap->in[13] + L * 16, tid, lane, wave);
    PHASE_END(P0 + 2)
#define SSD_ARGS LinArgs A{(bf16_t*)(ws + OFF_CONV) + 768, (bf16_t*)(ws + OFF_CONV) + 512, (bf16_t*)(ws + OFF_CONV), 1024, (bf16_t*)(ws + OFF_ST), (float*)(ws + OFF_G), (float*)(ws + OFF_DT), (float*)(ws + OFF_CD), nullptr};
#define RET_ARGS LinArgs A{(bf16_t*)(ws + OFF_RQ), (bf16_t*)(ws + OFF_RK), (bf16_t*)(ws + OFF_RV), 512, (bf16_t*)(ws + OFF_ST), nullptr, nullptr, nullptr, ap->in[17] + L * 8};
    PHASE_BEGIN(P0 + 3) SSD_ARGS if (EN(3)) lin_s1_phase<64, 4, true>(A, lds, tid, lane, wave); PHASE_END(P0 + 3)
    PHASE_BEGIN(P0 + 4) SSD_ARGS if (EN(4)) lin_s2_phase<64, true>(A, tid); PHASE_END(P0 + 4)
    PHASE_BEGIN(P0 + 5) SSD_ARGS if (EN(5)) { SsdEpi E{(bf16_t*)(ws + OFF_Z), (float*)(ws + OFF_SSQ), ap->in[15] + L * 8}; lin_s3_phase<64, 4, 2, true, SsdEpi>(A, E, L == DEPTH - 1 ? 2 : 0, lds, tid, lane, wave); } PHASE_END(P0 + 5)
    PHASE_BEGIN(P0 + 6) RET_ARGS if (EN(6)) lin_s1_phase<128, 1, false>(A, lds, tid, lane, wave); PHASE_END(P0 + 6)
    PHASE_BEGIN(P0 + 7) RET_ARGS if (EN(7)) lin_s2_phase<128, false>(A, tid); PHASE_END(P0 + 7)
    PHASE_BEGIN(P0 + 8) RET_ARGS
        if (EN(8)) { RetEpi E{(bf16_t*)(ws + OFF_RG), ap->in[18] + L * 512}; lin_s3_phase<128, 1, 1, false, RetEpi>(A, E, L == DEPTH - 1 ? 2 : 0, lds, tid, lane, wave); __syncthreads(); }
        if (EN(15)) {
            typedef attn_body::bf16 abf; const abf* Qp = (const abf*)(ws + OFF_Q); const abf* KVp = (const abf*)(ws + OFF_KV);
            if (L < DEPTH - 1) for (int u = (int)((blockIdx.x + gridDim.x - 32u) % gridDim.x); u < NB * 8; u += gridDim.x) { const int b = u >> 3, h = u & 7;     const long r0 = (long)b * SA;
                attn_body::attn_unit<8>(r0, r0, 4, Qp + h * 64, KVp + (h >> 2) * 64, KVp + 128 + (h >> 2) * 64, (abf*)Qp + h * 64, (char*)lds_raw, tid); }
            for (int u = blockIdx.x; u < NB * 8 * 32; u += gridDim.x) { const int x = u & 7, qb = (u >> 3) & 31, i = u >> 8; const int b = x >> 1, h = (x & 1) * 4 + i; const long r0 = (long)b * SA;
                attn_body::attn_unit<8>(r0 + NCTX + 256 * qb, r0, SA / 64, Qp + h * 64, KVp + (h >> 2) * 64, KVp + 128 + (h >> 2) * 64, (abf*)Qp + h * 64, (char*)lds_raw, tid); }
        }
    PHASE_END(P0 + 8)
    PHASE_BEGIN(P0 + 9) LAYER_COMMON
        if (EN(9)) { pg8::Gemm g{(bf16_t*)(ws + OFF_U), (const bf16_t*)(wl + W_G), 0, 0, T, NGATE, DM, DM, 0, 1};
            pg8::StaticOrder S; S.init(T, NGATE, gridDim.x, blockIdx.x, L == DEPTH - 1);
            pg8::EpiBf16<2> E{(bf16_t*)(ws + OFF_GATE), NGATE, 0};
            pg8::gemm_phase<pg8::EpiBf16<2>, pg8::StaticOrder, true, true>(lds, g, S, E, tid); }
    PHASE_END(P0 + 9)
    PHASE_BEGIN(P0 + 10) LAYER_COMMON
        if (EN(10)) { pg8::Gemm g{(bf16_t*)(ws + OFF_Q), (const bf16_t*)(wl + W_B), SZ512, (size_t)DM * 512 * 2, T, DM, 512, 512, 0, 1};
            pg8::MergeOrder S; S.S.init(T, DM, gridDim.x, blockIdx.x, L == DEPTH - 1);
            pg8::EpiMerge E{(bf16_t*)(ws + OFF_GATE), (float*)(ws + OFF_SSQ), (bf16_t*)(ws + OFF_U)};
            pg8::gemm_phase<pg8::EpiMerge, pg8::MergeOrder, true, true>(lds, g, S, E, tid); }
    PHASE_END(P0 + 10)
    PHASE_BEGIN(P0 + 11) LAYER_COMMON
        if (EN(11)) { pg8::Gemm g{(bf16_t*)(ws + OFF_U), (const bf16_t*)(wl + W_O), 0, 0, T, DM, DM, DM, 0, 1};
            pg8::StaticOrder S; S.init(T, DM, gridDim.x, blockIdx.x, 1);
            pg8::EpiResid E{bl, bc, hlat, (float*)(ws + OFF_HCTX), modL + 2 * DM};
            pg8::gemm_phase<pg8::EpiResid, pg8::StaticOrder, true, true>(lds, g, S, E, tid);
            if (L < DEPTH - 1) { pg8::Gemm g2{(bf16_t*)(ws + OFF_U), (const bf16_t*)(wl + W_O), 512, 131072, T, DM, 256, DM, 0, 1};
                pg8::CtxSplitOrder S2{4, (int)gridDim.x, (int)blockIdx.x}; pg8::EpiPartial E2{(float*)(ws + OFF_PART)};
                pg8::gemm_phase<pg8::EpiPartial, pg8::CtxSplitOrder, true, true>(lds, g2, S2, E2, mk_tid(wave_id)); } }
    PHASE_END(P0 + 11)
    PHASE_BEGIN(P0 + 12) LAYER_COMMON
        if (EN(12)) { if (L == 0) norm_mod_phase(hlat, ap->in[2], ap->in[7] + L * DM, modL, 3, 4, (bf16_t*)(ws + OFF_U), lane, wave, (const float*)(ws + OFF_PART), 4, modL + 4 * MODW + 2 * DM, (float*)(ws + OFF_HCTX));
                      else norm_mod_phase(hlat, (const float*)(ws + OFF_HCTX), ap->in[7] + L * DM, modL, 3, 4, (bf16_t*)(ws + OFF_U), lane, wave); }
    PHASE_END(P0 + 12)
    PHASE_BEGIN(P0 + 13) LAYER_COMMON
        if (EN(13)) { pg8::Gemm g{(bf16_t*)(ws + OFF_U), (const bf16_t*)(wl + W_1), 0, 0, T, HID, DM, DM, 0, 1};
            pg8::StaticOrder S; S.init(T, HID, gridDim.x, blockIdx.x, L == DEPTH - 1);
            pg8::EpiBf16<1> E{(bf16_t*)(ws + OFF_HID), HID, 1};
            pg8::gemm_phase<pg8::EpiBf16<1>, pg8::StaticOrder, true, true>(lds, g, S, E, tid); }
    PHASE_END(P0 + 13)
    PHASE_BEGIN(P0 + 14) LAYER_COMMON
        if (EN(14)) { pg8::Gemm g{(bf16_t*)(ws + OFF_HID), (const bf16_t*)(wl + W_2), 0, 0, T, DM, HID, HID, 1, 1};
            pg8::StaticOrder S; S.init(T, DM, gridDim.x, blockIdx.x, 1);
            pg8::EpiResid E{hlat, (const float*)(ws + OFF_HCTX), hlat, (float*)(ws + OFF_HCTX), modL + 5 * DM};
            pg8::gemm_phase<pg8::EpiResid, pg8::StaticOrder, true, true>(lds, g, S, E, tid);
            if (L < DEPTH - 1) { pg8::Gemm g2{(bf16_t*)(ws + OFF_HID), (const bf16_t*)(wl + W_2), 131072, 131072, T, DM, 256, HID, 1, 1};
                pg8::CtxSplitOrder S2{16, (int)gridDim.x, (int)blockIdx.x}; pg8::EpiPartial E2{(float*)(ws + OFF_PART)};
                pg8::gemm_phase<pg8::EpiPartial, pg8::CtxSplitOrder, true, true>(lds, g2, S2, E2, mk_tid(wave_id)); } }
    PHASE_END(P0 + 14)
}

template <int MODE> __global__ void __launch_bounds__(512, 2) mega_fwd(Args args) {
    extern __shared__ __attribute__((aligned(16))) unsigned char lds_raw[];
    LAS unsigned char* lds = (LAS unsigned char*)lds_raw;
    cg::grid_group grid = cg::this_grid();
    const int ph_lo = args.ph_lo, ph_hi = args.ph_hi;
    if (threadIdx.x < 16) ((LAS unsigned*)(lds + MISC_OFF))[threadIdx.x] = 0u;
    __syncthreads();
    const int wave_id = __builtin_amdgcn_readfirstlane((int)threadIdx.x >> 6);
    XcdBarrier xbar; xbar.bar = (unsigned*)(args.ws + OFF_BAR); xbar.x = 0; xbar.st = nullptr;
    if (ph_hi - ph_lo > 1) xbar = xcd_barrier_post((unsigned*)(args.ws + OFF_BAR), (volatile LAS unsigned*)(lds + MISC_OFF));
    PHASE_BEGIN(0) if (EN(100)) prologue_phase(ap, lds, tid, lane, wave); PHASE_END(0)
    layer_phases<MODE, 0>(grid, xbar, wave_id, lds, lds_raw, ph_lo, ph_hi);
    layer_phases<MODE, 1>(grid, xbar, wave_id, lds, lds_raw, ph_lo, ph_hi);
    PHASE_BEGIN(N_PHASES - 1) if (EN(101)) final_norm_phase(hlat, ap->in[23], lane, wave); PHASE_END(N_PHASES - 1)
}

extern "C" void kernel_launch(void* const* d_in, const int* in_sizes, int n_in, void* d_out, int out_size, void* d_ws, size_t ws_size, hipStream_t stream) {
    static int grid = 0;
    if (grid == 0) {
        if (n_in != 24 || ws_size < OFF_END) { fprintf(stderr, "kernel_launch: unexpected problem (n_in %d, ws %zu)\n", n_in, ws_size); grid = -1; return; }
        int dev = 0, cus = 0, per_cu = 0;
        (void)hipGetDevice(&dev); (void)hipDeviceGetAttribute(&cus, hipDeviceAttributeMultiprocessorCount, dev);
        #if MK_ONE_LAUNCH
        (void)hipFuncSetAttribute((const void*)mega_fwd<0>, hipFuncAttributeMaxDynamicSharedMemorySize, LDS_BYTES);
#else
        (void)hipFuncSetAttribute((const void*)mega_fwd<1>, hipFuncAttributeMaxDynamicSharedMemorySize, LDS_BYTES); (void)hipFuncSetAttribute((const void*)mega_fwd<2>, hipFuncAttributeMaxDynamicSharedMemorySize, LDS_BYTES);
#endif
        (void)hipOccupancyMaxActiveBlocksPerMultiprocessor(&per_cu, (const void*)mega_fwd<MK_ONE_LAUNCH ? 0 : 1>, 512, LDS_BYTES);
        if (per_cu < 1) { fprintf(stderr, "kernel_launch: occupancy query says %d\n", per_cu); per_cu = 1; }
        (void)hipGetLastError();
        grid = cus * 1;
    }
    if (grid < 0) return;
    Args a{};
    for (int i = 0; i < 24; ++i) a.in[i] = (const float*)d_in[i];
    a.out = (float*)d_out; a.ws = (unsigned char*)d_ws;
#if MK_ONE_LAUNCH
    (void)hipMemsetAsync((char*)d_ws + OFF_BAR, 0, 16384, stream);
    a.ph_lo = 0; a.ph_hi = N_PHASES;
    { void* kargs[] = {&a}; hipError_t e = hipLaunchCooperativeKernel((const void*)mega_fwd<0>, dim3(grid), dim3(512), kargs, LDS_BYTES, stream);
      if (e != hipSuccess) fprintf(stderr, "cooperative launch failed: %s\n", hipGetErrorString(e)); }
#ifdef PROBE_LO
    (void)hipMemsetAsync((char*)d_ws + OFF_BAR, 0, 16384, stream);
    a.ph_lo = PROBE_LO; a.ph_hi = PROBE_HI;
    { void* kargs[] = {&a}; (void)hipLaunchCooperativeKernel((const void*)mega_fwd<0>, dim3(grid), dim3(512), kargs, LDS_BYTES, stream); }
#endif
#else
    for (int ph = 0; ph < N_PHASES; ++ph) { a.ph_lo = ph; a.ph_hi = ph + 1; void* kargs[] = {&a};
        hipError_t e = hipLaunchCooperativeKernel((const void*)mega_fwd<1>, dim3(grid), dim3(512), kargs, LDS_BYTES, stream);
        if (e != hipSuccess) { fprintf(stderr, "launch %d failed: %s\n", ph, hipGetErrorString(e)); break; }
        if (ph >= 1 && ph < N_PHASES - 1 && (ph - 1) % PH_PER_LAYER == 8) { e = hipLaunchCooperativeKernel((const void*)mega_fwd<2>, dim3(grid), dim3(512), kargs, LDS_BYTES, stream);
            if (e != hipSuccess) { fprintf(stderr, "attn launch %d failed: %s\n", ph, hipGetErrorString(e)); break; } } }
#endif
}
```

```cpp
#include <hip/hip_runtime.h>
#include <hip/hip_cooperative_groups.h>
#include <hip/hip_bf16.h>
#include <cstdint>
#include <cstdio>
#include <cmath>
namespace cg = cooperative_groups;

#ifndef MK_ONE_LAUNCH
#define MK_ONE_LAUNCH 1
#endif

constexpr int NB = 4, NLAT = 8192, NCTX = 256, SA = NLAT + NCTX  , T = NB * SA  , DM = 1024, DEPTH = 2;
constexpr int NCH = SA / 128;
constexpr int N1 = 4352, N1W = 4608  , NGATE = 3072, HID = 4096, INDIM = 7440, MODW = 6144;
constexpr float EPS = 1e-6f;
constexpr float QC2 = 0.125f * 1.4426950408889634f;

constexpr size_t KiB = 1024, MiB = 1u << 20;
constexpr size_t OFF_MOD = 0;
constexpr size_t OFF_DT = 256 * KiB;
constexpr size_t OFF_G = OFF_DT + 2304 * KiB;
constexpr size_t OFF_CD = OFF_G + 2304 * KiB;
constexpr size_t OFF_SSQ = OFF_CD + 64 * KiB;
constexpr size_t OFF_ATAB = 6 * MiB;
constexpr size_t OFF_RTAB = 8 * MiB;
constexpr size_t OFF_HCTX = 16 * MiB;
constexpr size_t OFF_W = 20 * MiB;
constexpr size_t W_LAYER = 36 * MiB, W_P = 0, W_G = 9 * MiB, W_B = 15 * MiB, W_O = 18 * MiB, W_1 = 20 * MiB, W_2 = 28 * MiB;
constexpr size_t OFF_U = 92 * MiB;
constexpr size_t SZ512 = (size_t)T * 512 * 2;
constexpr size_t OFF_Q = 158 * MiB, OFF_Z = OFF_Q + SZ512, OFF_RG = OFF_Z + SZ512, OFF_KV = OFF_RG + SZ512;
constexpr size_t OFF_XBC = OFF_KV + SZ512 / 2, OFF_ST = OFF_XBC, OFF_CONV = OFF_XBC + 2 * SZ512;
constexpr size_t OFF_RQ = OFF_CONV + 2 * SZ512, OFF_RK = OFF_RQ + SZ512, OFF_RV = OFF_RK + SZ512, OFF_END = OFF_RV + SZ512;
constexpr size_t OFF_GATE = OFF_KV;
constexpr size_t OFF_HID = OFF_Q;
static_assert(OFF_END <= 512 * MiB, "ws map");
static_assert(OFF_GATE + (size_t)T * 3072 * 2 <= OFF_END && OFF_HID + (size_t)T * 4096 * 2 <= OFF_END, "overlays");
static_assert(OFF_SSQ + (size_t)T * 8 * 4 <= OFF_ATAB && OFF_RTAB + 8448 * 64 * 8 <= OFF_HCTX, "misc map");

constexpr int LDS_BYTES = 155648;

typedef unsigned short bf16_t;
typedef float f32x2_cv __attribute__((ext_vector_type(2))); typedef __bf16 bf16x2_cv __attribute__((ext_vector_type(2)));
__device__ __forceinline__ unsigned pk2(float lo, float hi) { const f32x2_cv v = {lo, hi}; const bf16x2_cv b = __builtin_convertvector(v, bf16x2_cv); return __builtin_bit_cast(unsigned, b); }
__device__ __forceinline__ unsigned f2bf(float f) { return pk2(f, 0.f) & 0xffffu; }
__device__ __forceinline__ float bf2f(unsigned h) { return __builtin_bit_cast(float, h << 16); }
__device__ __forceinline__ float siluf(float x) { return x * __builtin_amdgcn_rcpf(1.f + __expf(-x)); }

__device__ __forceinline__ float shx(float v, int m, int lane) { return __builtin_bit_cast(float, __builtin_amdgcn_ds_bpermute((lane ^ m) << 2, __builtin_bit_cast(int, v))); }

namespace pg8 {
#define PG8_LAS __attribute__((address_space(3)))
typedef unsigned short bf16_t;
typedef short bf16x8 __attribute__((ext_vector_type(8)));
typedef float f32x4 __attribute__((ext_vector_type(4)));
typedef unsigned u32x4 __attribute__((ext_vector_type(4)));
constexpr int BM = 256, BK = 64, HALF = 128, HTB = HALF * BK * 2  , STAGE_BYTES = 8 * HTB, NXCD = 8, WGM = 8;

__host__ __device__ __forceinline__ int lds_byte(int r, int c) { const int st = (r >> 4) * 2 + (c >> 5), rr = r & 15, cc = c & 31, ob = rr * 64 + cc * 2; return st * 1024 + (ob ^ (((ob >> 9) & 1) << 5)); }
__host__ __device__ __forceinline__ void stage_rc(int b, int& R, int& C) { const int st = b / 1024, sb = b % 1024, swz = sb ^ (((sb >> 9) & 1) << 5); R = (st >> 1) * 16 + swz / 64; C = (st & 1) * 32 + (swz % 64) / 2; }
__host__ __device__ __forceinline__ int perm32(int rho) { const int n = rho >> 4, i = rho & 15; return 8 * (i >> 2) + 4 * n + (i & 3); }

struct Unit { int pm, pn, sel; };
struct Gemm { const bf16_t* A; const bf16_t* Bt; size_t strideA, strideB; int M, N, K, ld, packA, packB;
    __device__ __forceinline__ const char* a(int s) const { return (const char*)A + (size_t)s * strideA; }
    __device__ __forceinline__ const char* b(int s) const { return (const char*)Bt + (size_t)s * strideB; } };

struct StaticOrder {
    int nM, nN, nwg, G, c, skipctx;
    __device__ __forceinline__ void init(int M, int N, int G_, int c_, int skip_ = 0) { nM = M / BM; if (skip_) nM = 128; nN = N / BM; nwg = nM * nN; G = G_; c = c_; skipctx = skip_; }
    __device__ __forceinline__ bool tile(long L, Unit& u) const {
        if (L >= nwg) return false;
        int wgid = (int)L; { const int q = nwg / NXCD, r = nwg % NXCD, xcd = wgid % NXCD, off = wgid / NXCD; wgid = (xcd < r ? xcd * (q + 1) : r * (q + 1) + (xcd - r) * q) + off; }
        const int nig = WGM * nN, gid = wgid / nig, fm = gid * WGM, gsz = (nM - fm) < WGM ? (nM - fm) : WGM;
        u.pm = fm + ((wgid % nig) % gsz); if (skipctx) u.pm += (u.pm >> 5) + 1; u.pn = (wgid % nig) / gsz; u.sel = 0; return true;
    }
    __device__ __forceinline__ bool next(int i, Unit& u) const { return tile((long)i * G + c, u); }
    __device__ __forceinline__ void a_ready(const Unit&) const {}
};
struct MergeOrder {
    StaticOrder S;
    __device__ __forceinline__ bool next(int i, Unit& u) const { const int t = i / 3; if (!S.tile((long)t * S.G + S.c, u)) return false; u.sel = i - 3 * t; return true; }
    __device__ __forceinline__ void a_ready(const Unit&) const {}
};


struct CtxSplitOrder {
    int parts, G, c;
    __device__ __forceinline__ bool next(int i, Unit& u) const { const int L = i * G + c; if (L >= 16 * parts) return false; const int t = L & 15; u.pm = 33 * (t >> 2); u.pn = t & 3; u.sel = L >> 4; return true; }
    __device__ __forceinline__ void a_ready(const Unit&) const {}
};
typedef float f32x2 __attribute__((ext_vector_type(2)));
typedef unsigned u32x2 __attribute__((ext_vector_type(2)));

template <int ACT  > struct EpiBf16 {
    static constexpr bool PERM = true;
    bf16_t* O; int ldc, pack;
    __device__ __forceinline__ bool keep(const Unit&) const { return false; }
    __device__ __forceinline__ void operator()(f32x4 (&acc)[2][2][4][2], const Unit& u, int wr, int wc, int fr, int fq) const {
        const int row0 = u.pm * BM + wr * 64 + fr, col0 = u.pn * BM + wc * 32 + 8 * fq;
#pragma unroll
        for (int ai = 0; ai < 2; ++ai)
#pragma unroll
            for (int m = 0; m < 4; ++m) { const int rr = wr * 64 + fr + ai * HALF + m * 16;
                bf16_t* rowp = pack ? O + (((size_t)u.pm * (ldc >> 6) + (col0 >> 6)) * 256 + rr) * 64 + (col0 & 63) : O + (size_t)(row0 + ai * HALF + m * 16) * ldc + col0;
#pragma unroll
                for (int bj = 0; bj < 2; ++bj) { f32x4 v0 = acc[ai][bj][m][0], v1 = acc[ai][bj][m][1];
#pragma unroll
                    for (int e = 0; e < 4; ++e) {
                        if (ACT == 1) { float a = fmaxf(v0[e], 0.f), b = fmaxf(v1[e], 0.f); v0[e] = a * a; v1[e] = b * b; }
                        if (ACT == 2) { float a = fminf(fmaxf(v0[e], -30.f), 30.f), b = fminf(fmaxf(v1[e], -30.f), 30.f); v0[e] = __builtin_amdgcn_rcpf(1.f + __expf(-a)); v1[e] = __builtin_amdgcn_rcpf(1.f + __expf(-b)); } }
                    u32x4 w; w.x = pk2(v0[0], v0[1]); w.y = pk2(v0[2], v0[3]); w.z = pk2(v1[0], v1[1]); w.w = pk2(v1[2], v1[3]);
                    *(u32x4*)(rowp + (pack ? bj * (2 * 256 * 64) : bj * HALF)) = w; } }
    }
};

struct EpiResid {
    static constexpr bool PERM = true;
    const float* base_lat; const float* base_ctx; float* out_lat; float* out_ctx; const float* gate;
    __device__ __forceinline__ bool keep(const Unit&) const { return false; }
    __device__ __forceinline__ void operator()(f32x4 (&acc)[2][2][4][2], const Unit& u, int wr, int wc, int fr, int fq) const {
        const int b = u.pm / 33, j = u.pm % 33; const bool isctx = (j == 0);
        const float* gv = gate + (size_t)(isctx ? 4 : b) * MODW;
        const int col0 = u.pn * BM + wc * 32 + 8 * fq;
        f32x4 g[2][2];
#pragma unroll
        for (int bj = 0; bj < 2; ++bj) { g[bj][0] = *(const f32x4*)(gv + col0 + bj * HALF); g[bj][1] = *(const f32x4*)(gv + col0 + bj * HALF + 4); }
        const size_t rbase = isctx ? (size_t)(b * NCTX) : (size_t)(b * NLAT + (j - 1) * 256);
        const float* bp = isctx ? base_ctx : base_lat; float* op = isctx ? out_ctx : out_lat;
#pragma unroll
        for (int ai = 0; ai < 2; ++ai)
#pragma unroll
            for (int m = 0; m < 4; ++m) { const size_t off = (rbase + ai * HALF + wr * 64 + m * 16 + fr) * DM + col0;
#pragma unroll
                for (int bj = 0; bj < 2; ++bj)
#pragma unroll
                    for (int n = 0; n < 2; ++n) { const f32x4 bs = *(const f32x4*)(bp + off + bj * HALF + 4 * n);
                        *(f32x4*)(op + off + bj * HALF + 4 * n) = bs + g[bj][n] * acc[ai][bj][m][n]; } }
    }
};


struct EpiPartial {
    static constexpr bool PERM = true;
    float* part;
    __device__ __forceinline__ bool keep(const Unit&) const { return false; }
    __device__ __forceinline__ void operator()(f32x4 (&acc)[2][2][4][2], const Unit& u, int wr, int wc, int fr, int fq) const {
        { unsigned m_ = ~0u; asm volatile("" : "+s"(m_)); const int ln = (int)__builtin_amdgcn_mbcnt_hi(m_, __builtin_amdgcn_mbcnt_lo(m_, 0u)); fr = ln & 15; fq = ln >> 4; }
        const int b = u.pm / 33; const int col0 = u.pn * BM + wc * 32 + 8 * fq;
        float* pb = part + (size_t)u.sel * (NB * NCTX) * DM;
#pragma unroll
        for (int ai = 0; ai < 2; ++ai)
#pragma unroll
            for (int m = 0; m < 4; ++m) { float* p = pb + ((size_t)(b * NCTX) + ai * HALF + wr * 64 + m * 16 + fr) * DM + col0;
#pragma unroll
                for (int bj = 0; bj < 2; ++bj)
#pragma unroll
                    for (int n = 0; n < 2; ++n) *(f32x4*)(p + bj * HALF + 4 * n) = acc[ai][bj][m][n]; }
    }
};

struct EpiMerge {
    static constexpr bool PERM = true;
    const bf16_t* G; const float* SSQ; bf16_t* O;
    __device__ __forceinline__ bool keep(const Unit& u) const { return u.sel < 2; }
    __device__ __forceinline__ void operator()(f32x4 (&acc)[2][2][4][2], const Unit& u, int wr, int wc, int fr, int fq) const {
        const int row0 = u.pm * BM + wr * 64 + fr, col0 = u.pn * BM + wc * 32 + 8 * fq; const int sel = u.sel;
#pragma unroll
        for (int ai = 0; ai < 2; ++ai)
#pragma unroll
            for (int m = 0; m < 4; ++m) { const size_t row = (size_t)(row0 + ai * HALF + m * 16);
                const f32x4 q0 = *(const f32x4*)(SSQ + row * 8), q1 = *(const f32x4*)(SSQ + row * 8 + 4);
                const float s1 = rsqrtf(((q0[0] + q0[1]) + (q0[2] + q0[3]) + (q1[0] + q1[1]) + (q1[2] + q1[3])) * (1.f / 512.f) + EPS);
#pragma unroll
                for (int bj = 0; bj < 2; ++bj) { const bf16_t* gp = G + row * NGATE + col0 + bj * HALF;
                    float f[8];
                    if (sel == 0) { const u32x4 a = *(const u32x4*)(gp), b = *(const u32x4*)(gp + 1024);
#pragma unroll
                        for (int t = 0; t < 4; ++t) { f[2 * t] = bf2f(a[t] & 0xffffu) * __builtin_amdgcn_rcpf(s1 * bf2f(b[t] & 0xffffu)); f[2 * t + 1] = bf2f(a[t] >> 16) * __builtin_amdgcn_rcpf(s1 * bf2f(b[t] >> 16)); } }
                    else if (sel == 1) { const u32x4 a = *(const u32x4*)(gp + 1024), b = *(const u32x4*)(gp + 2048);
#pragma unroll
                        for (int t = 0; t < 4; ++t) { f[2 * t] = s1 * bf2f(a[t] & 0xffffu) * __builtin_amdgcn_rcpf(bf2f(b[t] & 0xffffu)); f[2 * t + 1] = s1 * bf2f(a[t] >> 16) * __builtin_amdgcn_rcpf(bf2f(b[t] >> 16)); } }
                    else { const u32x4 a = *(const u32x4*)(gp + 2048);
#pragma unroll
                        for (int t = 0; t < 4; ++t) { f[2 * t] = bf2f(a[t] & 0xffffu); f[2 * t + 1] = bf2f(a[t] >> 16); } }
                    f32x4 v0 = acc[ai][bj][m][0], v1 = acc[ai][bj][m][1];
#pragma unroll
                    for (int e = 0; e < 4; ++e) { v0[e] *= f[e]; v1[e] *= f[4 + e]; }
                    if (sel == 2) { u32x4 w; w.x = pk2(v0[0], v0[1]); w.y = pk2(v0[2], v0[3]); w.z = pk2(v1[0], v1[1]); w.w = pk2(v1[2], v1[3]);
                        *(u32x4*)(O + row * DM + col0 + bj * HALF) = w; }
                    else { acc[ai][bj][m][0] = v0; acc[ai][bj][m][1] = v1; } } }
    }
};
struct EpiInProj {
    static constexpr bool PERM = true;
    unsigned char* ws; float* DT;
    const float *qnw, *knw, *dtb; const f32x2 *atab, *rtab;
    __device__ __forceinline__ bool keep(const Unit&) const { return false; }
    __device__ __forceinline__ void store8(bf16_t* p, const float* v) const { u32x4 w; w.x = pk2(v[0], v[1]); w.y = pk2(v[2], v[3]); w.z = pk2(v[4], v[5]); w.w = pk2(v[6], v[7]); *(u32x4*)p = w; }
    __device__ __forceinline__ void operator()(f32x4 (&acc)[2][2][4][2], const Unit& u, int wr, int wc, int fr, int fq) const {
        const int pn = u.pn, j = u.pm % 33; const bool isctx = (j == 0);
        const int rowt = u.pm * BM + wr * 64 + fr, post = j * 256 + wr * 64 + fr;
        if (pn <= 2) {
            const bool isv = (pn == 2 && wc >= 2), isk = (pn == 2 && wc < 2);
            const float* nw = isk ? knw : qnw;
#pragma unroll
            for (int ai = 0; ai < 2; ++ai)
#pragma unroll
                for (int m = 0; m < 4; ++m) {
                    const size_t row = (size_t)(rowt + ai * HALF + m * 16); const int pos = post + ai * HALF + m * 16;
                    float v[2][8];
#pragma unroll
                    for (int bj = 0; bj < 2; ++bj)
#pragma unroll
                        for (int t = 0; t < 8; ++t) v[bj][t] = acc[ai][bj][m][t >> 2][t & 3];
                    if (!isv) {
                        float ss = 0.f;
#pragma unroll
                        for (int bj = 0; bj < 2; ++bj)
#pragma unroll
                            for (int t = 0; t < 8; ++t) ss += v[bj][t] * v[bj][t];
                        ss += shx(ss, 16, fq * 16 + fr); ss += shx(ss, 32, fq * 16 + fr);
                        const float rstd = rsqrtf(ss * (1.f / 64.f) + EPS);
#pragma unroll
                        for (int bj = 0; bj < 2; ++bj) { const f32x4 wa = *(const f32x4*)(nw + 32 * bj + 8 * fq), wb = *(const f32x4*)(nw + 32 * bj + 8 * fq + 4);
#pragma unroll
                            for (int t = 0; t < 4; ++t) { v[bj][t] = v[bj][t] * rstd * wa[t]; v[bj][4 + t] = v[bj][4 + t] * rstd * wb[t]; } }
                        if (!isctx) {
                            const f32x4* tp = (const f32x4*)(atab + (size_t)(pos - NCTX) * 32 + 8 * fq);
#pragma unroll
                            for (int t2 = 0; t2 < 4; ++t2) { const f32x4 cs = tp[t2];
                                { const float x1 = v[0][2 * t2], x2 = v[1][2 * t2]; v[0][2 * t2] = x1 * cs[0] - x2 * cs[1]; v[1][2 * t2] = x1 * cs[1] + x2 * cs[0]; }
                                { const float x1 = v[0][2 * t2 + 1], x2 = v[1][2 * t2 + 1]; v[0][2 * t2 + 1] = x1 * cs[2] - x2 * cs[3]; v[1][2 * t2 + 1] = x1 * cs[3] + x2 * cs[2]; } }
                        }
                        if (pn < 2) {
#pragma unroll
                            for (int bj = 0; bj < 2; ++bj)
#pragma unroll
                                for (int t = 0; t < 8; ++t) v[bj][t] *= QC2;
                        }
                    }
                    const size_t doff = (pn < 2) ? OFF_Q + (row * 512 + 64 * (4 * pn + wc) + 8 * fq) * 2
                                                 : OFF_KV + (row * 256 + (isk ? 64 * wc : 128 + 64 * (wc - 2)) + 8 * fq) * 2;
                    bf16_t* dst = (bf16_t*)(ws + doff);
                    store8(dst, v[0]); store8(dst + 32, v[1]);
                    asm volatile("" ::: "memory");
                }
        } else if (pn >= 9 && pn <= 12) {
            const bool isk = pn >= 11; const int head = 2 * ((pn - 9) & 1) + (wc >> 1);
            bf16_t* dbase = (bf16_t*)(ws + (isk ? OFF_RK : OFF_RQ)) + 128 * head + 32 * (wc & 1) + 8 * fq;
            const float sc = isk ? 0.08838834764831845f : 1.f;
#pragma unroll
            for (int ai = 0; ai < 2; ++ai)
#pragma unroll
                for (int m = 0; m < 4; ++m) {
                    const size_t row = (size_t)(rowt + ai * HALF + m * 16); const int pos = post + ai * HALF + m * 16;
                    const f32x4* tp = (const f32x4*)(rtab + (size_t)pos * 64 + 32 * (wc & 1) + 8 * fq);
                    float o1[8], o2[8];
#pragma unroll
                    for (int t2 = 0; t2 < 4; ++t2) { const f32x4 cs = tp[t2];
                        { const int t = 2 * t2; const float x1 = acc[ai][0][m][t >> 2][t & 3], x2 = acc[ai][1][m][t >> 2][t & 3]; o1[t] = (x1 * cs[0] - x2 * cs[1]) * sc; o2[t] = (x1 * cs[1] + x2 * cs[0]) * sc; }
                        { const int t = 2 * t2 + 1; const float x1 = acc[ai][0][m][t >> 2][t & 3], x2 = acc[ai][1][m][t >> 2][t & 3]; o1[t] = (x1 * cs[2] - x2 * cs[3]) * sc; o2[t] = (x1 * cs[3] + x2 * cs[2]) * sc; } }
                    store8(dbase + row * 512, o1); store8(dbase + row * 512 + 64, o2);
                    asm volatile("" ::: "memory");
                }
        } else if (pn == 17) {
            if (wc == 0 && fq < 2) {
                float bb[8];
#pragma unroll
                for (int t = 0; t < 8; ++t) bb[t] = dtb[8 * fq + t];
#pragma unroll
                for (int ai = 0; ai < 2; ++ai)
#pragma unroll
                    for (int m = 0; m < 4; ++m) { const size_t row = (size_t)(rowt + ai * HALF + m * 16); f32x4 o[2];
#pragma unroll
                        for (int t = 0; t < 8; ++t) { const float x = acc[ai][0][m][t >> 2][t & 3] + bb[t]; o[t >> 2][t & 3] = x > 20.f ? x : log1pf(__expf(x)); }
                        *(f32x4*)(DT + row * 16 + 8 * fq) = o[0]; *(f32x4*)(DT + row * 16 + 8 * fq + 4) = o[1]; }
            }
        } else {
            size_t doff; int ld, cb;
            if (pn <= 4) { doff = OFF_Z; ld = 512; cb = (pn - 3) * 256; } else if (pn <= 8) { doff = OFF_XBC; ld = 1024; cb = (pn - 5) * 256; }
            else if (pn <= 14) { doff = OFF_RV; ld = 512; cb = (pn - 13) * 256; } else { doff = OFF_RG; ld = 512; cb = (pn - 15) * 256; }
            bf16_t* dst = (bf16_t*)(ws + doff);
            cb += wc * 32 + 8 * fq;
#pragma unroll
            for (int ai = 0; ai < 2; ++ai)
#pragma unroll
                for (int m = 0; m < 4; ++m) { bf16_t* rowp = dst + (size_t)(rowt + ai * HALF + m * 16) * ld + cb;
#pragma unroll
                    for (int bj = 0; bj < 2; ++bj) { const f32x4 v0 = acc[ai][bj][m][0], v1 = acc[ai][bj][m][1];
                        u32x4 w; w.x = pk2(v0[0], v0[1]); w.y = pk2(v0[2], v0[3]); w.z = pk2(v1[0], v1[1]); w.w = pk2(v1[2], v1[3]);
                        *(u32x4*)(rowp + bj * HALF) = w; } }
        }
    }
};
template <class Epi, class Sched, bool ALIGN_EPI = false, bool SP2 = false>
__device__ __forceinline__ void gemm_phase(PG8_LAS unsigned char* lds, const Gemm g, const Sched& S, const Epi& E, const int tid_in) {
    const int tid = tid_in, wid = __builtin_amdgcn_readfirstlane(tid >> 6), lane = tid & 63, wr = wid >> 2, wc = wid & 3, fr = lane & 15, fq = lane >> 4;
    const int K = g.K, nt = K / BK;
    unsigned voffA[2], voffB[2];
#pragma unroll
    for (int i = 0; i < 2; ++i) { int R, C; stage_rc(tid * 16 + i * 8192, R, C); const int Rb = Epi::PERM ? ((R & ~31) + perm32(R & 31)) : R;
        voffA[i] = (unsigned)(R * (g.packA ? BK : g.ld) + C) * 2u; voffB[i] = (unsigned)(Rb * (g.packB ? BK : g.ld) + C) * 2u; }
    const size_t kstep = g.packA ? (size_t)(BM * BK * 2) : (size_t)(BK * 2), kstepB = g.packB ? (size_t)(BM * BK * 2) : (size_t)(BK * 2);
    const size_t hstep = g.packA ? (size_t)(HALF * BK * 2) : (size_t)HALF * g.ld * 2, hstepB = g.packB ? (size_t)(HALF * BK * 2) : (size_t)HALF * g.ld * 2;
    const size_t tstep = (size_t)BM * g.ld * 2, tstepB = tstep;
    const unsigned ldsw = (unsigned)wid * 1024u;
    const int aoff = lds_byte(wr * 64 + fr, fq * 8), boff = lds_byte(wc * 32 + fr, fq * 8);
#define PG8_SA(b, h) (((b) * 2 + (h)) * HTB)
#define PG8_SB(b, h) ((4 + (b) * 2 + (h)) * HTB)
#define PG8_STAGE(bufoff, gbase, voff) do { _Pragma("unroll") for (int _i = 0; _i < 2; ++_i) \
        __builtin_amdgcn_global_load_lds((const unsigned*)((const char*)(gbase) + (voff)[_i]), (PG8_LAS unsigned*)(lds + (bufoff) + ldsw + _i * 8192), 16, 0, 0); } while (0)
#define PG8_LDA(dst, b, h) do { _Pragma("unroll") for (int m = 0; m < 4; ++m) _Pragma("unroll") for (int k = 0; k < 2; ++k) dst[m][k] = *(const PG8_LAS bf16x8*)(lds + PG8_SA(b, h) + aoff + m * 2048 + k * 1024); } while (0)
#define PG8_LDB(dst, b, h) do { _Pragma("unroll") for (int n = 0; n < 2; ++n) _Pragma("unroll") for (int k = 0; k < 2; ++k) dst[n][k] = *(const PG8_LAS bf16x8*)(lds + PG8_SB(b, h) + boff + n * 2048 + k * 1024); } while (0)
#define PG8_MMA(ai, bj, At, Bt) do { __builtin_amdgcn_s_setprio(1); _Pragma("unroll") for (int m = 0; m < 4; ++m) _Pragma("unroll") for (int n = 0; n < 2; ++n) _Pragma("unroll") for (int k = 0; k < 2; ++k) \
        acc[ai][bj][m][n] = __builtin_amdgcn_mfma_f32_16x16x32_bf16(Bt[n][k], At[m][k], acc[ai][bj][m][n], 0, 0, 0); __builtin_amdgcn_s_setprio(0); } while (0)
#define PG8_WAIT_V(n) asm volatile("s_waitcnt vmcnt(" #n ")" ::: "memory")
#define PG8_WAIT_L(n) asm volatile("s_waitcnt lgkmcnt(" #n ")" ::: "memory")
#define PG8_BAR __builtin_amdgcn_s_barrier()
#define PG8_SCHED __builtin_amdgcn_sched_barrier(0)
    Unit cur, nxt; int ui = 0;
    if (!S.next(0, cur)) return;
    f32x4 acc[2][2][4][2];
#pragma unroll
    for (int a = 0; a < 2; ++a)
#pragma unroll
        for (int b = 0; b < 2; ++b)
#pragma unroll
            for (int m = 0; m < 4; ++m)
#pragma unroll
                for (int n = 0; n < 2; ++n) acc[a][b][m][n] = (f32x4){0.f, 0.f, 0.f, 0.f};
    bf16x8 At[4][2], B0[2][2], B1[2][2];
    const char* cA = g.a(cur.sel) + (size_t)cur.pm * tstep; const char* cB = g.b(cur.sel) + (size_t)cur.pn * tstepB;
    S.a_ready(cur);
    if constexpr (SP2) {
        PG8_STAGE(PG8_SB(0, 0), cB, voffB); PG8_STAGE(PG8_SB(0, 1), cB + hstepB, voffB); PG8_STAGE(PG8_SA(0, 0), cA, voffA); PG8_STAGE(PG8_SA(0, 1), cA + hstep, voffA);
        if (wr == 1) PG8_BAR;
        PG8_WAIT_V(2); PG8_BAR;
        PG8_STAGE(PG8_SB(1, 0), cB + kstepB, voffB); PG8_STAGE(PG8_SA(1, 0), cA + kstep, voffA); PG8_STAGE(PG8_SB(1, 1), cB + hstepB + kstepB, voffB);
        PG8_WAIT_V(6); PG8_BAR;
    } else {
        PG8_STAGE(PG8_SB(0, 0), cB, voffB); PG8_STAGE(PG8_SA(0, 0), cA, voffA); PG8_STAGE(PG8_SB(0, 1), cB + hstepB, voffB); PG8_STAGE(PG8_SA(0, 1), cA + hstep, voffA);
        if (wr == 1) PG8_BAR;
        PG8_WAIT_V(4); PG8_BAR;
        PG8_STAGE(PG8_SB(1, 0), cB + kstepB, voffB); PG8_STAGE(PG8_SA(1, 0), cA + kstep, voffA); PG8_STAGE(PG8_SB(1, 1), cB + hstepB + kstepB, voffB);
        PG8_WAIT_V(6); PG8_BAR;
    }
    for (;;) {
        const bool has_next = S.next(ui + 1, nxt);
        const char* nA = has_next ? g.a(nxt.sel) + (size_t)nxt.pm * tstep : cA; const char* nB = has_next ? g.b(nxt.sel) + (size_t)nxt.pn * tstepB : cB;
        for (int t = 0; t < nt; t += 2) {
            const bool last = (t == nt - 2);
            const char* a1 = cA + (size_t)(t + 1) * kstep;
            const char* a2 = last ? nA : cA + (size_t)(t + 2) * kstep; const char* b2 = last ? nB : cB + (size_t)(t + 2) * kstepB;
            const char* a3 = a2 + kstep; const char* b3 = b2 + kstepB;
            if (last && has_next) S.a_ready(nxt);
            if constexpr (SP2) {
            PG8_LDB(B0, 0, 0); PG8_LDB(B1, 0, 1); PG8_SCHED; PG8_LDA(At, 0, 0); PG8_STAGE(PG8_SA(1, 1), a1 + hstep, voffA);
            PG8_WAIT_V(8); PG8_WAIT_L(0); PG8_BAR; PG8_MMA(0, 0, At, B0); PG8_MMA(0, 1, At, B1); PG8_BAR; PG8_SCHED;
            PG8_LDA(At, 0, 1); PG8_STAGE(PG8_SB(0, 0), b2, voffB); PG8_STAGE(PG8_SB(0, 1), b2 + hstepB, voffB); PG8_STAGE(PG8_SA(0, 0), a2, voffA);
            PG8_WAIT_V(8); PG8_WAIT_L(0); PG8_BAR; PG8_MMA(1, 0, At, B0); PG8_MMA(1, 1, At, B1); PG8_BAR; PG8_SCHED;
            PG8_LDB(B0, 1, 0); PG8_LDB(B1, 1, 1); PG8_SCHED; PG8_LDA(At, 1, 0); PG8_STAGE(PG8_SA(0, 1), a2 + hstep, voffA);
            PG8_WAIT_V(8); PG8_WAIT_L(0); PG8_BAR; PG8_MMA(0, 0, At, B0); PG8_MMA(0, 1, At, B1); PG8_BAR; PG8_SCHED;
            PG8_LDA(At, 1, 1); PG8_STAGE(PG8_SB(1, 0), b3, voffB); PG8_STAGE(PG8_SB(1, 1), b3 + hstepB, voffB); PG8_STAGE(PG8_SA(1, 0), a3, voffA);
            PG8_WAIT_V(8); PG8_WAIT_L(0); PG8_BAR; PG8_MMA(1, 0, At, B0); PG8_MMA(1, 1, At, B1); PG8_BAR; PG8_SCHED;
            } else {
            PG8_LDB(B0, 0, 0); PG8_SCHED; PG8_LDA(At, 0, 0); PG8_STAGE(PG8_SA(1, 1), a1 + hstep, voffA);
            PG8_WAIT_L(8); PG8_BAR; PG8_WAIT_L(0); PG8_MMA(0, 0, At, B0); PG8_BAR; PG8_SCHED;
            PG8_LDB(B1, 0, 1); PG8_STAGE(PG8_SB(0, 0), b2, voffB);
            PG8_BAR; PG8_WAIT_L(0); PG8_MMA(0, 1, At, B1); PG8_BAR;
            PG8_LDA(At, 0, 1); PG8_STAGE(PG8_SA(0, 0), a2, voffA);
            PG8_BAR; PG8_WAIT_L(0); PG8_MMA(1, 0, At, B0); PG8_BAR; PG8_SCHED;
            PG8_STAGE(PG8_SB(0, 1), b2 + hstepB, voffB);
            PG8_WAIT_V(6); PG8_BAR; PG8_MMA(1, 1, At, B1); PG8_BAR;
            PG8_LDB(B0, 1, 0); PG8_SCHED; PG8_LDA(At, 1, 0); PG8_STAGE(PG8_SA(0, 1), a2 + hstep, voffA);
            PG8_WAIT_L(8); PG8_BAR; PG8_WAIT_L(0); PG8_MMA(0, 0, At, B0); PG8_BAR; PG8_SCHED;
            PG8_LDB(B1, 1, 1); PG8_STAGE(PG8_SB(1, 0), b3, voffB);
            PG8_BAR; PG8_WAIT_L(0); PG8_MMA(0, 1, At, B1); PG8_BAR;
            PG8_LDA(At, 1, 1); PG8_STAGE(PG8_SA(1, 0), a3, voffA);
            PG8_BAR; PG8_WAIT_L(0); PG8_MMA(1, 0, At, B0); PG8_BAR; PG8_SCHED;
            PG8_STAGE(PG8_SB(1, 1), b3 + hstepB, voffB);
            PG8_WAIT_V(6); PG8_BAR; PG8_MMA(1, 1, At, B1); PG8_BAR;
            }
        }
        if constexpr (ALIGN_EPI) { if (wr == 0) PG8_BAR; }
        E(acc, cur, wr, wc, fr, fq);
        if (!has_next) break;
        if (!E.keep(cur)) {
#pragma unroll
        for (int a = 0; a < 2; ++a)
#pragma unroll
            for (int b = 0; b < 2; ++b)
#pragma unroll
                for (int m = 0; m < 4; ++m)
#pragma unroll
                    for (int n = 0; n < 2; ++n) acc[a][b][m][n] = (f32x4){0.f, 0.f, 0.f, 0.f}; }
        cur = nxt; cA = nA; cB = nB; ++ui;
        if constexpr (ALIGN_EPI) { if (wr == 1) PG8_BAR; }
    }
    PG8_WAIT_V(0);
    if constexpr (!ALIGN_EPI) { if (wr == 0) PG8_BAR; }
    PG8_BAR;

#undef PG8_SA
#undef PG8_SB
#undef PG8_STAGE
#undef PG8_LDA
#undef PG8_LDB
#undef PG8_MMA
#undef PG8_WAIT_V
#undef PG8_WAIT_L
#undef PG8_BAR
#undef PG8_SCHED
}
}
#include <hip/hip_bf16.h>
namespace attn_body {
using bf16=__hip_bfloat16;
using bf16x8=__attribute__((ext_vector_type(8)))short;
using s16x4=__attribute__((ext_vector_type(4)))short;
using f32x16=__attribute__((ext_vector_type(16)))float;
using u32x4=__attribute__((ext_vector_type(4)))unsigned;
constexpr int BATCH=2,NHEAD=16,SEQ=8192,D=64,DM=NHEAD*D;
constexpr int NW=8,QBLK=32,QB=QBLK*NW,KVBLK=64,NQB=SEQ/QB;
constexpr int ATTN_PITCH=DM, ATTN_UNIT_ROWS=QB;
__device__ __forceinline__ int crow(int r,int hi){return (r&3)+8*(r>>2)+4*hi;}
#define SBAR() __builtin_amdgcn_sched_barrier(0)
constexpr int NSLOT=3, SLOTB=8192;
constexpr int LDS_K=0, LDS_V=NSLOT*SLOTB, LDS_WS=2*NSLOT*SLOTB, LDS_OST=LDS_WS+NW*64*4, LDS_BYTES=LDS_OST+NW*4096;
constexpr float C2=0.125f*1.4426950408889634f;
__device__ __forceinline__ void glds16(const void*gsrc,unsigned lds_dst){unsigned keep;
  asm volatile("s_mov_b32 %0, m0\n\ts_mov_b32 m0, %2\n\ts_nop 0\n\tglobal_load_lds_dwordx4 %1, off\n\ts_mov_b32 m0, %0":"=&s"(keep):"v"(gsrc),"s"(lds_dst):"memory");}
__device__ __forceinline__ float max3f(float a,float b,float c){float r;asm("v_max3_f32 %0, %1, %2, %3":"=v"(r):"v"(a),"v"(b),"v"(c));return r;}
__device__ __forceinline__ float max2f(float a,float b){float r;asm("v_max_f32_e32 %0, %1, %2":"=v"(r):"v"(a),"v"(b));return r;}
__device__ __forceinline__ float fadd_s(float a,float b){float r;asm("v_add_f32_e32 %0, %1, %2":"=v"(r):"v"(a),"v"(b));return r;}
__device__ __forceinline__ float fsub_s(float a,float b){float r;asm("v_sub_f32_e32 %0, %1, %2":"=v"(r):"v"(a),"v"(b));return r;}
typedef float f32x2_t __attribute__((ext_vector_type(2))); typedef __bf16 bf16x2_t __attribute__((ext_vector_type(2)));
__device__ __forceinline__ unsigned cvtpk_s(float lo,float hi){f32x2_t v={lo,hi};bf16x2_t b=__builtin_convertvector(v,bf16x2_t);return __builtin_bit_cast(unsigned,b);}
#define WAIT_BAR(N) asm volatile("s_waitcnt vmcnt(" #N ") lgkmcnt(0)\n\ts_barrier":::"memory")

__device__ __forceinline__ void qkt(f32x16&p0,f32x16&p1,const char*Kslot,const bf16x8*qr,const f32x16&negm,int r32,int hi){
  const char*kb=Kslot+hi*1024+r32*16;
  #pragma unroll
  for(int d0=0;d0<4;++d0){
    const bf16x8 b0=*reinterpret_cast<const bf16x8*>(kb+d0*2048);
    const bf16x8 b1=*reinterpret_cast<const bf16x8*>(kb+d0*2048+512);
    if(d0==0){p0=__builtin_amdgcn_mfma_f32_32x32x16_bf16(b0,qr[0],negm,0,0,0);p1=__builtin_amdgcn_mfma_f32_32x32x16_bf16(b1,qr[0],negm,0,0,0);}
    else{p0=__builtin_amdgcn_mfma_f32_32x32x16_bf16(b0,qr[d0],p0,0,0,0);p1=__builtin_amdgcn_mfma_f32_32x32x16_bf16(b1,qr[d0],p1,0,0,0);}}
}
typedef __attribute__((address_space(3))) const char* lds_cptr;
typedef short v4i16_t __attribute__((ext_vector_type(4)));
__device__ __forceinline__ void kload8(bf16x8*kf,lds_cptr kp){
  kf[0]=*(const __attribute__((address_space(3))) bf16x8*)(kp);      kf[1]=*(const __attribute__((address_space(3))) bf16x8*)(kp+512);
  kf[2]=*(const __attribute__((address_space(3))) bf16x8*)(kp+2048); kf[3]=*(const __attribute__((address_space(3))) bf16x8*)(kp+2560);
  kf[4]=*(const __attribute__((address_space(3))) bf16x8*)(kp+4096); kf[5]=*(const __attribute__((address_space(3))) bf16x8*)(kp+4608);
  kf[6]=*(const __attribute__((address_space(3))) bf16x8*)(kp+6144); kf[7]=*(const __attribute__((address_space(3))) bf16x8*)(kp+6656);
}
__device__ __forceinline__ void kload2(bf16x8*kf,lds_cptr kp,int j){ kf[2*j]=*(const __attribute__((address_space(3))) bf16x8*)(kp+j*2048); kf[2*j+1]=*(const __attribute__((address_space(3))) bf16x8*)(kp+j*2048+512); }
__device__ __forceinline__ s16x4 vtr(lds_cptr p){ return __builtin_bit_cast(s16x4,__builtin_amdgcn_ds_read_tr16_b64_v4i16((__attribute__((address_space(3))) v4i16_t*)p)); }
__device__ __forceinline__ float rowmax(const f32x16&p0,const f32x16&p1){
  float a=max3f(p0[0],p0[1],p1[0]),b=max3f(p0[2],p0[3],p1[1]);a=max3f(a,p1[2],p1[3]);
  #pragma unroll
  for(int r=4;r<16;r+=4){a=max3f(a,p0[r],p0[r+1]);b=max3f(b,p0[r+2],p0[r+3]);a=max3f(a,p1[r],p1[r+1]);b=max3f(b,p1[r+2],p1[r+3]);}
  const float m=max2f(a,b);
  auto rr=__builtin_amdgcn_permlane32_swap(__float_as_uint(m),__float_as_uint(m),false,false);
  return max2f(__uint_as_float(rr[0]),__uint_as_float(rr[1]));
}
__device__ __forceinline__ void pv(f32x16*o,int vb,bf16x8 pa0,bf16x8 pa1,bf16x8 pa2,bf16x8 pa3){
  #pragma unroll
  for(int d0=0;d0<2;++d0){s16x4 lo[4],hi[4];
    #pragma unroll
    for(int ks=0;ks<4;++ks){
      asm volatile("ds_read_b64_tr_b16 %0,%1 offset:%c2":"=&v"(lo[ks]):"v"(vb),"i"(d0*4096+ks*1024):"memory");
      asm volatile("ds_read_b64_tr_b16 %0,%1 offset:%c2":"=&v"(hi[ks]):"v"(vb),"i"(d0*4096+ks*1024+512):"memory");}
    asm volatile("s_waitcnt lgkmcnt(0)":::"memory");SBAR();
    #define PK(k) (bf16x8){lo[k][0],lo[k][1],lo[k][2],lo[k][3],hi[k][0],hi[k][1],hi[k][2],hi[k][3]}
    o[d0]=__builtin_amdgcn_mfma_f32_32x32x16_bf16(pa0,PK(0),o[d0],0,0,0);
    o[d0]=__builtin_amdgcn_mfma_f32_32x32x16_bf16(pa1,PK(1),o[d0],0,0,0);
    o[d0]=__builtin_amdgcn_mfma_f32_32x32x16_bf16(pa2,PK(2),o[d0],0,0,0);
    o[d0]=__builtin_amdgcn_mfma_f32_32x32x16_bf16(pa3,PK(3),o[d0],0,0,0);
    #undef PK
  }
}
#define ATTN_STORE16(p,v) (*(u32x4*)(p)=(v))
template<int THRL> __device__ __forceinline__ void attn_unit(long qrow0,long krow0,int NT,const bf16*Q,const bf16*__restrict__ K,const bf16*__restrict__ V,bf16*O,char*shm,const int tid_in){
  const int tid=tid_in,lane=tid&63,r32=lane&31,hi=lane>>5; const int wid=__builtin_amdgcn_readfirstlane(tid>>6);
  constexpr int PQ=512,PK=256;
  const bf16*Qw=Q+(qrow0+wid*QBLK)*PQ;
  const bf16*Kh=K+krow0*PK,*Vh=V+krow0*PK;
  const unsigned lds0=(unsigned)(uintptr_t)shm;
  float*wsf=(float*)(shm+LDS_WS)+wid*64;
  const bf16*ksrc=Kh+(long)lane*PK+wid*8;
  const bf16*vsrc=Vh+(long)(16*(wid&3)+(lane>>2))*PK+(wid>>2)*32+(lane&3)*8;
  const unsigned kdst=lds0+LDS_K+wid*1024, vdst=lds0+LDS_V+wid*1024;
  #define DMA_K(t,slot) glds16(ksrc+(long)(t)*KVBLK*PK,(unsigned)__builtin_amdgcn_readfirstlane(kdst+(slot)))
  #define DMA_V(t,slot) glds16(vsrc+(long)(t)*KVBLK*PK,(unsigned)__builtin_amdgcn_readfirstlane(vdst+(slot)))
  const int vb0=(int)(lds0+LDS_V)+((lane>>4)&1)*32+(lane&3)*8+(4*hi+((lane&15)>>2))*64;
  const char*Kbase=shm+LDS_K; bf16x8 kf[8];
  const lds_cptr shm3=(lds_cptr)shm; const lds_cptr kp0=shm3+LDS_K+hi*1024+r32*16; const lds_cptr vp0=shm3+LDS_V+((lane>>4)&1)*32+(lane&3)*8+(4*hi+((lane&15)>>2))*64;

  DMA_K(0,0);DMA_V(0,0);DMA_K(1,SLOTB);
  bf16x8 qr[4];
  #pragma unroll
  for(int d0=0;d0<4;++d0)qr[d0]=*reinterpret_cast<const bf16x8*>(&Qw[(long)r32*PQ+d0*16+hi*8]);
  float mhat=0.f,l_reg=0.f;f32x16 o[2];o[0]=f32x16{};o[1]=f32x16{};f32x16 negm=f32x16{};asm volatile("":"+v"(negm));

  #define CMASK(P0,P1,t) do{}while(0)
  bool resc=false;
  #define START(P0,P1) do{ const float rm=rowmax(P0,P1); resc=false; \
    { const float dl=rm; mhat=fadd_s(mhat,dl); \
      _Pragma("unroll") for(int r=0;r<16;++r){P0[r]=fsub_s(P0[r],dl);P1[r]=fsub_s(P1[r],dl);} \
      _Pragma("unroll") for(int r=0;r<16;++r)negm[r]=-mhat; asm volatile("":"+v"(negm)); } \
    _Pragma("unroll") for(int r=0;r<16;++r)P0[r]=__builtin_amdgcn_exp2f(P0[r]); }while(0)
  #define RESC() do{ if(resc){ asm volatile("s_waitcnt lgkmcnt(0)":::"memory"); \
      _Pragma("unroll") for(int d_=0;d_<2;++d_) _Pragma("unroll") for(int r=0;r<16;++r)o[d_][r]*=wsf[crow(r,hi)]; } }while(0)
  f32x16 pA0,pA1,pB0,pB1;
  int sl_prev=0,sl_cur=0,sl_next=SLOTB;
  #define ROT() do{sl_prev=sl_cur;sl_cur=sl_next;sl_next=(sl_next==(NSLOT-1)*SLOTB)?0:sl_next+SLOTB;}while(0)
  DMA_K(2,2*SLOTB);
  WAIT_BAR(3);
  qkt(pA0,pA1,Kbase,qr,negm,r32,hi);asm volatile("s_nop 15\n\ts_nop 7":"+v"(pA0),"+v"(pA1));CMASK(pA0,pA1,0);
  START(pA0,pA1);
  _Pragma("unroll") for(int r=0;r<16;++r)pA1[r]=__builtin_amdgcn_exp2f(pA1[r]);
  WAIT_BAR(0);
  DMA_K(3,0);DMA_V(1,SLOTB);
  ROT();
  kload8(kf,kp0+sl_cur);
  WAIT_BAR(2);
  s16x4 vlo[8],vhi[8]; u32x4 pw0,pw1,pw2,pw3;
  #define PKW(P,B) cvtpk_s(P[B],P[B+1])
  #define PAF(k) __builtin_bit_cast(bf16x8,pw##k)
  #define VFR(i) (bf16x8){vlo[i][0],vlo[i][1],vlo[i][2],vlo[i][3],vhi[i][0],vhi[i][1],vhi[i][2],vhi[i][3]}
  #define PIN(x) asm volatile("":"+v"(x))
  #define MX3(a,b,c) __builtin_fmaxf(__builtin_fmaxf((a),(b)),(c))
  #define GAPA(MF,A0,A1,A2,A3,W0,W1,PW) do{ MF; sacc+=A0; sacc+=A1; sacc+=A2; sacc+=A3; PIN(sacc); W0; W1; PIN(PW); SBAR(); }while(0)
  #define EX(v) __builtin_amdgcn_exp2f(v)
  #define GAPB(MF,X,B) do{ MF; X[B]=EX(X[B]); X[B+1]=EX(X[B+1]); X[B+2]=EX(X[B+2]); X[B+3]=EX(X[B+3]); PIN(X); SBAR(); }while(0)
  #define VRD(i) do{ vlo[i]=vtr(vp_+(((i)>>2)*4096+((i)&3)*1024)); vhi[i]=vtr(vp_+(((i)>>2)*4096+((i)&3)*1024+512)); }while(0)
  #define KRD(G,j) do{ if(G){ kload2(kf,kp0+sl_next,j); SBAR(); } }while(0)
  #define STEP(C0,C1,P0,P1,t,GK,GV,GL) do{ SBAR(); \
    const lds_cptr vp_=vp0+sl_prev; \
    VRD(0); SBAR(); float sacc=(P0[0]+P0[1]); \
    GAPA(C0=__builtin_amdgcn_mfma_f32_32x32x16_bf16(kf[0],qr[0],negm,0,0,0), P0[2],P0[3],P0[4],P0[5],     pw0[0]=PKW(P0,0), pw0[1]=PKW(P0,2), pw0); \
    VRD(4); SBAR(); GAPA(C1=__builtin_amdgcn_mfma_f32_32x32x16_bf16(kf[1],qr[0],negm,0,0,0), P0[6],P0[7],P0[8],P0[9],     pw0[2]=PKW(P0,4), pw0[3]=PKW(P0,6), pw0); \
    VRD(1); SBAR(); GAPA(C0=__builtin_amdgcn_mfma_f32_32x32x16_bf16(kf[2],qr[1],C0,0,0,0),   P0[10],P0[11],P0[12],P0[13], pw1[0]=PKW(P0,8), pw1[1]=PKW(P0,10), pw1); \
    VRD(5); SBAR(); GAPA(C1=__builtin_amdgcn_mfma_f32_32x32x16_bf16(kf[3],qr[1],C1,0,0,0),   P0[14],P0[15],P1[0],P1[1],   pw1[2]=PKW(P0,12),pw1[3]=PKW(P0,14), pw1); \
    VRD(2); SBAR(); GAPA(C0=__builtin_amdgcn_mfma_f32_32x32x16_bf16(kf[4],qr[2],C0,0,0,0),   P1[2],P1[3],P1[4],P1[5],     pw2[0]=PKW(P1,0), pw2[1]=PKW(P1,2), pw2); \
    VRD(6); SBAR(); GAPA(C1=__builtin_amdgcn_mfma_f32_32x32x16_bf16(kf[5],qr[2],C1,0,0,0),   P1[6],P1[7],P1[8],P1[9],     pw2[2]=PKW(P1,4), pw2[3]=PKW(P1,6), pw2); \
    VRD(3); SBAR(); GAPA(C0=__builtin_amdgcn_mfma_f32_32x32x16_bf16(kf[6],qr[3],C0,0,0,0),   P1[10],P1[11],P1[12],P1[13], pw3[0]=PKW(P1,8), pw3[1]=PKW(P1,10), pw3); \
    VRD(7); SBAR(); GAPA(C1=__builtin_amdgcn_mfma_f32_32x32x16_bf16(kf[7],qr[3],C1,0,0,0),   P1[14],P1[15],0.f,0.f,       pw3[2]=PKW(P1,12),pw3[3]=PKW(P1,14), pw3); \
    l_reg+=sacc; \
    if(GK){DMA_K((t)+3,sl_cur);} if(GV){DMA_V((t)+1,sl_next);} \
    CMASK(C0,C1,t); \
    { float a=MX3(C0[0],C0[1],C1[0]),b=MX3(C0[2],C0[3],C1[1]); a=MX3(a,C1[2],C1[3]); \
      _Pragma("unroll") for(int r=4;r<16;r+=4){a=MX3(a,C0[r],C0[r+1]);b=MX3(b,C0[r+2],C0[r+3]);a=MX3(a,C1[r],C1[r+1]);b=MX3(b,C1[r+2],C1[r+3]);} \
      float rm=__builtin_fmaxf(a,b); { auto rr=__builtin_amdgcn_permlane32_swap(__float_as_uint(rm),__float_as_uint(rm),false,false); rm=__builtin_fmaxf(__uint_as_float(rr[0]),__uint_as_float(rr[1])); } \
      resc=false; \
      if(__builtin_expect(__any(rm>(float)THRL),0)){ const float dl=__builtin_fmaxf(rm,0.f); mhat+=dl; \
        _Pragma("unroll") for(int r=0;r<16;++r){C0[r]-=dl;C1[r]-=dl;} \
        _Pragma("unroll") for(int r=0;r<16;++r)negm[r]=-mhat; asm volatile("":"+v"(negm)); \
        const float f=__builtin_amdgcn_exp2f(-dl); l_reg*=f; if(hi==0)wsf[r32]=f; resc=true; } } \
    SBAR(); \
    GAPB(o[0]=__builtin_amdgcn_mfma_f32_32x32x16_bf16(PAF(0),VFR(0),o[0],0,0,0), C0,0); \
    GAPB(o[1]=__builtin_amdgcn_mfma_f32_32x32x16_bf16(PAF(0),VFR(4),o[1],0,0,0), C0,4); \
    KRD(GL,0); GAPB(o[0]=__builtin_amdgcn_mfma_f32_32x32x16_bf16(PAF(1),VFR(1),o[0],0,0,0), C0,8); \
    KRD(GL,1); GAPB(o[1]=__builtin_amdgcn_mfma_f32_32x32x16_bf16(PAF(1),VFR(5),o[1],0,0,0), C0,12); \
    KRD(GL,2); GAPB(o[0]=__builtin_amdgcn_mfma_f32_32x32x16_bf16(PAF(2),VFR(2),o[0],0,0,0), C1,0); \
    KRD(GL,3); GAPB(o[1]=__builtin_amdgcn_mfma_f32_32x32x16_bf16(PAF(2),VFR(6),o[1],0,0,0), C1,4); \
    GAPB(o[0]=__builtin_amdgcn_mfma_f32_32x32x16_bf16(PAF(3),VFR(3),o[0],0,0,0), C1,8); \
    GAPB(o[1]=__builtin_amdgcn_mfma_f32_32x32x16_bf16(PAF(3),VFR(7),o[1],0,0,0), C1,12); \
    }while(0)
  int t=1;
  #undef CMASK
  #define CMASK(P0,P1,t) do{}while(0)
  for(;t+5<NT;t+=2){
    STEP(pB0,pB1,pA0,pA1,t,true,true,true);     WAIT_BAR(2); RESC(); ROT();
    STEP(pA0,pA1,pB0,pB1,t+1,true,true,true);   WAIT_BAR(2); RESC(); ROT();
  }
  #undef CMASK
  #define CMASK(P0,P1,t) do{}while(0)
  #define ENDW(tt) do{ if((tt)+3<NT){WAIT_BAR(2);} else if((tt)+2<NT){WAIT_BAR(1);} else {WAIT_BAR(0);} }while(0)
  for(;t+1<NT;t+=2){
    STEP(pB0,pB1,pA0,pA1,t,(t+3<NT),(t+1<NT),(t+1<NT));       ENDW(t);   RESC(); ROT();
    STEP(pA0,pA1,pB0,pB1,t+1,(t+4<NT),(t+2<NT),(t+2<NT));     ENDW(t+1); RESC(); ROT();
  }
  STEP(pB0,pB1,pA0,pA1,NT-1,false,false,false); RESC();
  { float sacc=pB0[0]+pB0[1]; _Pragma("unroll") for(int r=2;r<16;++r)sacc+=pB0[r]; _Pragma("unroll") for(int r=0;r<16;++r)sacc+=pB1[r]; l_reg+=sacc;
    pw0=(u32x4){PKW(pB0,0),PKW(pB0,2),PKW(pB0,4),PKW(pB0,6)};pw1=(u32x4){PKW(pB0,8),PKW(pB0,10),PKW(pB0,12),PKW(pB0,14)};pw2=(u32x4){PKW(pB1,0),PKW(pB1,2),PKW(pB1,4),PKW(pB1,6)};pw3=(u32x4){PKW(pB1,8),PKW(pB1,10),PKW(pB1,12),PKW(pB1,14)};
    SBAR(); pv(o,vb0+sl_cur,PAF(0),PAF(1),PAF(2),PAF(3)); }
  #undef PKW
  #undef PAF
  #undef VFR
  #undef PIN
  #undef MX3
  #undef GAPA
  #undef GAPB
  #undef EX
  #undef VRD
  #undef KRD
  #undef STEP
  #undef ENDW
  {auto rr=__builtin_amdgcn_permlane32_swap(__float_as_uint(l_reg),__float_as_uint(l_reg),false,false);l_reg=__uint_as_float(rr[0])+__uint_as_float(rr[1]);}
  if(hi==0)wsf[32+r32]=l_reg;asm volatile("s_waitcnt lgkmcnt(0)":::"memory");
  float rli[16];
  #pragma unroll
  for(int r=0;r<16;++r)rli[r]=__builtin_amdgcn_rcpf(wsf[32+crow(r,hi)]);
  bf16*Ow=O+(qrow0+wid*QBLK)*PQ;
  { bf16*stg=(bf16*)(shm+LDS_OST)+wid*2048;
    #pragma unroll
    for(int r=0;r<16;++r){const int orow=crow(r,hi);
      #pragma unroll
      for(int d0=0;d0<2;++d0)stg[orow*64+d0*32+r32]=__float2bfloat16(o[d0][r]*rli[r]);}
    asm volatile("s_waitcnt lgkmcnt(0)":::"memory");
    #pragma unroll
    for(int i=0;i<4;++i){const int row=i*8+(lane>>3),ch=lane&7; const u32x4 v=*(const u32x4*)(stg+row*64+ch*8); ATTN_STORE16(Ow+(long)row*PQ+ch*8,v);} }
  asm volatile("s_waitcnt lgkmcnt(0)\n\ts_barrier":::"memory");
  #undef DMA_K
  #undef DMA_V
  #undef CMASK
  #undef START
  #undef RESC
  #undef ROT
}
#undef SBAR
#undef WAIT_BAR
}
#define LAS __attribute__((address_space(3)))
typedef short bf16x8 __attribute__((ext_vector_type(8)));
typedef float f32x4 __attribute__((ext_vector_type(4)));
typedef float f32x2 __attribute__((ext_vector_type(2)));
typedef unsigned u32x4 __attribute__((ext_vector_type(4)));
typedef unsigned u32x2 __attribute__((ext_vector_type(2)));

struct Args {
    const float* in[24]; float* out; unsigned char* ws; int ph_lo, ph_hi;
};

__device__ __forceinline__ float wave_sum(float v, int lane) {
#pragma unroll
    for (int o = 1; o < 64; o <<= 1) v += shx(v, o, lane);
    return v;
}

__device__ __forceinline__ void transpose_item(const float* W, int ldw, int k0, int src0, int nvalid, bf16_t* WT, int K, int dst0, const float* kscale, LAS float* scr, int lane) {
#pragma unroll
    for (int i = 0; i < 32; ++i) { const int kk = 2 * i + (lane >> 5), c = lane & 31;
        float v = (c < nvalid) ? W[(size_t)(k0 + kk) * ldw + src0 + c] : 0.f; if (kscale) v *= kscale[k0 + kk];
        scr[kk * 33 + c] = v; }
    asm volatile("s_waitcnt lgkmcnt(0)" ::: "memory");
    const int c = lane & 7;
#pragma unroll
    for (int j = 0; j < 4; ++j) { const int n = (lane >> 3) + 8 * j; const LAS float* s = scr + (8 * c) * 33 + n;
        u32x4 o; o.x = pk2(s[0 * 33], s[1 * 33]); o.y = pk2(s[2 * 33], s[3 * 33]); o.z = pk2(s[4 * 33], s[5 * 33]); o.w = pk2(s[6 * 33], s[7 * 33]);
        const int row = dst0 + n; *(u32x4*)(WT + ((((size_t)(row >> 8) * (K >> 6) + (k0 >> 6)) * 256 + (row & 255)) * 64) + 8 * c) = o; }
    asm volatile("s_waitcnt lgkmcnt(0)" ::: "memory");
}
__device__ __forceinline__ int inproj_src(int lam0, int& nvalid) {
    nvalid = 32;
    const int t = lam0 >> 8, loc = lam0 & 255, bj = loc >> 7, wc = (loc >> 5) & 3;
    if (t < 2) return 64 * (4 * t + wc) + 32 * bj;
    if (t == 2) return wc < 2 ? 512 + 64 * wc + 32 * bj : 640 + 64 * (wc - 2) + 32 * bj;
    if (t < 9) return lam0;
    if (t < 13) { const int base = t < 11 ? 2320 : 2832, head = 2 * ((t - 9) & 1) + (wc >> 1); return base + 128 * head + 64 * bj + 32 * (wc & 1); }
    if (t < 17) return lam0 + 16;
    if (loc == 0) { nvalid = 16; return 2304; }
    nvalid = 0; return 0;
}

typedef const __attribute__((address_space(4))) Args* CArgsP;
__device__ __forceinline__ void prologue_phase(CArgsP a, LAS unsigned char* lds, int tid, int lane, int wave) {
    unsigned char* ws = a->ws;
    const int G = gridDim.x, gw = blockIdx.x * 8 + wave, NGW = G * 8;
    LAS float* scr = (LAS float*)(lds + wave * 8448);
    constexpr int I1 = 144 * 16, I2 = 96 * 16, I3 = 3 * 32 * 8, I4 = 32 * 16, I5 = 128 * 16, I6 = 32 * 64, IL = I1 + I2 + I3 + I4 + I5 + I6;
    for (int it = gw; it < 2 * IL; it += NGW) {
        const int L = it / IL; int r = it % IL;
        unsigned char* wl = ws + OFF_W + (size_t)L * W_LAYER;
        const float* w_in = a->in[8] + (size_t)L * DM * INDIM;
        if (r < I1) { const int lb = r % 144, kb = r / 144; int nv; const int src = inproj_src(lb * 32, nv);
            transpose_item(w_in, INDIM, kb * 64, src, nv, (bf16_t*)(wl + W_P), DM, lb * 32, nullptr, scr, lane); continue; } r -= I1;
        if (r < I2) { const int lb = r % 96, kb = r / 96;
            transpose_item(w_in, INDIM, kb * 64, 4368 + lb * 32, 32, (bf16_t*)(wl + W_G), DM, lb * 32, nullptr, scr, lane); continue; } r -= I2;
        if (r < I3) { const int i = r / 256, q = r % 256, lb = q % 32, kb = q / 32;
            transpose_item(a->in[19] + ((size_t)L * 3 + i) * 512 * DM, DM, kb * 64, lb * 32, 32, (bf16_t*)(wl + W_B) + (size_t)i * DM * 512, 512, lb * 32,
                           i == 1 ? a->in[16] + L * 512 : nullptr, scr, lane); continue; } r -= I3;
        if (r < I4) { const int lb = r % 32, kb = r / 32;
            transpose_item(a->in[20] + (size_t)L * DM * DM, DM, kb * 64, lb * 32, 32, (bf16_t*)(wl + W_O), DM, lb * 32, nullptr, scr, lane); continue; } r -= I4;
        if (r < I5) { const int lb = r % 128, kb = r / 128;
            transpose_item(a->in[21] + (size_t)L * DM * HID, HID, kb * 64, lb * 32, 32, (bf16_t*)(wl + W_1), DM, lb * 32, nullptr, scr, lane); continue; } r -= I5;
        { const int lb = r % 32, kb = r / 32;
            transpose_item(a->in[22] + (size_t)L * HID * DM, DM, kb * 64, lb * 32, 32, (bf16_t*)(wl + W_2), HID, lb * 32, nullptr, scr, lane); }
    }
    { f32x2* atab = (f32x2*)(ws + OFF_ATAB); f32x2* rtab = (f32x2*)(ws + OFF_RTAB);
      const int gt = blockIdx.x * 512 + tid, NT_ = G * 512;
      for (int i = gt; i < NLAT * 32; i += NT_) { const int p = i >> 5, f = i & 31;
          const float inv = exp2f(-(float)(f & 15) * (13.287712379549449f / 16.f)); const float ang = (float)(f < 16 ? (p >> 6) : (p & 63)) * inv;
          const double rv = (double)ang * 0.15915494309189535; const float fr_ = (float)(rv - __builtin_rint(rv));
          atab[i] = (f32x2){__builtin_amdgcn_cosf(fr_), __builtin_amdgcn_sinf(fr_)}; }
      for (int i = gt; i < SA * 64; i += NT_) { const int p = i >> 6, f = i & 63;
          const float inv = exp2f(-((float)f / 63.f) * 13.287712379549449f); const float ang = (float)p * inv;
          const double rv = (double)ang * 0.15915494309189535; const float fr_ = (float)(rv - __builtin_rint(rv));
          rtab[i] = (f32x2){__builtin_amdgcn_cosf(fr_), __builtin_amdgcn_sinf(fr_)}; } }
    { LAS float* sc = (LAS float*)(lds + 73728);
      LAS float* red = (LAS float*)(lds + 98304);
      __syncthreads();
      for (int i = tid; i < 5 * DM; i += 512) { const int r = i >> 10, k = i & 1023; const float x = r < 4 ? a->in[1][r * DM + k] : a->in[3][k]; sc[i] = siluf(x); }
      __syncthreads();
      float* mod = (float*)(ws + OFF_MOD);
      for (int it = blockIdx.x; it < 2 * 96; it += G) { const int L = it / 96, cb = (it % 96) * 64;
          const float* wm = a->in[4] + (size_t)L * DM * MODW + cb + lane;
          float acc[5] = {0.f, 0.f, 0.f, 0.f, 0.f};
#pragma unroll 32
          for (int k = wave * 128; k < wave * 128 + 128; ++k) { const float wv = wm[(size_t)k * MODW];
#pragma unroll
              for (int r = 0; r < 5; ++r) acc[r] += sc[r * DM + k] * wv; }
#pragma unroll
          for (int r = 0; r < 5; ++r) red[(wave * 5 + r) * 64 + lane] = acc[r];
          __syncthreads();
          if (tid < 320) { const int r = tid >> 6, l = tid & 63; float s = 0.f;
#pragma unroll
              for (int w = 0; w < 8; ++w) s += red[(w * 5 + r) * 64 + l];
              mod[((size_t)L * 5 + r) * MODW + cb + l] = s + a->in[5][L * MODW + cb + l]; }
          __syncthreads();
      } }
}

__device__ __forceinline__ void norm_mod_phase(const float* hlat, const float* hctx, const float* w, const float* modL, int shift_idx, int scale_idx, bf16_t* U, int lane, int wave,
                                               const float* part = nullptr, int nparts = 0, const float* pgate = nullptr, float* wb = nullptr) {
    const int gw = blockIdx.x * 8 + wave, NGW = gridDim.x * 8;
    f32x4 wv[4];
#pragma unroll
    for (int j = 0; j < 4; ++j) wv[j] = *(const f32x4*)(w + 4 * lane + 256 * j);
    for (int row0 = gw; row0 < T; row0 += 2 * NGW) {
        f32x4 v[2][4]; float s[2]; const float* mrow[2]; bool ok[2];
#pragma unroll
        for (int q = 0; q < 2; ++q) { const int row = row0 + q * NGW; ok[q] = row < T; const int rr = ok[q] ? row : row0;
            const int b = rr / SA, pos = rr % SA; const bool isctx = pos < NCTX;
            const float* src = isctx ? hctx + (size_t)(b * NCTX + pos) * DM : hlat + (size_t)(b * NLAT + pos - NCTX) * DM;
            mrow[q] = modL + (size_t)(isctx ? 4 : b) * MODW; s[q] = 0.f;
#pragma unroll
            for (int j = 0; j < 4; ++j) v[q][j] = *(const f32x4*)(src + 4 * lane + 256 * j);
            if (part && isctx) {
                const float* pp = part + (size_t)(b * NCTX + pos) * DM + 4 * lane;
#pragma unroll
                for (int j = 0; j < 4; ++j) { f32x4 acc = {0.f, 0.f, 0.f, 0.f};
                    for (int p = 0; p < nparts; ++p) acc += *(const f32x4*)(pp + (size_t)p * (NB * NCTX) * DM + 256 * j);
                    v[q][j] += *(const f32x4*)(pgate + 4 * lane + 256 * j) * acc;
                    if (wb && ok[q]) *(f32x4*)(wb + (size_t)(b * NCTX + pos) * DM + 4 * lane + 256 * j) = v[q][j]; } } }
#pragma unroll
        for (int q = 0; q < 2; ++q) {
#pragma unroll
            for (int j = 0; j < 4; ++j) s[q] += (v[q][j][0] * v[q][j][0] + v[q][j][1] * v[q][j][1]) + (v[q][j][2] * v[q][j][2] + v[q][j][3] * v[q][j][3]);
            const float rstd = rsqrtf(wave_sum(s[q], lane) * (1.f / DM) + EPS);
            if (ok[q]) {
#pragma unroll
                for (int j = 0; j < 4; ++j) { const f32x4 sh = *(const f32x4*)(mrow[q] + shift_idx * DM + 4 * lane + 256 * j), scl = *(const f32x4*)(mrow[q] + scale_idx * DM + 4 * lane + 256 * j);
                    f32x4 y = v[q][j] * rstd * wv[j]; y = y * (scl + 1.f) + sh;
                    u32x2 o; o.x = pk2(y[0], y[1]); o.y = pk2(y[2], y[3]); *(u32x2*)(U + (size_t)(row0 + q * NGW) * DM + 4 * lane + 256 * j) = o; } } }
    }
}
__device__ __forceinline__ void final_norm_phase(float* hlat, const float* w, int lane, int wave) {
    const int gw = blockIdx.x * 8 + wave, NGW = gridDim.x * 8;
    f32x4 wv[4];
#pragma unroll
    for (int j = 0; j < 4; ++j) wv[j] = *(const f32x4*)(w + 4 * lane + 256 * j);
    for (int row0 = gw; row0 < NB * NLAT; row0 += 2 * NGW) {
        f32x4 v[2][4]; bool ok[2];
#pragma unroll
        for (int q = 0; q < 2; ++q) { const int row = row0 + q * NGW; ok[q] = row < NB * NLAT; const float* src = hlat + (size_t)(ok[q] ? row : row0) * DM;
#pragma unroll
            for (int j = 0; j < 4; ++j) v[q][j] = *(const f32x4*)(src + 4 * lane + 256 * j); }
#pragma unroll
        for (int q = 0; q < 2; ++q) { float s = 0.f;
#pragma unroll
            for (int j = 0; j < 4; ++j) s += (v[q][j][0] * v[q][j][0] + v[q][j][1] * v[q][j][1]) + (v[q][j][2] * v[q][j][2] + v[q][j][3] * v[q][j][3]);
            const float rstd = rsqrtf(wave_sum(s, lane) * (1.f / DM) + EPS);
            if (ok[q]) { float* dst = hlat + (size_t)(row0 + q * NGW) * DM;
#pragma unroll
                for (int j = 0; j < 4; ++j) *(f32x4*)(dst + 4 * lane + 256 * j) = v[q][j] * rstd * wv[j]; } }
    }
}
__device__ __forceinline__ void postproj_phase(const bf16_t* __restrict__ XBC, bf16_t* __restrict__ CONV, const float* cw, const float* cb, float* DT, float* Gc, float* CD, const float* a_log, const bf16_t* U, const bf16_t* Wdt, const float* dtb, int tid, int lane, int wave) {
    const int gw = blockIdx.x * 8 + wave, NGW = gridDim.x * 8;
    f32x4 w0[2][2], w1[2][2], w2[2][2], wb[2][2];
#pragma unroll
    for (int j = 0; j < 2; ++j)
#pragma unroll
        for (int h = 0; h < 2; ++h) { const int c = 8 * (lane + 64 * j) + 4 * h;
            w0[j][h] = *(const f32x4*)(cw + c); w1[j][h] = *(const f32x4*)(cw + 1024 + c); w2[j][h] = *(const f32x4*)(cw + 2048 + c); wb[j][h] = *(const f32x4*)(cb + c); }
#pragma unroll 2
    for (int row = gw; row < T; row += NGW) {
        const int pos = row % SA;
        const bool hasp = (pos != 0 && pos != NCTX), hasn = (pos != NCTX - 1 && pos != SA - 1);
#pragma unroll
        for (int j = 0; j < 2; ++j) { const int c0 = 8 * (lane + 64 * j);
            const bf16_t* p = XBC + (size_t)row * 1024 + c0;
            const u32x4 xc = *(const u32x4*)p; u32x4 xp = {0u, 0u, 0u, 0u}, xn = {0u, 0u, 0u, 0u};
            if (hasp) xp = *(const u32x4*)(p - 1024);
            if (hasn) xn = *(const u32x4*)(p + 1024);
            float o[8];
#pragma unroll
            for (int t = 0; t < 4; ++t) {
#pragma unroll
                for (int hh = 0; hh < 2; ++hh) { const int e = 2 * t + hh;
                    const float a = hh ? bf2f(xp[t] >> 16) : bf2f(xp[t] & 0xffffu), b = hh ? bf2f(xc[t] >> 16) : bf2f(xc[t] & 0xffffu), d = hh ? bf2f(xn[t] >> 16) : bf2f(xn[t] & 0xffffu);
                    const float y = w0[j][e >> 2][e & 3] * a + w1[j][e >> 2][e & 3] * b + w2[j][e >> 2][e & 3] * d + wb[j][e >> 2][e & 3];
                    o[e] = siluf(y); } }
            u32x4 w; w.x = pk2(o[0], o[1]); w.y = pk2(o[2], o[3]); w.z = pk2(o[4], o[5]); w.w = pk2(o[6], o[7]);
            *(u32x4*)(CONV + (size_t)row * 1024 + c0) = w; }
    }
    for (int u = blockIdx.x; u < NB * NCH; u += gridDim.x) {
        {
            const int fr = lane & 15, fq = lane >> 4; const size_t r0 = (size_t)(u / NCH) * SA + 128 * (u % NCH) + 16 * wave;
            const bf16_t* ap = U + (r0 + fr) * DM + 8 * fq; const bf16_t* bp = Wdt + (size_t)fr * 64 + 8 * fq;
            f32x4 acc = {0.f, 0.f, 0.f, 0.f};
#pragma unroll 8
            for (int kk = 0; kk < 32; ++kk) acc = __builtin_amdgcn_mfma_f32_16x16x32_bf16(*(const bf16x8*)(ap + 32 * kk), *(const bf16x8*)(bp + (size_t)(kk >> 1) * (256 * 64) + 32 * (kk & 1)), acc, 0, 0, 0);
            const float bias = dtb[fr];
#pragma unroll
            for (int r = 0; r < 4; ++r) { const float x = acc[r] + bias; DT[(r0 + 4 * fq + r) * 16 + fr] = x > 20.f ? x : log1pf(__expf(x)); }
        }
        __syncthreads();
        if (tid < 16) { const int b = u / NCH, c = u % NCH, dir = tid >> 3, h = tid & 7; const size_t row0 = (size_t)b * SA + 128 * c;
            const float an = -__expf(a_log[tid]); float g = 0.f;
            for (int l0 = 0; l0 < 128; l0 += 16) { float v[16];
#pragma unroll
                for (int j = 0; j < 16; ++j) { const int l = dir ? 127 - (l0 + j) : l0 + j; v[j] = __hip_atomic_load(DT + (row0 + l) * 16 + tid, __ATOMIC_RELAXED, __HIP_MEMORY_SCOPE_AGENT); }
#pragma unroll
                for (int j = 0; j < 16; ++j) { const int l = dir ? 127 - (l0 + j) : l0 + j; g += an * v[j]; Gc[(row0 + l) * 16 + tid] = g; } }
            CD[(((size_t)b * 2 + dir) * NCH + c) * 8 + h] = __expf(g); }
    }
}

constexpr int LP = 136;
struct LinArgs {
    const bf16_t* Qn; const bf16_t* Kn; const bf16_t* Vn; int ld;
    bf16_t* ST;
    const float* Gc; const float* DT; const float* CD;
    const float* rld;
};
__device__ __forceinline__ f32x4 mfma16(bf16x8 a, bf16x8 b, f32x4 c) { return __builtin_amdgcn_mfma_f32_16x16x32_bf16(a, b, c, 0, 0, 0); }

template <bool SSD> __device__ __forceinline__ void lin_gdt(const LinArgs& A, size_t row0, int dir, int h, int s, float& g, float& glast, float& dt) {
    if (SSD) { g = A.Gc[(row0 + s) * 16 + dir * 8 + h]; glast = A.Gc[(row0 + (dir ? 0 : 127)) * 16 + dir * 8 + h]; dt = A.DT[(row0 + s) * 16 + dir * 8 + h]; }
    else { const float lg = -__expf(A.rld[dir * 4 + h]);
        g = (float)(dir ? 128 - s : s + 1) * lg; glast = 128.f * lg; dt = 1.f; }
}
template <bool SCALE> __device__ __forceinline__ void stage_T(LAS bf16_t* dst, const bf16_t* src, int ld, size_t row0, int col0, int ncols, const LAS float* wts, int dvw, int tid) {
    const int nch = ncols >> 3;
    for (int id = tid; id < 128 * nch; id += 512) { const int s = id & 127, q = id >> 7;
        const u32x4 x = *(const u32x4*)(src + (row0 + s) * ld + col0 + 8 * q);
        float wv = 1.f; if (SCALE) wv = wts[((8 * q) / dvw) * 128 + s];
#pragma unroll
        for (int t = 0; t < 4; ++t) { float lo = bf2f(x[t] & 0xffffu), hi = bf2f(x[t] >> 16);
            if (SCALE) { lo *= wv; hi *= wv; dst[(8 * q + 2 * t) * LP + s] = (bf16_t)f2bf(lo); dst[(8 * q + 2 * t + 1) * LP + s] = (bf16_t)f2bf(hi); }
            else { dst[(8 * q + 2 * t) * LP + s] = (bf16_t)(x[t] & 0xffffu); dst[(8 * q + 2 * t + 1) * LP + s] = (bf16_t)(x[t] >> 16); } } }
}
__device__ __forceinline__ void stage_N(LAS bf16_t* dst, const bf16_t* src, int ld, size_t row0, int col0, int tid) {
    for (int id = tid; id < 128 * 16; id += 512) { const int q = id & 15, s = id >> 4;
        *(LAS u32x4*)(dst + s * LP + 8 * q) = *(const u32x4*)(src + (row0 + s) * ld + col0 + 8 * q); }
}

typedef short s16x4_t __attribute__((ext_vector_type(4)));
__device__ __forceinline__ bf16x8 frag_tr(const LAS bf16_t* base, int pitch, int krow0, int ncol0, int fr, int fq) {
    const LAS bf16_t* p = base + (krow0 + 8 * fq + (fr >> 2)) * pitch + ncol0 + 4 * (fr & 3);
    const s16x4_t lo = __builtin_bit_cast(s16x4_t, __builtin_amdgcn_ds_read_tr16_b64_v4i16((LAS s16x4_t*)p));
    const s16x4_t hi = __builtin_bit_cast(s16x4_t, __builtin_amdgcn_ds_read_tr16_b64_v4i16((LAS s16x4_t*)(p + 4 * pitch)));
    return (bf16x8){lo[0], lo[1], lo[2], lo[3], hi[0], hi[1], hi[2], hi[3]};
}
__device__ __forceinline__ void stage_NS(LAS bf16_t* dst, int pitch, const bf16_t* src, int ld, size_t row0, int col0, int ncols, const LAS float* wts, int dvw, int tid) {
    const int nch = ncols >> 3;
    for (int id = tid; id < 128 * nch; id += 512) { const int q = id % nch, s = id / nch;
        const u32x4 x = *(const u32x4*)(src + (row0 + s) * ld + col0 + 8 * q); const float wv = wts[((8 * q) / dvw) * 128 + s]; u32x4 o;
#pragma unroll
        for (int t = 0; t < 4; ++t) o[t] = pk2(bf2f(x[t] & 0xffffu) * wv, bf2f(x[t] >> 16) * wv);
        *(LAS u32x4*)(dst + s * pitch + 8 * q) = o; }
}
__device__ __forceinline__ void stage_NW(LAS bf16_t* dst, int pitch, const bf16_t* src, int ld, size_t row0, int col0, int ncols, int tid) {
    const int nch = ncols >> 3;
    for (int id = tid; id < 128 * nch; id += 512) { const int q = id % nch, s = id / nch;
        *(LAS u32x4*)(dst + s * pitch + 8 * q) = *(const u32x4*)(src + (row0 + s) * ld + col0 + 8 * q); }
}

template <int DV, int NH, bool SSD> __device__ __forceinline__ void lin_s1_phase(const LinArgs& A, LAS unsigned char* lds, int tid, int lane, int wave) {
    constexpr int NHT = SSD ? 8 : 4, NG = NHT / NH, NSLAB = NH * DV / 16 / 8, PV = NH * DV + 8;
    LAS bf16_t* KN = (LAS bf16_t*)lds;
    LAS bf16_t* VN = (LAS bf16_t*)(lds + 128 * LP * 2);
    LAS float* wts = (LAS float*)(lds + 128 * LP * 2 + 128 * PV * 2);
    const int fr = lane & 15, fq = lane >> 4;
    for (int u = blockIdx.x; u < NB * NCH * NG; u += gridDim.x) {
        const int grp = u % NG, c = (u / NG) % NCH, b = u / (NG * NCH); const size_t row0 = (size_t)b * SA + 128 * c;
        __syncthreads();
        for (int e = tid; e < 2 * NH * 128; e += 512) { const int dir = e / (NH * 128), hh = (e >> 7) % NH, s = e & 127; float g, gl, dt;
            lin_gdt<SSD>(A, row0, dir, grp * NH + hh, s, g, gl, dt); wts[e] = dt * __expf(gl - g); }
        stage_NW(KN, LP, A.Kn, A.ld, row0, grp * 128, 128, tid);
        stage_NW(VN, PV, A.Vn, A.ld, row0, grp * NH * DV, NH * DV, tid);
        __syncthreads();
#pragma unroll 1
        for (int dir = 0; dir < 2; ++dir) {
#pragma unroll
            for (int sl = 0; sl < NSLAB; ++sl) { const int slab = wave * NSLAB + sl;
                const int hh = (slab * 16) / DV, v0 = (slab * 16) % DV;
                const LAS float* wp = wts + (dir * NH + hh) * 128 + 8 * fq;
                f32x4 acc[8];
#pragma unroll
                for (int nt = 0; nt < 8; ++nt) acc[nt] = (f32x4){0.f, 0.f, 0.f, 0.f};
#pragma unroll
                for (int kk = 0; kk < 4; ++kk) { const bf16x8 vr = frag_tr(VN, PV, 32 * kk, slab * 16, fr, fq);
                    const f32x4 wa = *(const LAS f32x4*)(wp + 32 * kk), wb = *(const LAS f32x4*)(wp + 32 * kk + 4);
                    u32x4 vw;
#pragma unroll
                    for (int t = 0; t < 4; ++t) { const float w0 = t < 2 ? wa[2 * t] : wb[2 * t - 4], w1 = t < 2 ? wa[2 * t + 1] : wb[2 * t - 3];
                        vw[t] = pk2(bf2f((unsigned short)vr[2 * t]) * w0, bf2f((unsigned short)vr[2 * t + 1]) * w1); }
                    const bf16x8 vf = __builtin_bit_cast(bf16x8, vw);
#pragma unroll
                    for (int nt = 0; nt < 8; ++nt) acc[nt] = mfma16(frag_tr(KN, LP, 32 * kk, 16 * nt, fr, fq), vf, acc[nt]); }
                bf16_t* sp = A.ST + ((((size_t)b * 2 + dir) * NCH + c) * NHT + grp * NH + hh) * (size_t)(DV * 128) + (size_t)(v0 + fr) * 128 + 4 * fq;
#pragma unroll
                for (int nt = 0; nt < 8; ++nt) { u32x2 o; o.x = pk2(acc[nt][0], acc[nt][1]); o.y = pk2(acc[nt][2], acc[nt][3]); *(u32x2*)(sp + 16 * nt) = o; }
            }
        }
    }
}

template <int DV, bool SSD> __device__ __forceinline__ void lin_s2_phase(const LinArgs& A, int tid) {
    constexpr int NHT = SSD ? 8 : 4, PER = NHT * DV * 128;
    const int gt = blockIdx.x * 512 + tid, NT_ = gridDim.x * 512;
    for (int it = gt; it < 8 * (PER / 4); it += NT_) {
        const int bd = it / (PER / 4), e = (it % (PER / 4)) * 4, h = e / (DV * 128), dir = bd & 1;
        float run[4] = {0.f, 0.f, 0.f, 0.f};
        float dec_r = 1.f; if (!SSD) dec_r = __expf(-128.f * __expf(A.rld[dir * 4 + (h & 3)]));
        for (int s0 = 0; s0 < NCH; s0 += 11) {
            u32x2 x[11]; float dec[11]; bf16_t* pp[11];
#pragma unroll
            for (int j = 0; j < 11; ++j) { const int st = s0 + j; const int c = dir ? (st < 2 ? 1 - st : NCH + 1 - st) : st;
                pp[j] = A.ST + ((size_t)bd * NCH + c) * PER + e; x[j] = *(const u32x2*)pp[j];
                dec[j] = SSD ? A.CD[((size_t)bd * NCH + c) * 8 + h] : dec_r; }
#pragma unroll
            for (int j = 0; j < 11; ++j) {
                u32x2 o; o.x = pk2(run[0], run[1]); o.y = pk2(run[2], run[3]); *(u32x2*)pp[j] = o;
                run[0] = run[0] * dec[j] + bf2f(x[j].x & 0xffffu); run[1] = run[1] * dec[j] + bf2f(x[j].x >> 16);
                run[2] = run[2] * dec[j] + bf2f(x[j].y & 0xffffu); run[3] = run[3] * dec[j] + bf2f(x[j].y >> 16); }
        }
    }
}
template <int DV, int NH, bool SSD> struct LinEpi;
template <int DV, int NH, int NHU, bool SSD, class Epi> __device__ __forceinline__ void lin_s3_phase(const LinArgs& A, const Epi& E, int cmin, LAS unsigned char* lds, int tid, int lane, int wave) {
    constexpr int NHT = SSD ? 8 : 4, NG = NHT / NH, NSUB = NH / NHU, NVT = DV / 16, NSTD = SSD ? 2 : 1, NDG = 2 / NSTD, TILEB = 128 * LP * 2, NGE = 2 * NHU * 128;
    static_assert(NHU * DV == 128 && NGE <= 512, "unit output tile is 128 x 128");
    LAS bf16_t* KN = (LAS bf16_t*)lds;
    LAS bf16_t* VT = (LAS bf16_t*)(lds + TILEB);
    LAS bf16_t* WL = (LAS bf16_t*)(lds + 2 * TILEB) + wave * 16 * LP;
    LAS bf16_t* STL = (LAS bf16_t*)(lds + 3 * TILEB);
    LAS float* gsm = (LAS float*)(lds + 4 * TILEB);
    LAS float* dsm = gsm + NGE;
    const int fr = lane & 15, fq = lane >> 4, l0 = wave * 16;
    const int nunits = NB * NCH * NG * NSUB, G = gridDim.x;
#define S3_DECODE(uu, sub, grp, c, b) const int sub = (uu) % NSUB, grp = ((uu) / NSUB) % NG, c = ((uu) / (NSUB * NG)) % NCH, b = (uu) / (NSUB * NG * NCH)
    int u = blockIdx.x;
    while (u < nunits && ((u / (NSUB * NG)) % NCH) < cmin) u += G;
    u32x4 kreg[4], vreg[4]; bf16x8 qfn[4]; float gvn = 0.f, dvn = 0.f;
#define S3_LOAD_UNIT(uu) do { S3_DECODE(uu, sub_, grp_, c_, b_); const size_t row0_ = (size_t)b_ * SA + 128 * c_; const int h0_ = grp_ * NH + sub_ * NHU; \
        _Pragma("unroll") for (int i = 0; i < 4; ++i) { const int id = tid + 512 * i, q = id & 15, s_ = id >> 4; \
            kreg[i] = *(const u32x4*)(A.Kn + (row0_ + s_) * A.ld + grp_ * 128 + 8 * q); vreg[i] = *(const u32x4*)(A.Vn + (row0_ + s_) * A.ld + h0_ * DV + 8 * q); } \
        _Pragma("unroll") for (int kk = 0; kk < 4; ++kk) qfn[kk] = *(const bf16x8*)(A.Qn + (row0_ + l0 + fr) * A.ld + grp_ * 128 + 32 * kk + 8 * fq); \
        if (tid < NGE) { const int dir = tid / (NHU * 128), hh_ = (tid >> 7) % NHU, s_ = tid & 127; float gl_; lin_gdt<SSD>(A, row0_, dir, h0_ + hh_, s_, gvn, gl_, dvn); } } while (0)
    while (u < nunits) {
        S3_LOAD_UNIT(u);
        S3_DECODE(u, sub, grp, c, b); const size_t row0 = (size_t)b * SA + 128 * c; const int h0 = grp * NH + sub * NHU;
        int un = u + G; while (un < nunits && ((un / (NSUB * NG)) % NCH) < cmin) un += G;
        __syncthreads();
#pragma unroll
        for (int i = 0; i < 4; ++i) { const int id = tid + 512 * i, q = id & 15, s_ = id >> 4; *(LAS u32x4*)(KN + s_ * LP + 8 * q) = kreg[i]; *(LAS u32x4*)(VT + s_ * LP + 8 * q) = vreg[i]; }
        if (tid < NGE) { gsm[tid] = gvn; dsm[tid] = dvn; }
        bf16x8 qf[4];
#pragma unroll
        for (int kk = 0; kk < 4; ++kk) qf[kk] = qfn[kk];
        u32x4 zreg[4], sreg[4];
#pragma unroll
        for (int i = 0; i < 4; ++i) { const int id = tid + 512 * i, q = id & 15, s_ = id >> 4; zreg[i] = *(const u32x4*)(E.buf + (row0 + s_) * 512 + h0 * DV + 8 * q); }
#define S3_LOAD_ST(stage) do { const int hh_ = (stage) / NDG, dg_ = (stage) % NDG; \
        _Pragma("unroll") for (int i = 0; i < 4; ++i) { const int id = tid + 512 * i, q = id & 15, v = id >> 4, d = v / DV, dir = dg_ * NSTD + d; \
            sreg[i] = *(const u32x4*)(A.ST + ((((size_t)b * 2 + dir) * NCH + c) * NHT + h0 + hh_) * (size_t)(DV * 128) + (size_t)(v - d * DV) * 128 + 8 * q); } } while (0)
        S3_LOAD_ST(0);
        __syncthreads();
        f32x4 P[8];
#pragma unroll
        for (int nt = 0; nt < 8; ++nt) { P[nt] = (f32x4){0.f, 0.f, 0.f, 0.f};
#pragma unroll
            for (int kk = 0; kk < 4; ++kk) P[nt] = mfma16(qf[kk], *(const LAS bf16x8*)(KN + (16 * nt + fr) * LP + 32 * kk + 8 * fq), P[nt]); }
        __syncthreads();
#pragma unroll
        for (int i = 0; i < 4; ++i) { const int id = tid + 512 * i, q = id & 15, s_ = id >> 4; *(LAS u32x4*)(KN + s_ * LP + 8 * q) = zreg[i]; }
#pragma unroll 1
        for (int hh = 0; hh < NHU; ++hh) {
            const int h = h0 + hh;
            const LAS float* gf = gsm + hh * 128; const LAS float* gb = gsm + (NHU + hh) * 128;
            const LAS float* df = dsm + hh * 128; const LAS float* db = dsm + (NHU + hh) * 128;
            float gfl[4], gbl[4];
#pragma unroll
            for (int r = 0; r < 4; ++r) { gfl[r] = gf[l0 + 4 * fq + r]; gbl[r] = gb[l0 + 4 * fq + r]; }
#pragma unroll
            for (int nt = 0; nt < 8; ++nt) { const int s = 16 * nt + fr;
                if (16 * nt + 15 < l0) {
                    const float gfs = gf[s], dfs = df[s];
#pragma unroll
                    for (int r = 0; r < 4; ++r) WL[(4 * fq + r) * LP + s] = (bf16_t)f2bf(P[nt][r] * (__expf(fminf(gfl[r] - gfs, 0.f)) * dfs));
                } else if (16 * nt > l0 + 15) {
                    const float gbs = gb[s], dbs = db[s];
#pragma unroll
                    for (int r = 0; r < 4; ++r) WL[(4 * fq + r) * LP + s] = (bf16_t)f2bf(P[nt][r] * (__expf(fminf(gbl[r] - gbs, 0.f)) * dbs));
                } else {
                    const float gfs = gf[s], gbs = gb[s], dfs = df[s], dbs = db[s];
#pragma unroll
                    for (int r = 0; r < 4; ++r) { const int l = l0 + 4 * fq + r;
                        const float mf = (s <= l) ? __expf(fminf(gfl[r] - gfs, 0.f)) * dfs : 0.f;
                        const float mb = (s >= l) ? __expf(fminf(gbl[r] - gbs, 0.f)) * dbs : 0.f;
                        WL[(4 * fq + r) * LP + s] = (bf16_t)f2bf(P[nt][r] * (mf + mb)); } } }
            asm volatile("s_waitcnt lgkmcnt(0)" ::: "memory");
            bf16x8 af[4];
#pragma unroll
            for (int kk = 0; kk < 4; ++kk) af[kk] = *(const LAS bf16x8*)(WL + fr * LP + 32 * kk + 8 * fq);
            f32x4 y[NVT];
#pragma unroll
            for (int vt = 0; vt < NVT; ++vt) { f32x4 ay = {0.f, 0.f, 0.f, 0.f};
#pragma unroll
                for (int kk = 0; kk < 4; ++kk) ay = mfma16(af[kk], frag_tr(VT, LP, 32 * kk, hh * DV + 16 * vt, fr, fq), ay);
                y[vt] = ay; }
#pragma unroll 1
            for (int dg = 0; dg < NDG; ++dg) {
                __syncthreads();
#pragma unroll
                for (int i = 0; i < 4; ++i) { const int id = tid + 512 * i, q = id & 15, v = id >> 4; *(LAS u32x4*)(STL + v * LP + 8 * q) = sreg[i]; }
                { const int nst = hh * NDG + dg + 1; if (nst < NHU * NDG) S3_LOAD_ST(nst); }
                __syncthreads();
#pragma unroll
                for (int d = 0; d < NSTD; ++d) { const int dir = dg * NSTD + d; float ed[4];
#pragma unroll
                    for (int r = 0; r < 4; ++r) ed[r] = __expf((dir ? gb : gf)[l0 + 4 * fq + r]);
#pragma unroll
                    for (int vt = 0; vt < NVT; ++vt) { f32x4 a0 = {0.f, 0.f, 0.f, 0.f};
#pragma unroll
                        for (int kk = 0; kk < 4; ++kk) a0 = mfma16(qf[kk], *(const LAS bf16x8*)(STL + (d * DV + 16 * vt + fr) * LP + 32 * kk + 8 * fq), a0);
#pragma unroll
                        for (int r = 0; r < 4; ++r) y[vt][r] += ed[r] * a0[r]; } }
            }
            E(y, l0 + 4 * fq, row0 + l0 + 4 * fq, h, hh, fr, VT, KN, lane);
        }
        __syncthreads();
        for (int id = tid; id < 128 * 16; id += 512) { const int q = id & 15, s = id >> 4;
            *(u32x4*)(E.buf + (row0 + s) * 512 + h0 * DV + 8 * q) = *(const LAS u32x4*)(KN + s * LP + 8 * q); }
        u = un;
    }
#undef S3_DECODE
#undef S3_LOAD_UNIT
#undef S3_LOAD_ST
}
struct SsdEpi {
    bf16_t* buf; float* SSQ; const float* dskip;
    __device__ __forceinline__ void operator()(f32x4 (&y)[4], int lb, size_t rowb, int h, int hh, int fr, const LAS bf16_t* VT, LAS bf16_t* ZT, int lane) const {
        const float dsk = dskip[h]; float ss[4] = {0.f, 0.f, 0.f, 0.f};
#pragma unroll
        for (int vt = 0; vt < 4; ++vt)
#pragma unroll
            for (int r = 0; r < 4; ++r) { const int v = 16 * vt + fr; LAS bf16_t* zp = ZT + (lb + r) * LP + hh * 64 + v;
                const float x = bf2f(VT[(lb + r) * LP + hh * 64 + v]);
                const float val = (y[vt][r] + dsk * x) * siluf(bf2f(*zp)); ss[r] += val * val; *zp = (bf16_t)f2bf(val); }
#pragma unroll
        for (int r = 0; r < 4; ++r) { float s = ss[r]; s += shx(s, 1, lane); s += shx(s, 2, lane); s += shx(s, 4, lane); s += shx(s, 8, lane);
            if (fr == 0) SSQ[(rowb + r) * 8 + h] = s; }
    }
};
struct RetEpi {
    bf16_t* buf; const float* gnw;
    __device__ __forceinline__ void operator()(f32x4 (&y)[8], int lb, size_t rowb, int h, int hh, int fr, const LAS bf16_t* VT, LAS bf16_t* ZT, int lane) const {
#pragma unroll
        for (int r = 0; r < 4; ++r) { float s = 0.f;
#pragma unroll
            for (int vt = 0; vt < 8; ++vt) s += y[vt][r];
            s += shx(s, 1, lane); s += shx(s, 2, lane); s += shx(s, 4, lane); s += shx(s, 8, lane);
            const float mu = s * (1.f / 128.f); float q = 0.f;
#pragma unroll
            for (int vt = 0; vt < 8; ++vt) { const float d = y[vt][r] - mu; q += d * d; }
            q += shx(q, 1, lane); q += shx(q, 2, lane); q += shx(q, 4, lane); q += shx(q, 8, lane);
            const float rstd = rsqrtf(q * (1.f / 128.f) + EPS);
#pragma unroll
            for (int vt = 0; vt < 8; ++vt) { const int v = 16 * vt + fr; LAS bf16_t* gp = ZT + (lb + r) * LP + v;
                *gp = (bf16_t)f2bf((y[vt][r] - mu) * rstd * gnw[h * 128 + v] * siluf(bf2f(*gp))); } }
    }
};
#ifdef ONLY_PH
#define EN(x) ((x) == ONLY_PH)
#elif defined(SKIP_PH)
#define EN(x) ((x) != SKIP_PH)
#else
#define EN(x) (MODE == 0 || (MODE == 1 && (x) != 15) || (MODE == 2 && (x) == 15))
#endif
#define XB_TMO      128
#define XB_XCNT(j)  (256  + 64 * (j))
#define XB_XSUB(j)  (1280 + 64 * (j))
#define XB_XGEN(j)  (2304 + 64 * (j))
#define XB_TOP      3328
#define XB_TOPGEN   3392
#define XCD_BAR_WORDS 3456
#define XB_SPIN_CAP (1u << 18)

__device__ __forceinline__ unsigned xb_ld(unsigned* p)              { return __hip_atomic_load(p, __ATOMIC_RELAXED, __HIP_MEMORY_SCOPE_AGENT); }
__device__ __forceinline__ unsigned xb_add(unsigned* p, unsigned v) { return __hip_atomic_fetch_add(p, v, __ATOMIC_RELAXED, __HIP_MEMORY_SCOPE_AGENT); }
__device__ __forceinline__ unsigned xb_xcc_id() { return (unsigned)__builtin_amdgcn_s_getreg((3 << 11) | 20) & 0xFu; }
#define XB_SPIN(cond, bar) do { unsigned _sp = 0; while (cond) { __builtin_amdgcn_s_sleep(1); \
    if ((++_sp & 255u) == 0u) { if (xb_ld(&(bar)[XB_TMO])) break; if (_sp > XB_SPIN_CAP) { atomicAdd(&(bar)[XB_TMO], 1u); break; } } } } while (0)

struct XcdBarrier {
    unsigned* bar; unsigned x;
    volatile LAS unsigned* st;
};

__device__ __forceinline__ XcdBarrier xcd_barrier_post(unsigned* bar, volatile LAS unsigned* st) {
    XcdBarrier b; b.bar = bar; b.x = xb_xcc_id(); b.st = st;
    if (threadIdx.x == 0) (void)xb_add(&bar[XB_XCNT(b.x)], 1u);
    return b;
}
__device__ __forceinline__ void xcd_barrier_complete(unsigned* bar, unsigned x, unsigned& nloc, unsigned& nx) {
    const unsigned G = gridDim.x * gridDim.y * gridDim.z;
    unsigned sum, cnt, mine, sp = 0u;
    for (;;) {
        sum = 0u; cnt = 0u; mine = 0u;
#pragma unroll
        for (unsigned j = 0; j < 16; ++j) { const unsigned c = xb_ld(&bar[XB_XCNT(j)]); sum += c; cnt += (c > 0u) ? 1u : 0u; mine = (j == x) ? c : mine; }
        if (sum == G) break;
        __builtin_amdgcn_s_sleep(1);
        if ((++sp & 255u) == 0u) { if (xb_ld(&bar[XB_TMO])) break; if (sp > XB_SPIN_CAP) { atomicAdd(&bar[XB_TMO], 1u); break; } }
    }
    nloc = mine > 0u ? mine : 1u; nx = cnt > 0u ? cnt : 1u;
}

__device__ __forceinline__ void xcd_barrier(const XcdBarrier& b, const int tid_) {
    asm volatile("s_waitcnt vmcnt(0)" ::: "memory");
    __syncthreads();
    if (tid_ == 0) {
        unsigned* bar = b.bar;
        __builtin_amdgcn_s_waitcnt(0);
        unsigned nloc = b.st[0], nx = b.st[1];
        if (nloc == 0u) { xcd_barrier_complete(bar, b.x, nloc, nx); b.st[0] = nloc; b.st[1] = nx; }
        const unsigned old = xb_add(&bar[XB_XSUB(b.x)], 1u);
        const unsigned gen = old / nloc;
        if (old + 1u == (gen + 1u) * nloc) {
            __builtin_amdgcn_fence(__ATOMIC_RELEASE, "agent");
            asm volatile("s_waitcnt vmcnt(0)" ::: "memory");
            const unsigned og = xb_add(&bar[XB_TOP], 1u);
            const unsigned tg = og / nx;
            if (og + 1u == (tg + 1u) * nx) xb_add(&bar[XB_TOPGEN], 1u);
            else XB_SPIN(xb_ld(&bar[XB_TOPGEN]) == tg, bar);
            __builtin_amdgcn_fence(__ATOMIC_ACQUIRE, "agent");
            xb_add(&bar[XB_XGEN(b.x)], 1u);
            asm volatile("s_waitcnt vmcnt(0)" ::: "memory");
        } else {
            XB_SPIN(xb_ld(&bar[XB_XGEN(b.x)]) == gen, bar);
            __builtin_amdgcn_fence(__ATOMIC_ACQUIRE, "agent");
            asm volatile("s_waitcnt vmcnt(0)" ::: "memory");
        }
    }
    __syncthreads();
}

constexpr size_t OFF_PART = 424 * MiB;
constexpr size_t OFF_BAR = 13 * MiB;
constexpr int MISC_OFF = LDS_BYTES - 64;
constexpr int PH_PER_LAYER = 15, N_PHASES = 2 + DEPTH * PH_PER_LAYER;
#define EN(x) (MODE == 0 || (MODE == 1 && (x) != 15) || (MODE == 2 && (x) == 15))
__device__ __forceinline__ int mk_tid(int wave_id) { unsigned m_ = ~0u; asm volatile("" : "+s"(m_)); int t = wave_id * 64 + (int)__builtin_amdgcn_mbcnt_hi(m_, __builtin_amdgcn_mbcnt_lo(m_, 0u)); asm volatile("" : "+v"(t)); return t; }
#define PHASE_BEGIN(p) if (ph_lo <= (p) && (p) < ph_hi) { int tid = mk_tid(wave_id); const int lane = tid & 63, wave = __builtin_amdgcn_readfirstlane(tid >> 6); \
    CArgsP ap = (CArgsP)__builtin_amdgcn_kernarg_segment_ptr(); asm volatile("" : "+s"(ap)); unsigned char* ws = ap->ws; float* hlat = ap->out; (void)lane; (void)wave; (void)hlat;
#define PHASE_END(p) if ((p) + 1 < ph_hi) { if (ph_hi < 0) grid.sync();   else xcd_barrier(xbar, mk_tid(wave_id)); } }

template <int MODE, int L> __device__ __forceinline__ void layer_phases(cg::grid_group& grid, const XcdBarrier& xbar, const int wave_id, LAS unsigned char* lds, unsigned char* lds_raw, const int ph_lo, const int ph_hi) {
    constexpr int P0 = 1 + L * PH_PER_LAYER;
#define LAYER_COMMON const float* modL = (const float*)(ws + OFF_MOD) + (size_t)L * 5 * MODW; unsigned char* wl = ws + OFF_W + (size_t)L * W_LAYER; \
    const float* bl = L == 0 ? ap->in[0] : hlat; const float* bc = L == 0 ? ap->in[2] : (const float*)(ws + OFF_HCTX);     (void)modL; (void)wl; (void)bl; (void)bc;
    PHASE_BEGIN(P0 + 0) LAYER_COMMON
        if (EN(0)) { if (L == 0) norm_mod_phase(bl, bc, ap->in[6] + L * DM, modL, 0, 1, (bf16_t*)(ws + OFF_U), lane, wave);
                     else norm_mod_phase(bl, bc, ap->in[6] + L * DM, modL, 0, 1, (bf16_t*)(ws + OFF_U), lane, wave, (const float*)(ws + OFF_PART), 16, modL - 5 * MODW + 4 * MODW + 5 * DM, nullptr); }
    PHASE_END(P0 + 0)
    PHASE_BEGIN(P0 + 1) LAYER_COMMON
        if (EN(1)) { pg8::Gemm g{(bf16_t*)(ws + OFF_U), (const bf16_t*)(wl + W_P), 0, 0, T, N1, DM, DM, 0, 1};
            pg8::StaticOrder S; S.init(T, N1, gridDim.x, blockIdx.x);
            pg8::EpiInProj E{ws, (float*)(ws + OFF_DT), ap->in[9] + L * 64, ap->in[10] + L * 64, ap->in[13] + L * 16, (const f32x2*)(ws + OFF_ATAB), (const f32x2*)(ws + OFF_RTAB)};
            pg8::gemm_phase<pg8::EpiInProj, pg8::StaticOrder, true, true>(lds, g, S, E, tid); }
    PHASE_END(P0 + 1)
    PHASE_BEGIN(P0 + 2) LAYER_COMMON
        if (EN(2)) postproj_phase((bf16_t*)(ws + OFF_XBC), (bf16_t*)(ws + OFF_CONV), ap->in[11] + L * 3 * 1024, ap->in[12] + L * 1024, (float*)(ws + OFF_DT), (float*)(ws + OFF_G), (float*)(ws + OFF_CD), ap->in[14] + L * 16, (const bf16_t*)(ws + OFF_U), (const bf16_t*)(wl + W_P) + (size_t)N1 * DM, ap->in[13] + L * 16, tid, lane, wave);
    PHASE_END(P0 + 2)
#define SSD_ARGS LinArgs A{(bf16_t*)(ws + OFF_CONV) + 768, (bf16_t*)(ws + OFF_CONV) + 512, (bf16_t*)(ws + OFF_CONV), 1024, (bf16_t*)(ws + OFF_ST), (float*)(ws + OFF_G), (float*)(ws + OFF_DT), (float*)(ws + OFF_CD), nullptr};
#define RET_ARGS LinArgs A{(bf16_t*)(ws + OFF_RQ), (bf16_t*)(ws + OFF_RK), (bf16_t*)(ws + OFF_RV), 512, (bf16_t*)(ws + OFF_ST), nullptr, nullptr, nullptr, ap->in[17] + L * 8};
    PHASE_BEGIN(P0 + 3) SSD_ARGS if (EN(3)) lin_s1_phase<64, 4, true>(A, lds, tid, lane, wave); PHASE_END(P0 + 3)
    PHASE_BEGIN(P0 + 4) SSD_ARGS if (EN(4)) lin_s2_phase<64, true>(A, tid); PHASE_END(P0 + 4)
    PHASE_BEGIN(P0 + 5) SSD_ARGS if (EN(5)) { SsdEpi E{(bf16_t*)(ws + OFF_Z), (float*)(ws + OFF_SSQ), ap->in[15] + L * 8}; lin_s3_phase<64, 4, 2, true, SsdEpi>(A, E, L == DEPTH - 1 ? 2 : 0, lds, tid, lane, wave); } PHASE_END(P0 + 5)
    PHASE_BEGIN(P0 + 6) RET_ARGS if (EN(6)) lin_s1_phase<128, 1, false>(A, lds, tid, lane, wave); PHASE_END(P0 + 6)
    PHASE_BEGIN(P0 + 7) RET_ARGS if (EN(7)) lin_s2_phase<128, false>(A, tid); PHASE_END(P0 + 7)
    PHASE_BEGIN(P0 + 8) RET_ARGS
        if (EN(8)) { RetEpi E{(bf16_t*)(ws + OFF_RG), ap->in[18] + L * 512}; lin_s3_phase<128, 1, 1, false, RetEpi>(A, E, L == DEPTH - 1 ? 2 : 0, lds, tid, lane, wave); __syncthreads(); }
        if (EN(15)) {
            typedef attn_body::bf16 abf; const abf* Qp = (const abf*)(ws + OFF_Q); const abf* KVp = (const abf*)(ws + OFF_KV);
            if (L < DEPTH - 1) for (int u = (int)((blockIdx.x + gridDim.x - 32u) % gridDim.x); u < NB * 8; u += gridDim.x) { const int b = u >> 3, h = u & 7;     const long r0 = (long)b * SA;
                attn_body::attn_unit<8>(r0, r0, 4, Qp + h * 64, KVp + (h >> 2) * 64, KVp + 128 + (h >> 2) * 64, (abf*)Qp + h * 64, (char*)lds_raw, tid); }
            for (int u = blockIdx.x; u < NB * 8 * 32; u += gridDim.x) { const int x = u & 7, qb = (u >> 3) & 31, i = u >> 8; const int b = x >> 1, h = (x & 1) * 4 + i; const long r0 = (long)b * SA;
                attn_body::attn_unit<8>(r0 + NCTX + 256 * qb, r0, SA / 64, Qp + h * 64, KVp + (h >> 2) * 64, KVp + 128 + (h >> 2) * 64, (abf*)Qp + h * 64, (char*)lds_raw, tid); }
        }
    PHASE_END(P0 + 8)
    PHASE_BEGIN(P0 + 9) LAYER_COMMON
        if (EN(9)) { pg8::Gemm g{(bf16_t*)(ws + OFF_U), (const bf16_t*)(wl + W_G), 0, 0, T, NGATE, DM, DM, 0, 1};
            pg8::StaticOrder S; S.init(T, NGATE, gridDim.x, blockIdx.x, L == DEPTH - 1);
            pg8::EpiBf16<2> E{(bf16_t*)(ws + OFF_GATE), NGATE, 0};
            pg8::gemm_phase<pg8::EpiBf16<2>, pg8::StaticOrder, true, true>(lds, g, S, E, tid); }
    PHASE_END(P0 + 9)
    PHASE_BEGIN(P0 + 10) LAYER_COMMON
        if (EN(10)) { pg8::Gemm g{(bf16_t*)(ws + OFF_Q), (const bf16_t*)(wl + W_B), SZ512, (size_t)DM * 512 * 2, T, DM, 512, 512, 0, 1};
            pg8::MergeOrder S; S.S.init(T, DM, gridDim.x, blockIdx.x, L == DEPTH - 1);
            pg8::EpiMerge E{(bf16_t*)(ws + OFF_GATE), (float*)(ws + OFF_SSQ), (bf16_t*)(ws + OFF_U)};
            pg8::gemm_phase<pg8::EpiMerge, pg8::MergeOrder, true, true>(lds, g, S, E, tid); }
    PHASE_END(P0 + 10)
    PHASE_BEGIN(P0 + 11) LAYER_COMMON
        if (EN(11)) { pg8::Gemm g{(bf16_t*)(ws + OFF_U), (const bf16_t*)(wl + W_O), 0, 0, T, DM, DM, DM, 0, 1};
            pg8::StaticOrder S; S.init(T, DM, gridDim.x, blockIdx.x, 1);
            pg8::EpiResid E{bl, bc, hlat, (float*)(ws + OFF_HCTX), modL + 2 * DM};
            pg8::gemm_phase<pg8::EpiResid, pg8::StaticOrder, true, true>(lds, g, S, E, tid);
            if (L < DEPTH - 1) { pg8::Gemm g2{(bf16_t*)(ws + OFF_U), (const bf16_t*)(wl + W_O), 512, 131072, T, DM, 256, DM, 0, 1};
                pg8::CtxSplitOrder S2{4, (int)gridDim.x, (int)blockIdx.x}; pg8::EpiPartial E2{(float*)(ws + OFF_PART)};
                pg8::gemm_phase<pg8::EpiPartial, pg8::CtxSplitOrder, true, true>(lds, g2, S2, E2, mk_tid(wave_id)); } }
    PHASE_END(P0 + 11)
    PHASE_BEGIN(P0 + 12) LAYER_COMMON
        if (EN(12)) { if (L == 0) norm_mod_phase(hlat, ap->in[2], ap->in[7] + L * DM, modL, 3, 4, (bf16_t*)(ws + OFF_U), lane, wave, (const float*)(ws + OFF_PART), 4, modL + 4 * MODW + 2 * DM, (float*)(ws + OFF_HCTX));
                      else norm_mod_phase(hlat, (const float*)(ws + OFF_HCTX), ap->in[7] + L * DM, modL, 3, 4, (bf16_t*)(ws + OFF_U), lane, wave); }
    PHASE_END(P0 + 12)
    PHASE_BEGIN(P0 + 13) LAYER_COMMON
        if (EN(13)) { pg8::Gemm g{(bf16_t*)(ws + OFF_U), (const bf16_t*)(wl + W_1), 0, 0, T, HID, DM, DM, 0, 1};
            pg8::StaticOrder S; S.init(T, HID, gridDim.x, blockIdx.x, L == DEPTH - 1);
            pg8::EpiBf16<1> E{(bf16_t*)(ws + OFF_HID), HID, 1};
            pg8::gemm_phase<pg8::EpiBf16<1>, pg8::StaticOrder, true, true>(lds, g, S, E, tid); }
    PHASE_END(P0 + 13)
    PHASE_BEGIN(P0 + 14) LAYER_COMMON
        if (EN(14)) { pg8::Gemm g{(bf16_t*)(ws + OFF_HID), (const bf16_t*)(wl + W_2), 0, 0, T, DM, HID, HID, 1, 1};
            pg8::StaticOrder S; S.init(T, DM, gridDim.x, blockIdx.x, 1);
            pg8::EpiResid E{hlat, (const float*)(ws + OFF_HCTX), hlat, (float*)(ws + OFF_HCTX), modL + 5 * DM};
            pg8::gemm_phase<pg8::EpiResid, pg8::StaticOrder, true, true>(lds, g, S, E, tid);
            if (L < DEPTH - 1) { pg8::Gemm g2{(bf16_t*)(ws + OFF_HID), (const bf16_t*)(wl + W_2), 131072, 131072, T, DM, 256, HID, 1, 1};
                pg8::CtxSplitOrder S2{16, (int)gridDim.x, (int)blockIdx.x}; pg8::EpiPartial E2{(float*)(ws + OFF_PART)};
                pg8::gemm_phase<pg8::EpiPartial, pg8::CtxSplitOrder, true, true>(lds, g2, S2, E2, mk_tid(wave_id)); } }
    PHASE_END(P0 + 14)
}

template <int MODE> __global__ void __launch_bounds__(512, 2) mega_fwd(Args args) {
    extern __shared__ __attribute__((aligned(16))) unsigned char lds_raw[];
    LAS unsigned char* lds = (LAS unsigned char*)lds_raw;
    cg::grid_group grid = cg::this_grid();
    const int ph_lo = args.ph_lo, ph_hi = args.ph_hi;
    if (threadIdx.x < 16) ((LAS unsigned*)(lds + MISC_OFF))[threadIdx.x] = 0u;
    __syncthreads();
    const int wave_id = __builtin_amdgcn_readfirstlane((int)threadIdx.x >> 6);
    XcdBarrier xbar; xbar.bar = (unsigned*)(args.ws + OFF_BAR); xbar.x = 0; xbar.st = nullptr;
    if (ph_hi - ph_lo > 1) xbar = xcd_barrier_post((unsigned*)(args.ws + OFF_BAR), (volatile LAS unsigned*)(lds + MISC_OFF));
    PHASE_BEGIN(0) if (EN(100)) prologue_phase(ap, lds, tid, lane, wave); PHASE_END(0)
    layer_phases<MODE, 0>(grid, xbar, wave_id, lds, lds_raw, ph_lo, ph_hi);
    layer_phases<MODE, 1>(grid, xbar, wave_id, lds, lds_raw, ph_lo, ph_hi);
    PHASE_BEGIN(N_PHASES - 1) if (EN(101)) final_norm_phase(hlat, ap->in[23], lane, wave); PHASE_END(N_PHASES - 1)
}

extern "C" void kernel_launch(void* const* d_in, const int* in_sizes, int n_in, void* d_out, int out_size, void* d_ws, size_t ws_size, hipStream_t stream) {
    static int grid = 0;
    if (grid == 0) {
        if (n_in != 24 || ws_size < OFF_END) { fprintf(stderr, "kernel_launch: unexpected problem (n_in %d, ws %zu)\n", n_in, ws_size); grid = -1; return; }
        int dev = 0, cus = 0, per_cu = 0;
        (void)hipGetDevice(&dev); (void)hipDeviceGetAttribute(&cus, hipDeviceAttributeMultiprocessorCount, dev);
        #if MK_ONE_LAUNCH
        (void)hipFuncSetAttribute((const void*)mega_fwd<0>, hipFuncAttributeMaxDynamicSharedMemorySize, LDS_BYTES);
#else
        (void)hipFuncSetAttribute((const void*)mega_fwd<1>, hipFuncAttributeMaxDynamicSharedMemorySize, LDS_BYTES); (void)hipFuncSetAttribute((const void*)mega_fwd<2>, hipFuncAttributeMaxDynamicSharedMemorySize, LDS_BYTES);
#endif
        (void)hipOccupancyMaxActiveBlocksPerMultiprocessor(&per_cu, (const void*)mega_fwd<MK_ONE_LAUNCH ? 0 : 1>, 512, LDS_BYTES);
        if (per_cu < 1) { fprintf(stderr, "kernel_launch: occupancy query says %d\n", per_cu); per_cu = 1; }
        (void)hipGetLastError();
        grid = cus * 1;
    }
    if (grid < 0) return;
    Args a{};
    for (int i = 0; i < 24; ++i) a.in[i] = (const float*)d_in[i];
    a.out = (float*)d_out; a.ws = (unsigned char*)d_ws;
#if MK_ONE_LAUNCH
    (void)hipMemsetAsync((char*)d_ws + OFF_BAR, 0, 16384, stream);
    a.ph_lo = 0; a.ph_hi = N_PHASES;
    { void* kargs[] = {&a}; hipError_t e = hipLaunchCooperativeKernel((const void*)mega_fwd<0>, dim3(grid), dim3(512), kargs, LDS_BYTES, stream);
      if (e != hipSuccess) fprintf(stderr, "cooperative launch failed: %s\n", hipGetErrorString(e)); }
#ifdef PROBE_LO
    (void)hipMemsetAsync((char*)d_ws + OFF_BAR, 0, 16384, stream);
    a.ph_lo = PROBE_LO; a.ph_hi = PROBE_HI;
    { void* kargs[] = {&a}; (void)hipLaunchCooperativeKernel((const void*)mega_fwd<0>, dim3(grid), dim3(512), kargs, LDS_BYTES, stream); }
#endif
#else
    for (int ph = 0; ph < N_PHASES; ++ph) { a.ph_lo = ph; a.ph_hi = ph + 1; void* kargs[] = {&a};
        hipError_t e = hipLaunchCooperativeKernel((const void*)mega_fwd<1>, dim3(grid), dim3(512), kargs, LDS_BYTES, stream);
        if (e != hipSuccess) { fprintf(stderr, "launch %d failed: %s\n", ph, hipGetErrorString(e)); break; }
        if (ph >= 1 && ph < N_PHASES - 1 && (ph - 1) % PH_PER_LAYER == 8) { e = hipLaunchCooperativeKernel((const void*)mega_fwd<2>, dim3(grid), dim3(512), kargs, LDS_BYTES, stream);
            if (e != hipSuccess) { fprintf(stderr, "attn launch %d failed: %s\n", ph, hipGetErrorString(e)); break; } } }
#endif
}
```

```cpp
#include <hip/hip_runtime.h>
#include <hip/hip_cooperative_groups.h>
#include <hip/hip_bf16.h>
#include <cstdint>
#include <cstdio>
#include <cmath>
namespace cg = cooperative_groups;

#ifndef MK_ONE_LAUNCH
#define MK_ONE_LAUNCH 1
#endif

constexpr int NB = 4, NLAT = 8192, NCTX = 256, SA = NLAT + NCTX  , T = NB * SA  , DM = 1024, DEPTH = 2;
constexpr int NCH = SA / 128;
constexpr int N1 = 4352, N1W = 4608  , NGATE = 3072, HID = 4096, INDIM = 7440, MODW = 6144;
constexpr float EPS = 1e-6f;
constexpr float QC2 = 0.125f * 1.4426950408889634f;

constexpr size_t KiB = 1024, MiB = 1u << 20;
constexpr size_t OFF_MOD = 0;
constexpr size_t OFF_DT = 256 * KiB;
constexpr size_t OFF_G = OFF_DT + 2304 * KiB;
constexpr size_t OFF_CD = OFF_G + 2304 * KiB;
constexpr size_t OFF_SSQ = OFF_CD + 64 * KiB;
constexpr size_t OFF_ATAB = 6 * MiB;
constexpr size_t OFF_RTAB = 8 * MiB;
constexpr size_t OFF_HCTX = 16 * MiB;
constexpr size_t OFF_W = 20 * MiB;
constexpr size_t W_LAYER = 36 * MiB, W_P = 0, W_G = 9 * MiB, W_B = 15 * MiB, W_O = 18 * MiB, W_1 = 20 * MiB, W_2 = 28 * MiB;
constexpr size_t OFF_U = 92 * MiB;
constexpr size_t SZ512 = (size_t)T * 512 * 2;
constexpr size_t OFF_Q = 158 * MiB, OFF_Z = OFF_Q + SZ512, OFF_RG = OFF_Z + SZ512, OFF_KV = OFF_RG + SZ512;
constexpr size_t OFF_XBC = OFF_KV + SZ512 / 2, OFF_ST = OFF_XBC, OFF_CONV = OFF_XBC + 2 * SZ512;
constexpr size_t OFF_RQ = OFF_CONV + 2 * SZ512, OFF_RK = OFF_RQ + SZ512, OFF_RV = OFF_RK + SZ512, OFF_END = OFF_RV + SZ512;
constexpr size_t OFF_GATE = OFF_KV;
constexpr size_t OFF_HID = OFF_Q;
static_assert(OFF_END <= 512 * MiB, "ws map");
static_assert(OFF_GATE + (size_t)T * 3072 * 2 <= OFF_END && OFF_HID + (size_t)T * 4096 * 2 <= OFF_END, "overlays");
static_assert(OFF_SSQ + (size_t)T * 8 * 4 <= OFF_ATAB && OFF_RTAB + 8448 * 64 * 8 <= OFF_HCTX, "misc map");

constexpr int LDS_BYTES = 155648;

typedef unsigned short bf16_t;
typedef float f32x2_cv __attribute__((ext_vector_type(2))); typedef __bf16 bf16x2_cv __attribute__((ext_vector_type(2)));
__device__ __forceinline__ unsigned pk2(float lo, float hi) { const f32x2_cv v = {lo, hi}; const bf16x2_cv b = __builtin_convertvector(v, bf16x2_cv); return __builtin_bit_cast(unsigned, b); }
__device__ __forceinline__ unsigned f2bf(float f) { return pk2(f, 0.f) & 0xffffu; }
__device__ __forceinline__ float bf2f(unsigned h) { return __builtin_bit_cast(float, h << 16); }
__device__ __forceinline__ float siluf(float x) { return x * __builtin_amdgcn_rcpf(1.f + __expf(-x)); }

__device__ __forceinline__ float shx(float v, int m, int lane) { return __builtin_bit_cast(float, __builtin_amdgcn_ds_bpermute((lane ^ m) << 2, __builtin_bit_cast(int, v))); }

namespace pg8 {
#define PG8_LAS __attribute__((address_space(3)))
typedef unsigned short bf16_t;
typedef short bf16x8 __attribute__((ext_vector_type(8)));
typedef float f32x4 __attribute__((ext_vector_type(4)));
typedef unsigned u32x4 __attribute__((ext_vector_type(4)));
constexpr int BM = 256, BK = 64, HALF = 128, HTB = HALF * BK * 2  , STAGE_BYTES = 8 * HTB, NXCD = 8, WGM = 8;

__host__ __device__ __forceinline__ int lds_byte(int r, int c) { const int st = (r >> 4) * 2 + (c >> 5), rr = r & 15, cc = c & 31, ob = rr * 64 + cc * 2; return st * 1024 + (ob ^ (((ob >> 9) & 1) << 5)); }
__host__ __device__ __forceinline__ void stage_rc(int b, int& R, int& C) { const int st = b / 1024, sb = b % 1024, swz = sb ^ (((sb >> 9) & 1) << 5); R = (st >> 1) * 16 + swz / 64; C = (st & 1) * 32 + (swz % 64) / 2; }
__host__ __device__ __forceinline__ int perm32(int rho) { const int n = rho >> 4, i = rho & 15; return 8 * (i >> 2) + 4 * n + (i & 3); }

struct Unit { int pm, pn, sel; };
struct Gemm { const bf16_t* A; const bf16_t* Bt; size_t strideA, strideB; int M, N, K, ld, packA, packB;
    __device__ __forceinline__ const char* a(int s) const { return (const char*)A + (size_t)s * strideA; }
    __device__ __forceinline__ const char* b(int s) const { return (const char*)Bt + (size_t)s * strideB; } };

struct StaticOrder {
    int nM, nN, nwg, G, c, skipctx;
    __device__ __forceinline__ void init(int M, int N, int G_, int c_, int skip_ = 0) { nM = M / BM; if (skip_) nM = 128; nN = N / BM; nwg = nM * nN; G = G_; c = c_; skipctx = skip_; }
    __device__ __forceinline__ bool tile(long L, Unit& u) const {
        if (L >= nwg) return false;
        int wgid = (int)L; { const int q = nwg / NXCD, r = nwg % NXCD, xcd = wgid % NXCD, off = wgid / NXCD; wgid = (xcd < r ? xcd * (q + 1) : r * (q + 1) + (xcd - r) * q) + off; }
        const int nig = WGM * nN, gid = wgid / nig, fm = gid * WGM, gsz = (nM - fm) < WGM ? (nM - fm) : WGM;
        u.pm = fm + ((wgid % nig) % gsz); if (skipctx) u.pm += (u.pm >> 5) + 1; u.pn = (wgid % nig) / gsz; u.sel = 0; return true;
    }
    __device__ __forceinline__ bool next(int i, Unit& u) const { return tile((long)i * G + c, u); }
    __device__ __forceinline__ void a_ready(const Unit&) const {}
};
struct MergeOrder {
    StaticOrder S;
    __device__ __forceinline__ bool next(int i, Unit& u) const { const int t = i / 3; if (!S.tile((long)t * S.G + S.c, u)) return false; u.sel = i - 3 * t; return true; }
    __device__ __forceinline__ void a_ready(const Unit&) const {}
};


struct CtxSplitOrder {
    int parts, G, c;
    __device__ __forceinline__ bool next(int i, Unit& u) const { const int L = i * G + c; if (L >= 16 * parts) return false; const int t = L & 15; u.pm = 33 * (t >> 2); u.pn = t & 3; u.sel = L >> 4; return true; }
    __device__ __forceinline__ void a_ready(const Unit&) const {}
};
typedef float f32x2 __attribute__((ext_vector_type(2)));
typedef unsigned u32x2 __attribute__((ext_vector_type(2)));

template <int ACT  > struct EpiBf16 {
    static constexpr bool PERM = true;
    bf16_t* O; int ldc, pack;
    __device__ __forceinline__ bool keep(const Unit&) const { return false; }
    __device__ __forceinline__ void operator()(f32x4 (&acc)[2][2][4][2], const Unit& u, int wr, int wc, int fr, int fq) const {
        const int row0 = u.pm * BM + wr * 64 + fr, col0 = u.pn * BM + wc * 32 + 8 * fq;
#pragma unroll
        for (int ai = 0; ai < 2; ++ai)
#pragma unroll
            for (int m = 0; m < 4; ++m) { const int rr = wr * 64 + fr + ai * HALF + m * 16;
                bf16_t* rowp = pack ? O + (((size_t)u.pm * (ldc >> 6) + (col0 >> 6)) * 256 + rr) * 64 + (col0 & 63) : O + (size_t)(row0 + ai * HALF + m * 16) * ldc + col0;
#pragma unroll
                for (int bj = 0; bj < 2; ++bj) { f32x4 v0 = acc[ai][bj][m][0], v1 = acc[ai][bj][m][1];
#pragma unroll
                    for (int e = 0; e < 4; ++e) {
                        if (ACT == 1) { const float a = v0[e] > 0.f ? v0[e] : 0.f, b = v1[e] > 0.f ? v1[e] : 0.f; v0[e] = a * a; v1[e] = b * b; }
                        if (ACT == 2) { float a = __builtin_amdgcn_fmed3f(v0[e], -30.f, 30.f), b = __builtin_amdgcn_fmed3f(v1[e], -30.f, 30.f); v0[e] = __builtin_amdgcn_rcpf(1.f + __expf(-a)); v1[e] = __builtin_amdgcn_rcpf(1.f + __expf(-b)); } }
                    u32x4 w; w.x = pk2(v0[0], v0[1]); w.y = pk2(v0[2], v0[3]); w.z = pk2(v1[0], v1[1]); w.w = pk2(v1[2], v1[3]);
                    *(u32x4*)(rowp + (pack ? bj * (2 * 256 * 64) : bj * HALF)) = w; } }
    }
};

struct EpiResid {
    static constexpr bool PERM = true;
    const float* base_lat; const float* base_ctx; float* out_lat; float* out_ctx; const float* gate;
    __device__ __forceinline__ bool keep(const Unit&) const { return false; }
    __device__ __forceinline__ void operator()(f32x4 (&acc)[2][2][4][2], const Unit& u, int wr, int wc, int fr, int fq) const {
        const int b = u.pm / 33, j = u.pm % 33; const bool isctx = (j == 0);
        const float* gv = gate + (size_t)(isctx ? 4 : b) * MODW;
        const int col0 = u.pn * BM + wc * 32 + 8 * fq;
        f32x4 g[2][2];
#pragma unroll
        for (int bj = 0; bj < 2; ++bj) { g[bj][0] = *(const f32x4*)(gv + col0 + bj * HALF); g[bj][1] = *(const f32x4*)(gv + col0 + bj * HALF + 4); }
        const size_t rbase = isctx ? (size_t)(b * NCTX) : (size_t)(b * NLAT + (j - 1) * 256);
        const float* bp = isctx ? base_ctx : base_lat; float* op = isctx ? out_ctx : out_lat;
#pragma unroll
        for (int ai = 0; ai < 2; ++ai)
#pragma unroll
            for (int m = 0; m < 4; ++m) { const size_t off = (rbase + ai * HALF + wr * 64 + m * 16 + fr) * DM + col0;
#pragma unroll
                for (int bj = 0; bj < 2; ++bj)
#pragma unroll
                    for (int n = 0; n < 2; ++n) { const f32x4 bs = *(const f32x4*)(bp + off + bj * HALF + 4 * n);
                        *(f32x4*)(op + off + bj * HALF + 4 * n) = bs + g[bj][n] * acc[ai][bj][m][n]; } }
    }
};


struct EpiPartial {
    static constexpr bool PERM = true;
    float* part;
    __device__ __forceinline__ bool keep(const Unit&) const { return false; }
    __device__ __forceinline__ void operator()(f32x4 (&acc)[2][2][4][2], const Unit& u, int wr, int wc, int fr, int fq) const {
        { unsigned m_ = ~0u; asm volatile("" : "+s"(m_)); const int ln = (int)__builtin_amdgcn_mbcnt_hi(m_, __builtin_amdgcn_mbcnt_lo(m_, 0u)); fr = ln & 15; fq = ln >> 4; }
        const int b = u.pm / 33; const int col0 = u.pn * BM + wc * 32 + 8 * fq;
        float* pb = part + (size_t)u.sel * (NB * NCTX) * DM;
#pragma unroll
        for (int ai = 0; ai < 2; ++ai)
#pragma unroll
            for (int m = 0; m < 4; ++m) { float* p = pb + ((size_t)(b * NCTX) + ai * HALF + wr * 64 + m * 16 + fr) * DM + col0;
#pragma unroll
                for (int bj = 0; bj < 2; ++bj)
#pragma unroll
                    for (int n = 0; n < 2; ++n) *(f32x4*)(p + bj * HALF + 4 * n) = acc[ai][bj][m][n]; }
    }
};

struct EpiMerge {
    static constexpr bool PERM = true;
    const bf16_t* G; const float* SSQ; bf16_t* O;
    __device__ __forceinline__ bool keep(const Unit& u) const { return u.sel < 2; }
    __device__ __forceinline__ void operator()(f32x4 (&acc)[2][2][4][2], const Unit& u, int wr, int wc, int fr, int fq) const {
        const int row0 = u.pm * BM + wr * 64 + fr, col0 = u.pn * BM + wc * 32 + 8 * fq; const int sel = u.sel;
#pragma unroll
        for (int ai = 0; ai < 2; ++ai)
#pragma unroll
            for (int m = 0; m < 4; ++m) { const size_t row = (size_t)(row0 + ai * HALF + m * 16);
                const f32x4 q0 = *(const f32x4*)(SSQ + row * 8), q1 = *(const f32x4*)(SSQ + row * 8 + 4);
                const float s1 = __builtin_amdgcn_rsqf(((q0[0] + q0[1]) + (q0[2] + q0[3]) + (q1[0] + q1[1]) + (q1[2] + q1[3])) * (1.f / 512.f) + EPS);
#pragma unroll
                for (int bj = 0; bj < 2; ++bj) { const bf16_t* gp = G + row * NGATE + col0 + bj * HALF;
                    float f[8];
                    if (sel == 0) { const u32x4 a = *(const u32x4*)(gp), b = *(const u32x4*)(gp + 1024);
#pragma unroll
                        for (int t = 0; t < 4; ++t) { f[2 * t] = bf2f(a[t] & 0xffffu) * __builtin_amdgcn_rcpf(s1 * bf2f(b[t] & 0xffffu)); f[2 * t + 1] = bf2f(a[t] >> 16) * __builtin_amdgcn_rcpf(s1 * bf2f(b[t] >> 16)); } }
                    else if (sel == 1) { const u32x4 a = *(const u32x4*)(gp + 1024), b = *(const u32x4*)(gp + 2048);
#pragma unroll
                        for (int t = 0; t < 4; ++t) { f[2 * t] = s1 * bf2f(a[t] & 0xffffu) * __builtin_amdgcn_rcpf(bf2f(b[t] & 0xffffu)); f[2 * t + 1] = s1 * bf2f(a[t] >> 16) * __builtin_amdgcn_rcpf(bf2f(b[t] >> 16)); } }
                    else { const u32x4 a = *(const u32x4*)(gp + 2048);
#pragma unroll
                        for (int t = 0; t < 4; ++t) { f[2 * t] = bf2f(a[t] & 0xffffu); f[2 * t + 1] = bf2f(a[t] >> 16); } }
                    f32x4 v0 = acc[ai][bj][m][0], v1 = acc[ai][bj][m][1];
#pragma unroll
                    for (int e = 0; e < 4; ++e) { v0[e] *= f[e]; v1[e] *= f[4 + e]; }
                    if (sel == 2) { u32x4 w; w.x = pk2(v0[0], v0[1]); w.y = pk2(v0[2], v0[3]); w.z = pk2(v1[0], v1[1]); w.w = pk2(v1[2], v1[3]);
                        *(u32x4*)(O + row * DM + col0 + bj * HALF) = w; }
                    else { acc[ai][bj][m][0] = v0; acc[ai][bj][m][1] = v1; } } }
    }
};
struct EpiInProj {
    static constexpr bool PERM = true;
    unsigned char* ws; float* DT;
    const float *qnw, *knw, *dtb; const f32x2 *atab, *rtab;
    __device__ __forceinline__ bool keep(const Unit&) const { return false; }
    __device__ __forceinline__ void store8(bf16_t* p, const float* v) const { u32x4 w; w.x = pk2(v[0], v[1]); w.y = pk2(v[2], v[3]); w.z = pk2(v[4], v[5]); w.w = pk2(v[6], v[7]); *(u32x4*)p = w; }
    __device__ __forceinline__ void operator()(f32x4 (&acc)[2][2][4][2], const Unit& u, int wr, int wc, int fr, int fq) const {
        const int pn = u.pn, j = u.pm % 33; const bool isctx = (j == 0);
        const int rowt = u.pm * BM + wr * 64 + fr, post = j * 256 + wr * 64 + fr;
        if (pn <= 2) {
            const bool isv = (pn == 2 && wc >= 2), isk = (pn == 2 && wc < 2);
            const float* nw = isk ? knw : qnw;
#pragma unroll
            for (int ai = 0; ai < 2; ++ai)
#pragma unroll
                for (int m = 0; m < 4; ++m) {
                    const size_t row = (size_t)(rowt + ai * HALF + m * 16); const int pos = post + ai * HALF + m * 16;
                    float v[2][8];
#pragma unroll
                    for (int bj = 0; bj < 2; ++bj)
#pragma unroll
                        for (int t = 0; t < 8; ++t) v[bj][t] = acc[ai][bj][m][t >> 2][t & 3];
                    if (!isv) {
                        float ss = 0.f;
#pragma unroll
                        for (int bj = 0; bj < 2; ++bj)
#pragma unroll
                            for (int t = 0; t < 8; ++t) ss += v[bj][t] * v[bj][t];
                        ss += shx(ss, 16, fq * 16 + fr); ss += shx(ss, 32, fq * 16 + fr);
                        const float rstd = __builtin_amdgcn_rsqf(ss * (1.f / 64.f) + EPS);
#pragma unroll
                        for (int bj = 0; bj < 2; ++bj) { const f32x4 wa = *(const f32x4*)(nw + 32 * bj + 8 * fq), wb = *(const f32x4*)(nw + 32 * bj + 8 * fq + 4);
#pragma unroll
                            for (int t = 0; t < 4; ++t) { v[bj][t] = v[bj][t] * rstd * wa[t]; v[bj][4 + t] = v[bj][4 + t] * rstd * wb[t]; } }
                        if (!isctx) {
                            const f32x4* tp = (const f32x4*)(atab + (size_t)(pos - NCTX) * 32 + 8 * fq);
#pragma unroll
                            for (int t2 = 0; t2 < 4; ++t2) { const f32x4 cs = tp[t2];
                                { const float x1 = v[0][2 * t2], x2 = v[1][2 * t2]; v[0][2 * t2] = x1 * cs[0] - x2 * cs[1]; v[1][2 * t2] = x1 * cs[1] + x2 * cs[0]; }
                                { const float x1 = v[0][2 * t2 + 1], x2 = v[1][2 * t2 + 1]; v[0][2 * t2 + 1] = x1 * cs[2] - x2 * cs[3]; v[1][2 * t2 + 1] = x1 * cs[3] + x2 * cs[2]; } }
                        }
                        if (pn < 2) {
#pragma unroll
                            for (int bj = 0; bj < 2; ++bj)
#pragma unroll
                                for (int t = 0; t < 8; ++t) v[bj][t] *= QC2;
                        }
                    }
                    const size_t doff = (pn < 2) ? OFF_Q + (row * 512 + 64 * (4 * pn + wc) + 8 * fq) * 2
                                                 : OFF_KV + (row * 256 + (isk ? 64 * wc : 128 + 64 * (wc - 2)) + 8 * fq) * 2;
                    bf16_t* dst = (bf16_t*)(ws + doff);
                    store8(dst, v[0]); store8(dst + 32, v[1]);
                    asm volatile("" ::: "memory");
                }
        } else if (pn >= 9 && pn <= 12) {
            const bool isk = pn >= 11; const int head = 2 * ((pn - 9) & 1) + (wc >> 1);
            bf16_t* dbase = (bf16_t*)(ws + (isk ? OFF_RK : OFF_RQ)) + 128 * head + 32 * (wc & 1) + 8 * fq;
            const float sc = isk ? 0.08838834764831845f : 1.f;
#pragma unroll
            for (int ai = 0; ai < 2; ++ai)
#pragma unroll
                for (int m = 0; m < 4; ++m) {
                    const size_t row = (size_t)(rowt + ai * HALF + m * 16); const int pos = post + ai * HALF + m * 16;
                    const f32x4* tp = (const f32x4*)(rtab + (size_t)pos * 64 + 32 * (wc & 1) + 8 * fq);
                    float o1[8], o2[8];
#pragma unroll
                    for (int t2 = 0; t2 < 4; ++t2) { const f32x4 cs = tp[t2];
                        { const int t = 2 * t2; const float x1 = acc[ai][0][m][t >> 2][t & 3], x2 = acc[ai][1][m][t >> 2][t & 3]; o1[t] = (x1 * cs[0] - x2 * cs[1]) * sc; o2[t] = (x1 * cs[1] + x2 * cs[0]) * sc; }
                        { const int t = 2 * t2 + 1; const float x1 = acc[ai][0][m][t >> 2][t & 3], x2 = acc[ai][1][m][t >> 2][t & 3]; o1[t] = (x1 * cs[2] - x2 * cs[3]) * sc; o2[t] = (x1 * cs[3] + x2 * cs[2]) * sc; } }
                    store8(dbase + row * 512, o1); store8(dbase + row * 512 + 64, o2);
                    asm volatile("" ::: "memory");
                }
        } else if (pn == 17) {
            if (wc == 0 && fq < 2) {
                float bb[8];
#pragma unroll
                for (int t = 0; t < 8; ++t) bb[t] = dtb[8 * fq + t];
#pragma unroll
                for (int ai = 0; ai < 2; ++ai)
#pragma unroll
                    for (int m = 0; m < 4; ++m) { const size_t row = (size_t)(rowt + ai * HALF + m * 16); f32x4 o[2];
#pragma unroll
                        for (int t = 0; t < 8; ++t) { const float x = acc[ai][0][m][t >> 2][t & 3] + bb[t]; o[t >> 2][t & 3] = x > 20.f ? x : log1pf(__expf(x)); }
                        *(f32x4*)(DT + row * 16 + 8 * fq) = o[0]; *(f32x4*)(DT + row * 16 + 8 * fq + 4) = o[1]; }
            }
        } else {
            size_t doff; int ld, cb;
            if (pn <= 4) { doff = OFF_Z; ld = 512; cb = (pn - 3) * 256; } else if (pn <= 8) { doff = OFF_XBC; ld = 1024; cb = (pn - 5) * 256; }
            else if (pn <= 14) { doff = OFF_RV; ld = 512; cb = (pn - 13) * 256; } else { doff = OFF_RG; ld = 512; cb = (pn - 15) * 256; }
            bf16_t* dst = (bf16_t*)(ws + doff);
            cb += wc * 32 + 8 * fq;
#pragma unroll
            for (int ai = 0; ai < 2; ++ai)
#pragma unroll
                for (int m = 0; m < 4; ++m) { bf16_t* rowp = dst + (size_t)(rowt + ai * HALF + m * 16) * ld + cb;
#pragma unroll
                    for (int bj = 0; bj < 2; ++bj) { const f32x4 v0 = acc[ai][bj][m][0], v1 = acc[ai][bj][m][1];
                        u32x4 w; w.x = pk2(v0[0], v0[1]); w.y = pk2(v0[2], v0[3]); w.z = pk2(v1[0], v1[1]); w.w = pk2(v1[2], v1[3]);
                        *(u32x4*)(rowp + bj * HALF) = w; } }
        }
    }
};
template <class Epi, class Sched, bool ALIGN_EPI = false, bool SP2 = false>
__device__ __forceinline__ void gemm_phase(PG8_LAS unsigned char* lds, const Gemm g, const Sched& S, const Epi& E, const int tid_in) {
    const int tid = tid_in, wid = __builtin_amdgcn_readfirstlane(tid >> 6), lane = tid & 63, wr = wid >> 2, wc = wid & 3, fr = lane & 15, fq = lane >> 4;
    const int K = g.K, nt = K / BK;
    unsigned voffA[2], voffB[2];
#pragma unroll
    for (int i = 0; i < 2; ++i) { int R, C; stage_rc(tid * 16 + i * 8192, R, C); const int Rb = Epi::PERM ? ((R & ~31) + perm32(R & 31)) : R;
        voffA[i] = (unsigned)(R * (g.packA ? BK : g.ld) + C) * 2u; voffB[i] = (unsigned)(Rb * (g.packB ? BK : g.ld) + C) * 2u; }
    const size_t kstep = g.packA ? (size_t)(BM * BK * 2) : (size_t)(BK * 2), kstepB = g.packB ? (size_t)(BM * BK * 2) : (size_t)(BK * 2);
    const size_t hstep = g.packA ? (size_t)(HALF * BK * 2) : (size_t)HALF * g.ld * 2, hstepB = g.packB ? (size_t)(HALF * BK * 2) : (size_t)HALF * g.ld * 2;
    const size_t tstep = (size_t)BM * g.ld * 2, tstepB = tstep;
    const unsigned ldsw = (unsigned)wid * 1024u;
    const int aoff = lds_byte(wr * 64 + fr, fq * 8), boff = lds_byte(wc * 32 + fr, fq * 8);
#define PG8_SA(b, h) (((b) * 2 + (h)) * HTB)
#define PG8_SB(b, h) ((4 + (b) * 2 + (h)) * HTB)
#define PG8_STAGE(bufoff, gbase, voff) do { _Pragma("unroll") for (int _i = 0; _i < 2; ++_i) \
        __builtin_amdgcn_global_load_lds((const unsigned*)((const char*)(gbase) + (voff)[_i]), (PG8_LAS unsigned*)(lds + (bufoff) + ldsw + _i * 8192), 16, 0, 0); } while (0)
#define PG8_LDA(dst, b, h) do { _Pragma("unroll") for (int m = 0; m < 4; ++m) _Pragma("unroll") for (int k = 0; k < 2; ++k) dst[m][k] = *(const PG8_LAS bf16x8*)(lds + PG8_SA(b, h) + aoff + m * 2048 + k * 1024); } while (0)
#define PG8_LDB(dst, b, h) do { _Pragma("unroll") for (int n = 0; n < 2; ++n) _Pragma("unroll") for (int k = 0; k < 2; ++k) dst[n][k] = *(const PG8_LAS bf16x8*)(lds + PG8_SB(b, h) + boff + n * 2048 + k * 1024); } while (0)
#define PG8_MMA(ai, bj, At, Bt) do { __builtin_amdgcn_s_setprio(1); _Pragma("unroll") for (int m = 0; m < 4; ++m) _Pragma("unroll") for (int n = 0; n < 2; ++n) _Pragma("unroll") for (int k = 0; k < 2; ++k) \
        acc[ai][bj][m][n] = __builtin_amdgcn_mfma_f32_16x16x32_bf16(Bt[n][k], At[m][k], acc[ai][bj][m][n], 0, 0, 0); __builtin_amdgcn_s_setprio(0); } while (0)
#define PG8_WAIT_V(n) asm volatile("s_waitcnt vmcnt(" #n ")" ::: "memory")
#define PG8_WAIT_L(n) asm volatile("s_waitcnt lgkmcnt(" #n ")" ::: "memory")
#define PG8_BAR __builtin_amdgcn_s_barrier()
#define PG8_SCHED __builtin_amdgcn_sched_barrier(0)
    Unit cur, nxt; int ui = 0;
    if (!S.next(0, cur)) return;
    f32x4 acc[2][2][4][2];
#pragma unroll
    for (int a = 0; a < 2; ++a)
#pragma unroll
        for (int b = 0; b < 2; ++b)
#pragma unroll
            for (int m = 0; m < 4; ++m)
#pragma unroll
                for (int n = 0; n < 2; ++n) acc[a][b][m][n] = (f32x4){0.f, 0.f, 0.f, 0.f};
    bf16x8 At[4][2], B0[2][2], B1[2][2];
    const char* cA = g.a(cur.sel) + (size_t)cur.pm * tstep; const char* cB = g.b(cur.sel) + (size_t)cur.pn * tstepB;
    S.a_ready(cur);
    if constexpr (SP2) {
        PG8_STAGE(PG8_SB(0, 0), cB, voffB); PG8_STAGE(PG8_SB(0, 1), cB + hstepB, voffB); PG8_STAGE(PG8_SA(0, 0), cA, voffA); PG8_STAGE(PG8_SA(0, 1), cA + hstep, voffA);
        if (wr == 1) PG8_BAR;
        PG8_WAIT_V(2); PG8_BAR;
        PG8_STAGE(PG8_SB(1, 0), cB + kstepB, voffB); PG8_STAGE(PG8_SA(1, 0), cA + kstep, voffA); PG8_STAGE(PG8_SB(1, 1), cB + hstepB + kstepB, voffB);
        PG8_WAIT_V(6); PG8_BAR;
    } else {
        PG8_STAGE(PG8_SB(0, 0), cB, voffB); PG8_STAGE(PG8_SA(0, 0), cA, voffA); PG8_STAGE(PG8_SB(0, 1), cB + hstepB, voffB); PG8_STAGE(PG8_SA(0, 1), cA + hstep, voffA);
        if (wr == 1) PG8_BAR;
        PG8_WAIT_V(4); PG8_BAR;
        PG8_STAGE(PG8_SB(1, 0), cB + kstepB, voffB); PG8_STAGE(PG8_SA(1, 0), cA + kstep, voffA); PG8_STAGE(PG8_SB(1, 1), cB + hstepB + kstepB, voffB);
        PG8_WAIT_V(6); PG8_BAR;
    }
    for (;;) {
        const bool has_next = S.next(ui + 1, nxt);
        const char* nA = has_next ? g.a(nxt.sel) + (size_t)nxt.pm * tstep : cA; const char* nB = has_next ? g.b(nxt.sel) + (size_t)nxt.pn * tstepB : cB;
        for (int t = 0; t < nt; t += 2) {
            const bool last = (t == nt - 2);
            const char* a1 = cA + (size_t)(t + 1) * kstep;
            const char* a2 = last ? nA : cA + (size_t)(t + 2) * kstep; const char* b2 = last ? nB : cB + (size_t)(t + 2) * kstepB;
            const char* a3 = a2 + kstep; const char* b3 = b2 + kstepB;
            if (last && has_next) S.a_ready(nxt);
            if constexpr (SP2) {
            PG8_LDB(B0, 0, 0); PG8_LDB(B1, 0, 1); PG8_SCHED; PG8_LDA(At, 0, 0); PG8_STAGE(PG8_SA(1, 1), a1 + hstep, voffA);
            PG8_WAIT_V(8); PG8_WAIT_L(0); PG8_BAR; PG8_MMA(0, 0, At, B0); PG8_MMA(0, 1, At, B1); PG8_BAR; PG8_SCHED;
            PG8_LDA(At, 0, 1); PG8_STAGE(PG8_SB(0, 0), b2, voffB); PG8_STAGE(PG8_SB(0, 1), b2 + hstepB, voffB); PG8_STAGE(PG8_SA(0, 0), a2, voffA);
            PG8_WAIT_V(8); PG8_WAIT_L(0); PG8_BAR; PG8_MMA(1, 0, At, B0); PG8_MMA(1, 1, At, B1); PG8_BAR; PG8_SCHED;
            PG8_LDB(B0, 1, 0); PG8_LDB(B1, 1, 1); PG8_SCHED; PG8_LDA(At, 1, 0); PG8_STAGE(PG8_SA(0, 1), a2 + hstep, voffA);
            PG8_WAIT_V(8); PG8_WAIT_L(0); PG8_BAR; PG8_MMA(0, 0, At, B0); PG8_MMA(0, 1, At, B1); PG8_BAR; PG8_SCHED;
            PG8_LDA(At, 1, 1); PG8_STAGE(PG8_SB(1, 0), b3, voffB); PG8_STAGE(PG8_SB(1, 1), b3 + hstepB, voffB); PG8_STAGE(PG8_SA(1, 0), a3, voffA);
            PG8_WAIT_V(8); PG8_WAIT_L(0); PG8_BAR; PG8_MMA(1, 0, At, B0); PG8_MMA(1, 1, At, B1); PG8_BAR; PG8_SCHED;
            } else {
            PG8_LDB(B0, 0, 0); PG8_SCHED; PG8_LDA(At, 0, 0); PG8_STAGE(PG8_SA(1, 1), a1 + hstep, voffA);
            PG8_WAIT_L(8); PG8_BAR; PG8_WAIT_L(0); PG8_MMA(0, 0, At, B0); PG8_BAR; PG8_SCHED;
            PG8_LDB(B1, 0, 1); PG8_STAGE(PG8_SB(0, 0), b2, voffB);
            PG8_BAR; PG8_WAIT_L(0); PG8_MMA(0, 1, At, B1); PG8_BAR;
            PG8_LDA(At, 0, 1); PG8_STAGE(PG8_SA(0, 0), a2, voffA);
            PG8_BAR; PG8_WAIT_L(0); PG8_MMA(1, 0, At, B0); PG8_BAR; PG8_SCHED;
            PG8_STAGE(PG8_SB(0, 1), b2 + hstepB, voffB);
            PG8_WAIT_V(6); PG8_BAR; PG8_MMA(1, 1, At, B1); PG8_BAR;
            PG8_LDB(B0, 1, 0); PG8_SCHED; PG8_LDA(At, 1, 0); PG8_STAGE(PG8_SA(0, 1), a2 + hstep, voffA);
            PG8_WAIT_L(8); PG8_BAR; PG8_WAIT_L(0); PG8_MMA(0, 0, At, B0); PG8_BAR; PG8_SCHED;
            PG8_LDB(B1, 1, 1); PG8_STAGE(PG8_SB(1, 0), b3, voffB);
            PG8_BAR; PG8_WAIT_L(0); PG8_MMA(0, 1, At, B1); PG8_BAR;
            PG8_LDA(At, 1, 1); PG8_STAGE(PG8_SA(1, 0), a3, voffA);
            PG8_BAR; PG8_WAIT_L(0); PG8_MMA(1, 0, At, B0); PG8_BAR; PG8_SCHED;
            PG8_STAGE(PG8_SB(1, 1), b3 + hstepB, voffB);
            PG8_WAIT_V(6); PG8_BAR; PG8_MMA(1, 1, At, B1); PG8_BAR;
            }
        }
        if constexpr (ALIGN_EPI) { if (wr == 0) PG8_BAR; }
        E(acc, cur, wr, wc, fr, fq);
        if (!has_next) break;
        if (!E.keep(cur)) {
#pragma unroll
        for (int a = 0; a < 2; ++a)
#pragma unroll
            for (int b = 0; b < 2; ++b)
#pragma unroll
                for (int m = 0; m < 4; ++m)
#pragma unroll
                    for (int n = 0; n < 2; ++n) acc[a][b][m][n] = (f32x4){0.f, 0.f, 0.f, 0.f}; }
        cur = nxt; cA = nA; cB = nB; ++ui;
        if constexpr (ALIGN_EPI) { if (wr == 1) PG8_BAR; }
    }
    PG8_WAIT_V(0);
    if constexpr (!ALIGN_EPI) { if (wr == 0) PG8_BAR; }
    PG8_BAR;

#undef PG8_SA
#undef PG8_SB
#undef PG8_STAGE
#undef PG8_LDA
#undef PG8_LDB
#undef PG8_MMA
#undef PG8_WAIT_V
#undef PG8_WAIT_L
#undef PG8_BAR
#undef PG8_SCHED
}
}
#include <hip/hip_bf16.h>
namespace attn_body {
using bf16=__hip_bfloat16;
using bf16x8=__attribute__((ext_vector_type(8)))short;
using s16x4=__attribute__((ext_vector_type(4)))short;
using f32x16=__attribute__((ext_vector_type(16)))float;
using u32x4=__attribute__((ext_vector_type(4)))unsigned;
constexpr int BATCH=2,NHEAD=16,SEQ=8192,D=64,DM=NHEAD*D;
constexpr int NW=8,QBLK=32,QB=QBLK*NW,KVBLK=64,NQB=SEQ/QB;
constexpr int ATTN_PITCH=DM, ATTN_UNIT_ROWS=QB;
__device__ __forceinline__ int crow(int r,int hi){return (r&3)+8*(r>>2)+4*hi;}
#define SBAR() __builtin_amdgcn_sched_barrier(0)
constexpr int NSLOT=3, SLOTB=8192;
constexpr int LDS_K=0, LDS_V=NSLOT*SLOTB, LDS_WS=2*NSLOT*SLOTB, LDS_OST=LDS_WS+NW*64*4, LDS_BYTES=LDS_OST+NW*4096;
constexpr float C2=0.125f*1.4426950408889634f;
__device__ __forceinline__ void glds16(const void*gsrc,unsigned lds_dst){unsigned keep;
  asm volatile("s_mov_b32 %0, m0\n\ts_mov_b32 m0, %2\n\ts_nop 0\n\tglobal_load_lds_dwordx4 %1, off\n\ts_mov_b32 m0, %0":"=&s"(keep):"v"(gsrc),"s"(lds_dst):"memory");}
__device__ __forceinline__ float max3f(float a,float b,float c){float r;asm("v_max3_f32 %0, %1, %2, %3":"=v"(r):"v"(a),"v"(b),"v"(c));return r;}
__device__ __forceinline__ float max2f(float a,float b){float r;asm("v_max_f32_e32 %0, %1, %2":"=v"(r):"v"(a),"v"(b));return r;}
__device__ __forceinline__ float fadd_s(float a,float b){float r;asm("v_add_f32_e32 %0, %1, %2":"=v"(r):"v"(a),"v"(b));return r;}
__device__ __forceinline__ float fsub_s(float a,float b){float r;asm("v_sub_f32_e32 %0, %1, %2":"=v"(r):"v"(a),"v"(b));return r;}
typedef float f32x2_t __attribute__((ext_vector_type(2))); typedef __bf16 bf16x2_t __attribute__((ext_vector_type(2)));
__device__ __forceinline__ unsigned cvtpk_s(float lo,float hi){f32x2_t v={lo,hi};bf16x2_t b=__builtin_convertvector(v,bf16x2_t);return __builtin_bit_cast(unsigned,b);}
#define WAIT_BAR(N) asm volatile("s_waitcnt vmcnt(" #N ") lgkmcnt(0)\n\ts_barrier":::"memory")

__device__ __forceinline__ void qkt(f32x16&p0,f32x16&p1,const char*Kslot,const bf16x8*qr,const f32x16&negm,int r32,int hi){
  const char*kb=Kslot+hi*1024+r32*16;
  #pragma unroll
  for(int d0=0;d0<4;++d0){
    const bf16x8 b0=*reinterpret_cast<const bf16x8*>(kb+d0*2048);
    const bf16x8 b1=*reinterpret_cast<const bf16x8*>(kb+d0*2048+512);
    if(d0==0){p0=__builtin_amdgcn_mfma_f32_32x32x16_bf16(b0,qr[0],negm,0,0,0);p1=__builtin_amdgcn_mfma_f32_32x32x16_bf16(b1,qr[0],negm,0,0,0);}
    else{p0=__builtin_amdgcn_mfma_f32_32x32x16_bf16(b0,qr[d0],p0,0,0,0);p1=__builtin_amdgcn_mfma_f32_32x32x16_bf16(b1,qr[d0],p1,0,0,0);}}
}
typedef __attribute__((address_space(3))) const char* lds_cptr;
typedef short v4i16_t __attribute__((ext_vector_type(4)));
__device__ __forceinline__ void kload8(bf16x8*kf,lds_cptr kp){
  kf[0]=*(const __attribute__((address_space(3))) bf16x8*)(kp);      kf[1]=*(const __attribute__((address_space(3))) bf16x8*)(kp+512);
  kf[2]=*(const __attribute__((address_space(3))) bf16x8*)(kp+2048); kf[3]=*(const __attribute__((address_space(3))) bf16x8*)(kp+2560);
  kf[4]=*(const __attribute__((address_space(3))) bf16x8*)(kp+4096); kf[5]=*(const __attribute__((address_space(3))) bf16x8*)(kp+4608);
  kf[6]=*(const __attribute__((address_space(3))) bf16x8*)(kp+6144); kf[7]=*(const __attribute__((address_space(3))) bf16x8*)(kp+6656);
}
__device__ __forceinline__ void kload2(bf16x8*kf,lds_cptr kp,int j){ kf[2*j]=*(const __attribute__((address_space(3))) bf16x8*)(kp+j*2048); kf[2*j+1]=*(const __attribute__((address_space(3))) bf16x8*)(kp+j*2048+512); }
__device__ __forceinline__ s16x4 vtr(lds_cptr p){ return __builtin_bit_cast(s16x4,__builtin_amdgcn_ds_read_tr16_b64_v4i16((__attribute__((address_space(3))) v4i16_t*)p)); }
__device__ __forceinline__ float rowmax(const f32x16&p0,const f32x16&p1){
  float a=max3f(p0[0],p0[1],p1[0]),b=max3f(p0[2],p0[3],p1[1]);a=max3f(a,p1[2],p1[3]);
  #pragma unroll
  for(int r=4;r<16;r+=4){a=max3f(a,p0[r],p0[r+1]);b=max3f(b,p0[r+2],p0[r+3]);a=max3f(a,p1[r],p1[r+1]);b=max3f(b,p1[r+2],p1[r+3]);}
  const float m=max2f(a,b);
  auto rr=__builtin_amdgcn_permlane32_swap(__float_as_uint(m),__float_as_uint(m),false,false);
  return max2f(__uint_as_float(rr[0]),__uint_as_float(rr[1]));
}
__device__ __forceinline__ void pv(f32x16*o,int vb,bf16x8 pa0,bf16x8 pa1,bf16x8 pa2,bf16x8 pa3){
  #pragma unroll
  for(int d0=0;d0<2;++d0){s16x4 lo[4],hi[4];
    #pragma unroll
    for(int ks=0;ks<4;++ks){
      asm volatile("ds_read_b64_tr_b16 %0,%1 offset:%c2":"=&v"(lo[ks]):"v"(vb),"i"(d0*4096+ks*1024):"memory");
      asm volatile("ds_read_b64_tr_b16 %0,%1 offset:%c2":"=&v"(hi[ks]):"v"(vb),"i"(d0*4096+ks*1024+512):"memory");}
    asm volatile("s_waitcnt lgkmcnt(0)":::"memory");SBAR();
    #define PK(k) (bf16x8){lo[k][0],lo[k][1],lo[k][2],lo[k][3],hi[k][0],hi[k][1],hi[k][2],hi[k][3]}
    o[d0]=__builtin_amdgcn_mfma_f32_32x32x16_bf16(pa0,PK(0),o[d0],0,0,0);
    o[d0]=__builtin_amdgcn_mfma_f32_32x32x16_bf16(pa1,PK(1),o[d0],0,0,0);
    o[d0]=__builtin_amdgcn_mfma_f32_32x32x16_bf16(pa2,PK(2),o[d0],0,0,0);
    o[d0]=__builtin_amdgcn_mfma_f32_32x32x16_bf16(pa3,PK(3),o[d0],0,0,0);
    #undef PK
  }
}
#define ATTN_STORE16(p,v) (*(u32x4*)(p)=(v))
template<int THRL> __device__ __forceinline__ void attn_unit(long qrow0,long krow0,int NT,const bf16*Q,const bf16*__restrict__ K,const bf16*__restrict__ V,bf16*O,char*shm,const int tid_in){
  const int tid=tid_in,lane=tid&63,r32=lane&31,hi=lane>>5; const int wid=__builtin_amdgcn_readfirstlane(tid>>6);
  constexpr int PQ=512,PK=256;
  const bf16*Qw=Q+(qrow0+wid*QBLK)*PQ;
  const bf16*Kh=K+krow0*PK,*Vh=V+krow0*PK;
  const unsigned lds0=(unsigned)(uintptr_t)shm;
  float*wsf=(float*)(shm+LDS_WS)+wid*64;
  const bf16*ksrc=Kh+(long)lane*PK+wid*8;
  const bf16*vsrc=Vh+(long)(16*(wid&3)+(lane>>2))*PK+(wid>>2)*32+(lane&3)*8;
  const unsigned kdst=lds0+LDS_K+wid*1024, vdst=lds0+LDS_V+wid*1024;
  #define DMA_K(t,slot) glds16(ksrc+(long)(t)*KVBLK*PK,(unsigned)__builtin_amdgcn_readfirstlane(kdst+(slot)))
  #define DMA_V(t,slot) glds16(vsrc+(long)(t)*KVBLK*PK,(unsigned)__builtin_amdgcn_readfirstlane(vdst+(slot)))
  const int vb0=(int)(lds0+LDS_V)+((lane>>4)&1)*32+(lane&3)*8+(4*hi+((lane&15)>>2))*64;
  const char*Kbase=shm+LDS_K; bf16x8 kf[8];
  const lds_cptr shm3=(lds_cptr)shm; const lds_cptr kp0=shm3+LDS_K+hi*1024+r32*16; const lds_cptr vp0=shm3+LDS_V+((lane>>4)&1)*32+(lane&3)*8+(4*hi+((lane&15)>>2))*64;

  DMA_K(0,0);DMA_V(0,0);DMA_K(1,SLOTB);
  bf16x8 qr[4];
  #pragma unroll
  for(int d0=0;d0<4;++d0)qr[d0]=*reinterpret_cast<const bf16x8*>(&Qw[(long)r32*PQ+d0*16+hi*8]);
  float mhat=0.f,l_reg=0.f;f32x16 o[2];o[0]=f32x16{};o[1]=f32x16{};f32x16 negm=f32x16{};asm volatile("":"+v"(negm));

  #define CMASK(P0,P1,t) do{}while(0)
  bool resc=false;
  #define START(P0,P1) do{ const float rm=rowmax(P0,P1); resc=false; \
    { const float dl=rm; mhat=fadd_s(mhat,dl); \
      _Pragma("unroll") for(int r=0;r<16;++r){P0[r]=fsub_s(P0[r],dl);P1[r]=fsub_s(P1[r],dl);} \
      _Pragma("unroll") for(int r=0;r<16;++r)negm[r]=-mhat; asm volatile("":"+v"(negm)); } \
    _Pragma("unroll") for(int r=0;r<16;++r)P0[r]=__builtin_amdgcn_exp2f(P0[r]); }while(0)
  #define RESC() do{ if(resc){ asm volatile("s_waitcnt lgkmcnt(0)":::"memory"); \
      _Pragma("unroll") for(int d_=0;d_<2;++d_) _Pragma("unroll") for(int r=0;r<16;++r)o[d_][r]*=wsf[crow(r,hi)]; } }while(0)
  f32x16 pA0,pA1,pB0,pB1;
  int sl_prev=0,sl_cur=0,sl_next=SLOTB;
  #define ROT() do{sl_prev=sl_cur;sl_cur=sl_next;sl_next=(sl_next==(NSLOT-1)*SLOTB)?0:sl_next+SLOTB;}while(0)
  DMA_K(2,2*SLOTB);
  WAIT_BAR(3);
  qkt(pA0,pA1,Kbase,qr,negm,r32,hi);asm volatile("s_nop 15\n\ts_nop 7":"+v"(pA0),"+v"(pA1));CMASK(pA0,pA1,0);
  START(pA0,pA1);
  _Pragma("unroll") for(int r=0;r<16;++r)pA1[r]=__builtin_amdgcn_exp2f(pA1[r]);
  WAIT_BAR(0);
  DMA_K(3,0);DMA_V(1,SLOTB);
  ROT();
  kload8(kf,kp0+sl_cur);
  WAIT_BAR(2);
  s16x4 vlo[8],vhi[8]; u32x4 pw0,pw1,pw2,pw3;
  #define PKW(P,B) cvtpk_s(P[B],P[B+1])
  #define PAF(k) __builtin_bit_cast(bf16x8,pw##k)
  #define VFR(i) (bf16x8){vlo[i][0],vlo[i][1],vlo[i][2],vlo[i][3],vhi[i][0],vhi[i][1],vhi[i][2],vhi[i][3]}
  #define PIN(x) asm volatile("":"+v"(x))
  #define MX3(a,b,c) __builtin_fmaxf(__builtin_fmaxf((a),(b)),(c))
  #define GAPA(MF,A0,A1,A2,A3,W0,W1,PW) do{ MF; sacc+=A0; sacc+=A1; sacc+=A2; sacc+=A3; PIN(sacc); W0; W1; PIN(PW); SBAR(); }while(0)
  #define EX(v) __builtin_amdgcn_exp2f(v)
  #define GAPB(MF,X,B) do{ MF; X[B]=EX(X[B]); X[B+1]=EX(X[B+1]); X[B+2]=EX(X[B+2]); X[B+3]=EX(X[B+3]); PIN(X); SBAR(); }while(0)
  #define VRD(i) do{ vlo[i]=vtr(vp_+(((i)>>2)*4096+((i)&3)*1024)); vhi[i]=vtr(vp_+(((i)>>2)*4096+((i)&3)*1024+512)); }while(0)
  #define KRD(G,j) do{ if(G){ kload2(kf,kp0+sl_next,j); SBAR(); } }while(0)
  #define STEP(C0,C1,P0,P1,t,GK,GV,GL) do{ SBAR(); \
    const lds_cptr vp_=vp0+sl_prev; \
    VRD(0); SBAR(); float sacc=(P0[0]+P0[1]); \
    GAPA(C0=__builtin_amdgcn_mfma_f32_32x32x16_bf16(kf[0],qr[0],negm,0,0,0), P0[2],P0[3],P0[4],P0[5],     pw0[0]=PKW(P0,0), pw0[1]=PKW(P0,2), pw0); \
    VRD(4); SBAR(); GAPA(C1=__builtin_amdgcn_mfma_f32_32x32x16_bf16(kf[1],qr[0],negm,0,0,0), P0[6],P0[7],P0[8],P0[9],     pw0[2]=PKW(P0,4), pw0[3]=PKW(P0,6), pw0); \
    VRD(1); SBAR(); GAPA(C0=__builtin_amdgcn_mfma_f32_32x32x16_bf16(kf[2],qr[1],C0,0,0,0),   P0[10],P0[11],P0[12],P0[13], pw1[0]=PKW(P0,8), pw1[1]=PKW(P0,10), pw1); \
    VRD(5); SBAR(); GAPA(C1=__builtin_amdgcn_mfma_f32_32x32x16_bf16(kf[3],qr[1],C1,0,0,0),   P0[14],P0[15],P1[0],P1[1],   pw1[2]=PKW(P0,12),pw1[3]=PKW(P0,14), pw1); \
    VRD(2); SBAR(); GAPA(C0=__builtin_amdgcn_mfma_f32_32x32x16_bf16(kf[4],qr[2],C0,0,0,0),   P1[2],P1[3],P1[4],P1[5],     pw2[0]=PKW(P1,0), pw2[1]=PKW(P1,2), pw2); \
    VRD(6); SBAR(); GAPA(C1=__builtin_amdgcn_mfma_f32_32x32x16_bf16(kf[5],qr[2],C1,0,0,0),   P1[6],P1[7],P1[8],P1[9],     pw2[2]=PKW(P1,4), pw2[3]=PKW(P1,6), pw2); \
    VRD(3); SBAR(); GAPA(C0=__builtin_amdgcn_mfma_f32_32x32x16_bf16(kf[6],qr[3],C0,0,0,0),   P1[10],P1[11],P1[12],P1[13], pw3[0]=PKW(P1,8), pw3[1]=PKW(P1,10), pw3); \
    VRD(7); SBAR(); GAPA(C1=__builtin_amdgcn_mfma_f32_32x32x16_bf16(kf[7],qr[3],C1,0,0,0),   P1[14],P1[15],0.f,0.f,       pw3[2]=PKW(P1,12),pw3[3]=PKW(P1,14), pw3); \
    l_reg+=sacc; \
    if(GK){DMA_K((t)+3,sl_cur);} if(GV){DMA_V((t)+1,sl_next);} \
    CMASK(C0,C1,t); \
    { float a=MX3(C0[0],C0[1],C1[0]),b=MX3(C0[2],C0[3],C1[1]); a=MX3(a,C1[2],C1[3]); \
      _Pragma("unroll") for(int r=4;r<16;r+=4){a=MX3(a,C0[r],C0[r+1]);b=MX3(b,C0[r+2],C0[r+3]);a=MX3(a,C1[r],C1[r+1]);b=MX3(b,C1[r+2],C1[r+3]);} \
      float rm=__builtin_fmaxf(a,b); { auto rr=__builtin_amdgcn_permlane32_swap(__float_as_uint(rm),__float_as_uint(rm),false,false); rm=__builtin_fmaxf(__uint_as_float(rr[0]),__uint_as_float(rr[1])); } \
      resc=false; \
      if(__builtin_expect(__any(rm>(float)THRL),0)){ const float dl=__builtin_fmaxf(rm,0.f); mhat+=dl; \
        _Pragma("unroll") for(int r=0;r<16;++r){C0[r]-=dl;C1[r]-=dl;} \
        _Pragma("unroll") for(int r=0;r<16;++r)negm[r]=-mhat; asm volatile("":"+v"(negm)); \
        const float f=__builtin_amdgcn_exp2f(-dl); l_reg*=f; if(hi==0)wsf[r32]=f; resc=true; } } \
    SBAR(); \
    GAPB(o[0]=__builtin_amdgcn_mfma_f32_32x32x16_bf16(PAF(0),VFR(0),o[0],0,0,0), C0,0); \
    GAPB(o[1]=__builtin_amdgcn_mfma_f32_32x32x16_bf16(PAF(0),VFR(4),o[1],0,0,0), C0,4); \
    KRD(GL,0); GAPB(o[0]=__builtin_amdgcn_mfma_f32_32x32x16_bf16(PAF(1),VFR(1),o[0],0,0,0), C0,8); \
    KRD(GL,1); GAPB(o[1]=__builtin_amdgcn_mfma_f32_32x32x16_bf16(PAF(1),VFR(5),o[1],0,0,0), C0,12); \
    KRD(GL,2); GAPB(o[0]=__builtin_amdgcn_mfma_f32_32x32x16_bf16(PAF(2),VFR(2),o[0],0,0,0), C1,0); \
    KRD(GL,3); GAPB(o[1]=__builtin_amdgcn_mfma_f32_32x32x16_bf16(PAF(2),VFR(6),o[1],0,0,0), C1,4); \
    GAPB(o[0]=__builtin_amdgcn_mfma_f32_32x32x16_bf16(PAF(3),VFR(3),o[0],0,0,0), C1,8); \
    GAPB(o[1]=__builtin_amdgcn_mfma_f32_32x32x16_bf16(PAF(3),VFR(7),o[1],0,0,0), C1,12); \
    }while(0)
  int t=1;
  #undef CMASK
  #define CMASK(P0,P1,t) do{}while(0)
  for(;t+5<NT;t+=2){
    STEP(pB0,pB1,pA0,pA1,t,true,true,true);     WAIT_BAR(2); RESC(); ROT();
    STEP(pA0,pA1,pB0,pB1,t+1,true,true,true);   WAIT_BAR(2); RESC(); ROT();
  }
  #undef CMASK
  #define CMASK(P0,P1,t) do{}while(0)
  #define ENDW(tt) do{ if((tt)+3<NT){WAIT_BAR(2);} else if((tt)+2<NT){WAIT_BAR(1);} else {WAIT_BAR(0);} }while(0)
  for(;t+1<NT;t+=2){
    STEP(pB0,pB1,pA0,pA1,t,(t+3<NT),(t+1<NT),(t+1<NT));       ENDW(t);   RESC(); ROT();
    STEP(pA0,pA1,pB0,pB1,t+1,(t+4<NT),(t+2<NT),(t+2<NT));     ENDW(t+1); RESC(); ROT();
  }
  STEP(pB0,pB1,pA0,pA1,NT-1,false,false,false); RESC();
  { float sacc=pB0[0]+pB0[1]; _Pragma("unroll") for(int r=2;r<16;++r)sacc+=pB0[r]; _Pragma("unroll") for(int r=0;r<16;++r)sacc+=pB1[r]; l_reg+=sacc;
    pw0=(u32x4){PKW(pB0,0),PKW(pB0,2),PKW(pB0,4),PKW(pB0,6)};pw1=(u32x4){PKW(pB0,8),PKW(pB0,10),PKW(pB0,12),PKW(pB0,14)};pw2=(u32x4){PKW(pB1,0),PKW(pB1,2),PKW(pB1,4),PKW(pB1,6)};pw3=(u32x4){PKW(pB1,8),PKW(pB1,10),PKW(pB1,12),PKW(pB1,14)};
    SBAR(); pv(o,vb0+sl_cur,PAF(0),PAF(1),PAF(2),PAF(3)); }
  #undef PKW
  #undef PAF
  #undef VFR
  #undef PIN
  #undef MX3
  #undef GAPA
  #undef GAPB
  #undef EX
  #undef VRD
  #undef KRD
  #undef STEP
  #undef ENDW
  {auto rr=__builtin_amdgcn_permlane32_swap(__float_as_uint(l_reg),__float_as_uint(l_reg),false,false);l_reg=__uint_as_float(rr[0])+__uint_as_float(rr[1]);}
  if(hi==0)wsf[32+r32]=l_reg;asm volatile("s_waitcnt lgkmcnt(0)":::"memory");
  float rli[16];
  #pragma unroll
  for(int r=0;r<16;++r)rli[r]=__builtin_amdgcn_rcpf(wsf[32+crow(r,hi)]);
  bf16*Ow=O+(qrow0+wid*QBLK)*PQ;
  { bf16*stg=(bf16*)(shm+LDS_OST)+wid*2048;
    #pragma unroll
    for(int r=0;r<16;++r){const int orow=crow(r,hi);
      #pragma unroll
      for(int d0=0;d0<2;++d0)stg[orow*64+d0*32+r32]=__float2bfloat16(o[d0][r]*rli[r]);}
    asm volatile("s_waitcnt lgkmcnt(0)":::"memory");
    #pragma unroll
    for(int i=0;i<4;++i){const int row=i*8+(lane>>3),ch=lane&7; const u32x4 v=*(const u32x4*)(stg+row*64+ch*8); ATTN_STORE16(Ow+(long)row*PQ+ch*8,v);} }
  asm volatile("s_waitcnt lgkmcnt(0)\n\ts_barrier":::"memory");
  #undef DMA_K
  #undef DMA_V
  #undef CMASK
  #undef START
  #undef RESC
  #undef ROT
}
#undef SBAR
#undef WAIT_BAR
}
#define LAS __attribute__((address_space(3)))
typedef short bf16x8 __attribute__((ext_vector_type(8)));
typedef float f32x4 __attribute__((ext_vector_type(4)));
typedef float f32x2 __attribute__((ext_vector_type(2)));
typedef unsigned u32x4 __attribute__((ext_vector_type(4)));
typedef unsigned u32x2 __attribute__((ext_vector_type(2)));

struct Args {
    const float* in[24]; float* out; unsigned char* ws; int ph_lo, ph_hi;
};

__device__ __forceinline__ float wave_sum(float v, int lane) {
#pragma unroll
    for (int o = 1; o < 64; o <<= 1) v += shx(v, o, lane);
    return v;
}

__device__ __forceinline__ void transpose_item(const float* W, int ldw, int k0, int src0, int nvalid, bf16_t* WT, int K, int dst0, const float* kscale, LAS float* scr, int lane) {
#pragma unroll
    for (int i = 0; i < 32; ++i) { const int kk = 2 * i + (lane >> 5), c = lane & 31;
        float v = (c < nvalid) ? W[(size_t)(k0 + kk) * ldw + src0 + c] : 0.f; if (kscale) v *= kscale[k0 + kk];
        scr[kk * 33 + c] = v; }
    asm volatile("s_waitcnt lgkmcnt(0)" ::: "memory");
    const int c = lane & 7;
#pragma unroll
    for (int j = 0; j < 4; ++j) { const int n = (lane >> 3) + 8 * j; const LAS float* s = scr + (8 * c) * 33 + n;
        u32x4 o; o.x = pk2(s[0 * 33], s[1 * 33]); o.y = pk2(s[2 * 33], s[3 * 33]); o.z = pk2(s[4 * 33], s[5 * 33]); o.w = pk2(s[6 * 33], s[7 * 33]);
        const int row = dst0 + n; *(u32x4*)(WT + ((((size_t)(row >> 8) * (K >> 6) + (k0 >> 6)) * 256 + (row & 255)) * 64) + 8 * c) = o; }
    asm volatile("s_waitcnt lgkmcnt(0)" ::: "memory");
}
__device__ __forceinline__ int inproj_src(int lam0, int& nvalid) {
    nvalid = 32;
    const int t = lam0 >> 8, loc = lam0 & 255, bj = loc >> 7, wc = (loc >> 5) & 3;
    if (t < 2) return 64 * (4 * t + wc) + 32 * bj;
    if (t == 2) return wc < 2 ? 512 + 64 * wc + 32 * bj : 640 + 64 * (wc - 2) + 32 * bj;
    if (t < 9) return lam0;
    if (t < 13) { const int base = t < 11 ? 2320 : 2832, head = 2 * ((t - 9) & 1) + (wc >> 1); return base + 128 * head + 64 * bj + 32 * (wc & 1); }
    if (t < 17) return lam0 + 16;
    if (loc == 0) { nvalid = 16; return 2304; }
    nvalid = 0; return 0;
}

typedef const __attribute__((address_space(4))) Args* CArgsP;
__device__ __forceinline__ void prologue_phase(CArgsP a, LAS unsigned char* lds, int tid, int lane, int wave) {
    unsigned char* ws = a->ws;
    const int G = gridDim.x, gw = blockIdx.x * 8 + wave, NGW = G * 8;
    LAS float* scr = (LAS float*)(lds + wave * 8448);
    constexpr int I1 = 144 * 16, I2 = 96 * 16, I3 = 3 * 32 * 8, I4 = 32 * 16, I5 = 128 * 16, I6 = 32 * 64, IL = I1 + I2 + I3 + I4 + I5 + I6;
    for (int it = gw; it < 2 * IL; it += NGW) {
        const int L = it / IL; int r = it % IL;
        unsigned char* wl = ws + OFF_W + (size_t)L * W_LAYER;
        const float* w_in = a->in[8] + (size_t)L * DM * INDIM;
        if (r < I1) { const int lb = r % 144, kb = r / 144; int nv; const int src = inproj_src(lb * 32, nv);
            transpose_item(w_in, INDIM, kb * 64, src, nv, (bf16_t*)(wl + W_P), DM, lb * 32, nullptr, scr, lane); continue; } r -= I1;
        if (r < I2) { const int lb = r % 96, kb = r / 96;
            transpose_item(w_in, INDIM, kb * 64, 4368 + lb * 32, 32, (bf16_t*)(wl + W_G), DM, lb * 32, nullptr, scr, lane); continue; } r -= I2;
        if (r < I3) { const int i = r / 256, q = r % 256, lb = q % 32, kb = q / 32;
            transpose_item(a->in[19] + ((size_t)L * 3 + i) * 512 * DM, DM, kb * 64, lb * 32, 32, (bf16_t*)(wl + W_B) + (size_t)i * DM * 512, 512, lb * 32,
                           i == 1 ? a->in[16] + L * 512 : nullptr, scr, lane); continue; } r -= I3;
        if (r < I4) { const int lb = r % 32, kb = r / 32;
            transpose_item(a->in[20] + (size_t)L * DM * DM, DM, kb * 64, lb * 32, 32, (bf16_t*)(wl + W_O), DM, lb * 32, nullptr, scr, lane); continue; } r -= I4;
        if (r < I5) { const int lb = r % 128, kb = r / 128;
            transpose_item(a->in[21] + (size_t)L * DM * HID, HID, kb * 64, lb * 32, 32, (bf16_t*)(wl + W_1), DM, lb * 32, nullptr, scr, lane); continue; } r -= I5;
        { const int lb = r % 32, kb = r / 32;
            transpose_item(a->in[22] + (size_t)L * HID * DM, DM, kb * 64, lb * 32, 32, (bf16_t*)(wl + W_2), HID, lb * 32, nullptr, scr, lane); }
    }
    { f32x2* atab = (f32x2*)(ws + OFF_ATAB); f32x2* rtab = (f32x2*)(ws + OFF_RTAB);
      const int gt = blockIdx.x * 512 + tid, NT_ = G * 512;
      for (int i = gt; i < NLAT * 32; i += NT_) { const int p = i >> 5, f = i & 31;
          const float inv = exp2f(-(float)(f & 15) * (13.287712379549449f / 16.f)); const float ang = (float)(f < 16 ? (p >> 6) : (p & 63)) * inv;
          const double rv = (double)ang * 0.15915494309189535; const float fr_ = (float)(rv - __builtin_rint(rv));
          atab[i] = (f32x2){__builtin_amdgcn_cosf(fr_), __builtin_amdgcn_sinf(fr_)}; }
      for (int i = gt; i < SA * 64; i += NT_) { const int p = i >> 6, f = i & 63;
          const float inv = exp2f(-((float)f / 63.f) * 13.287712379549449f); const float ang = (float)p * inv;
          const double rv = (double)ang * 0.15915494309189535; const float fr_ = (float)(rv - __builtin_rint(rv));
          rtab[i] = (f32x2){__builtin_amdgcn_cosf(fr_), __builtin_amdgcn_sinf(fr_)}; } }
    { LAS float* sc = (LAS float*)(lds + 73728);
      LAS float* red = (LAS float*)(lds + 98304);
      __syncthreads();
      for (int i = tid; i < 5 * DM; i += 512) { const int r = i >> 10, k = i & 1023; const float x = r < 4 ? a->in[1][r * DM + k] : a->in[3][k]; sc[i] = siluf(x); }
      __syncthreads();
      float* mod = (float*)(ws + OFF_MOD);
      for (int it = blockIdx.x; it < 2 * 96; it += G) { const int L = it / 96, cb = (it % 96) * 64;
          const float* wm = a->in[4] + (size_t)L * DM * MODW + cb + lane;
          float acc[5] = {0.f, 0.f, 0.f, 0.f, 0.f};
#pragma unroll 32
          for (int k = wave * 128; k < wave * 128 + 128; ++k) { const float wv = wm[(size_t)k * MODW];
#pragma unroll
              for (int r = 0; r < 5; ++r) acc[r] += sc[r * DM + k] * wv; }
#pragma unroll
          for (int r = 0; r < 5; ++r) red[(wave * 5 + r) * 64 + lane] = acc[r];
          __syncthreads();
          if (tid < 320) { const int r = tid >> 6, l = tid & 63; float s = 0.f;
#pragma unroll
              for (int w = 0; w < 8; ++w) s += red[(w * 5 + r) * 64 + l];
              mod[((size_t)L * 5 + r) * MODW + cb + l] = s + a->in[5][L * MODW + cb + l]; }
          __syncthreads();
      } }
}

__device__ __forceinline__ void norm_mod_phase(const float* hlat, const float* hctx, const float* w, const float* modL, int shift_idx, int scale_idx, bf16_t* U, int lane, int wave,
                                               const float* part = nullptr, int nparts = 0, const float* pgate = nullptr, float* wb = nullptr) {
    const int gw = blockIdx.x * 8 + wave, NGW = gridDim.x * 8;
    f32x4 wv[4];
#pragma unroll
    for (int j = 0; j < 4; ++j) wv[j] = *(const f32x4*)(w + 4 * lane + 256 * j);
    for (int row0 = gw; row0 < T; row0 += 2 * NGW) {
        f32x4 v[2][4]; float s[2]; const float* mrow[2]; bool ok[2];
#pragma unroll
        for (int q = 0; q < 2; ++q) { const int row = row0 + q * NGW; ok[q] = row < T; const int rr = ok[q] ? row : row0;
            const int b = rr / SA, pos = rr % SA; const bool isctx = pos < NCTX;
            const float* src = isctx ? hctx + (size_t)(b * NCTX + pos) * DM : hlat + (size_t)(b * NLAT + pos - NCTX) * DM;
            mrow[q] = modL + (size_t)(isctx ? 4 : b) * MODW; s[q] = 0.f;
#pragma unroll
            for (int j = 0; j < 4; ++j) v[q][j] = *(const f32x4*)(src + 4 * lane + 256 * j);
            if (part && isctx) {
                const float* pp = part + (size_t)(b * NCTX + pos) * DM + 4 * lane;
#pragma unroll
                for (int j = 0; j < 4; ++j) { f32x4 acc = {0.f, 0.f, 0.f, 0.f};
                    for (int p = 0; p < nparts; ++p) acc += *(const f32x4*)(pp + (size_t)p * (NB * NCTX) * DM + 256 * j);
                    v[q][j] += *(const f32x4*)(pgate + 4 * lane + 256 * j) * acc;
                    if (wb && ok[q]) *(f32x4*)(wb + (size_t)(b * NCTX + pos) * DM + 4 * lane + 256 * j) = v[q][j]; } } }
#pragma unroll
        for (int q = 0; q < 2; ++q) {
#pragma unroll
            for (int j = 0; j < 4; ++j) s[q] += (v[q][j][0] * v[q][j][0] + v[q][j][1] * v[q][j][1]) + (v[q][j][2] * v[q][j][2] + v[q][j][3] * v[q][j][3]);
            const float rstd = __builtin_amdgcn_rsqf(wave_sum(s[q], lane) * (1.f / DM) + EPS);
            if (ok[q]) {
#pragma unroll
                for (int j = 0; j < 4; ++j) { const f32x4 sh = *(const f32x4*)(mrow[q] + shift_idx * DM + 4 * lane + 256 * j), scl = *(const f32x4*)(mrow[q] + scale_idx * DM + 4 * lane + 256 * j);
                    f32x4 y = v[q][j] * rstd * wv[j]; y = y * (scl + 1.f) + sh;
                    u32x2 o; o.x = pk2(y[0], y[1]); o.y = pk2(y[2], y[3]); *(u32x2*)(U + (size_t)(row0 + q * NGW) * DM + 4 * lane + 256 * j) = o; } } }
    }
}
__device__ __forceinline__ void final_norm_phase(float* hlat, const float* w, int lane, int wave) {
    const int gw = blockIdx.x * 8 + wave, NGW = gridDim.x * 8;
    f32x4 wv[4];
#pragma unroll
    for (int j = 0; j < 4; ++j) wv[j] = *(const f32x4*)(w + 4 * lane + 256 * j);
    for (int row0 = gw; row0 < NB * NLAT; row0 += 2 * NGW) {
        f32x4 v[2][4]; bool ok[2];
#pragma unroll
        for (int q = 0; q < 2; ++q) { const int row = row0 + q * NGW; ok[q] = row < NB * NLAT; const float* src = hlat + (size_t)(ok[q] ? row : row0) * DM;
#pragma unroll
            for (int j = 0; j < 4; ++j) v[q][j] = *(const f32x4*)(src + 4 * lane + 256 * j); }
#pragma unroll
        for (int q = 0; q < 2; ++q) { float s = 0.f;
#pragma unroll
            for (int j = 0; j < 4; ++j) s += (v[q][j][0] * v[q][j][0] + v[q][j][1] * v[q][j][1]) + (v[q][j][2] * v[q][j][2] + v[q][j][3] * v[q][j][3]);
            const float rstd = __builtin_amdgcn_rsqf(wave_sum(s, lane) * (1.f / DM) + EPS);
            if (ok[q]) { float* dst = hlat + (size_t)(row0 + q * NGW) * DM;
#pragma unroll
                for (int j = 0; j < 4; ++j) *(f32x4*)(dst + 4 * lane + 256 * j) = v[q][j] * rstd * wv[j]; } }
    }
}
__device__ __forceinline__ void postproj_phase(const bf16_t* __restrict__ XBC, bf16_t* __restrict__ CONV, const float* cw, const float* cb, float* DT, float* Gc, float* CD, const float* a_log, const bf16_t* U, const bf16_t* Wdt, const float* dtb, int tid, int lane, int wave) {
    const int gw = blockIdx.x * 8 + wave, NGW = gridDim.x * 8;
    f32x4 w0[2][2], w1[2][2], w2[2][2], wb[2][2];
#pragma unroll
    for (int j = 0; j < 2; ++j)
#pragma unroll
        for (int h = 0; h < 2; ++h) { const int c = 8 * (lane + 64 * j) + 4 * h;
            w0[j][h] = *(const f32x4*)(cw + c); w1[j][h] = *(const f32x4*)(cw + 1024 + c); w2[j][h] = *(const f32x4*)(cw + 2048 + c); wb[j][h] = *(const f32x4*)(cb + c); }
#pragma unroll 2
    for (int row = gw; row < T; row += NGW) {
        const int pos = row % SA;
        const bool hasp = (pos != 0 && pos != NCTX), hasn = (pos != NCTX - 1 && pos != SA - 1);
#pragma unroll
        for (int j = 0; j < 2; ++j) { const int c0 = 8 * (lane + 64 * j);
            const bf16_t* p = XBC + (size_t)row * 1024 + c0;
            const u32x4 xc = *(const u32x4*)p; u32x4 xp = {0u, 0u, 0u, 0u}, xn = {0u, 0u, 0u, 0u};
            if (hasp) xp = *(const u32x4*)(p - 1024);
            if (hasn) xn = *(const u32x4*)(p + 1024);
            float o[8];
#pragma unroll
            for (int t = 0; t < 4; ++t) {
#pragma unroll
                for (int hh = 0; hh < 2; ++hh) { const int e = 2 * t + hh;
                    const float a = hh ? bf2f(xp[t] >> 16) : bf2f(xp[t] & 0xffffu), b = hh ? bf2f(xc[t] >> 16) : bf2f(xc[t] & 0xffffu), d = hh ? bf2f(xn[t] >> 16) : bf2f(xn[t] & 0xffffu);
                    const float y = w0[j][e >> 2][e & 3] * a + w1[j][e >> 2][e & 3] * b + w2[j][e >> 2][e & 3] * d + wb[j][e >> 2][e & 3];
                    o[e] = siluf(y); } }
            u32x4 w; w.x = pk2(o[0], o[1]); w.y = pk2(o[2], o[3]); w.z = pk2(o[4], o[5]); w.w = pk2(o[6], o[7]);
            *(u32x4*)(CONV + (size_t)row * 1024 + c0) = w; }
    }
    for (int u = blockIdx.x; u < NB * NCH; u += gridDim.x) {
        {
            const int fr = lane & 15, fq = lane >> 4; const size_t r0 = (size_t)(u / NCH) * SA + 128 * (u % NCH) + 16 * wave;
            const bf16_t* ap = U + (r0 + fr) * DM + 8 * fq; const bf16_t* bp = Wdt + (size_t)fr * 64 + 8 * fq;
            f32x4 acc = {0.f, 0.f, 0.f, 0.f};
#pragma unroll 8
            for (int kk = 0; kk < 32; ++kk) acc = __builtin_amdgcn_mfma_f32_16x16x32_bf16(*(const bf16x8*)(ap + 32 * kk), *(const bf16x8*)(bp + (size_t)(kk >> 1) * (256 * 64) + 32 * (kk & 1)), acc, 0, 0, 0);
            const float bias = dtb[fr];
#pragma unroll
            for (int r = 0; r < 4; ++r) { const float x = acc[r] + bias; DT[(r0 + 4 * fq + r) * 16 + fr] = x > 20.f ? x : log1pf(__expf(x)); }
        }
        __syncthreads();
        if (tid < 16) { const int b = u / NCH, c = u % NCH, dir = tid >> 3, h = tid & 7; const size_t row0 = (size_t)b * SA + 128 * c;
            const float an = -__expf(a_log[tid]); float g = 0.f;
            for (int l0 = 0; l0 < 128; l0 += 16) { float v[16];
#pragma unroll
                for (int j = 0; j < 16; ++j) { const int l = dir ? 127 - (l0 + j) : l0 + j; v[j] = __hip_atomic_load(DT + (row0 + l) * 16 + tid, __ATOMIC_RELAXED, __HIP_MEMORY_SCOPE_AGENT); }
#pragma unroll
                for (int j = 0; j < 16; ++j) { const int l = dir ? 127 - (l0 + j) : l0 + j; g += an * v[j]; Gc[(row0 + l) * 16 + tid] = g; } }
            CD[(((size_t)b * 2 + dir) * NCH + c) * 8 + h] = __expf(g); }
    }
}

constexpr int LP = 136;
struct LinArgs {
    const bf16_t* Qn; const bf16_t* Kn; const bf16_t* Vn; int ld;
    bf16_t* ST;
    const float* Gc; const float* DT; const float* CD;
    const float* rld;
};
__device__ __forceinline__ f32x4 mfma16(bf16x8 a, bf16x8 b, f32x4 c) { return __builtin_amdgcn_mfma_f32_16x16x32_bf16(a, b, c, 0, 0, 0); }

template <bool SSD> __device__ __forceinline__ void lin_gdt(const LinArgs& A, size_t row0, int dir, int h, int s, float& g, float& glast, float& dt) {
    if (SSD) { g = A.Gc[(row0 + s) * 16 + dir * 8 + h]; glast = A.Gc[(row0 + (dir ? 0 : 127)) * 16 + dir * 8 + h]; dt = A.DT[(row0 + s) * 16 + dir * 8 + h]; }
    else { const float lg = -__expf(A.rld[dir * 4 + h]);
        g = (float)(dir ? 128 - s : s + 1) * lg; glast = 128.f * lg; dt = 1.f; }
}
template <bool SCALE> __device__ __forceinline__ void stage_T(LAS bf16_t* dst, const bf16_t* src, int ld, size_t row0, int col0, int ncols, const LAS float* wts, int dvw, int tid) {
    const int nch = ncols >> 3;
    for (int id = tid; id < 128 * nch; id += 512) { const int s = id & 127, q = id >> 7;
        const u32x4 x = *(const u32x4*)(src + (row0 + s) * ld + col0 + 8 * q);
        float wv = 1.f; if (SCALE) wv = wts[((8 * q) / dvw) * 128 + s];
#pragma unroll
        for (int t = 0; t < 4; ++t) { float lo = bf2f(x[t] & 0xffffu), hi = bf2f(x[t] >> 16);
            if (SCALE) { lo *= wv; hi *= wv; dst[(8 * q + 2 * t) * LP + s] = (bf16_t)f2bf(lo); dst[(8 * q + 2 * t + 1) * LP + s] = (bf16_t)f2bf(hi); }
            else { dst[(8 * q + 2 * t) * LP + s] = (bf16_t)(x[t] & 0xffffu); dst[(8 * q + 2 * t + 1) * LP + s] = (bf16_t)(x[t] >> 16); } } }
}
__device__ __forceinline__ void stage_N(LAS bf16_t* dst, const bf16_t* src, int ld, size_t row0, int col0, int tid) {
    for (int id = tid; id < 128 * 16; id += 512) { const int q = id & 15, s = id >> 4;
        *(LAS u32x4*)(dst + s * LP + 8 * q) = *(const u32x4*)(src + (row0 + s) * ld + col0 + 8 * q); }
}

typedef short s16x4_t __attribute__((ext_vector_type(4)));
__device__ __forceinline__ bf16x8 frag_tr(const LAS bf16_t* base, int pitch, int krow0, int ncol0, int fr, int fq) {
    const LAS bf16_t* p = base + (krow0 + 8 * fq + (fr >> 2)) * pitch + ncol0 + 4 * (fr & 3);
    const s16x4_t lo = __builtin_bit_cast(s16x4_t, __builtin_amdgcn_ds_read_tr16_b64_v4i16((LAS s16x4_t*)p));
    const s16x4_t hi = __builtin_bit_cast(s16x4_t, __builtin_amdgcn_ds_read_tr16_b64_v4i16((LAS s16x4_t*)(p + 4 * pitch)));
    return (bf16x8){lo[0], lo[1], lo[2], lo[3], hi[0], hi[1], hi[2], hi[3]};
}
__device__ __forceinline__ void stage_NS(LAS bf16_t* dst, int pitch, const bf16_t* src, int ld, size_t row0, int col0, int ncols, const LAS float* wts, int dvw, int tid) {
    const int nch = ncols >> 3;
    for (int id = tid; id < 128 * nch; id += 512) { const int q = id % nch, s = id / nch;
        const u32x4 x = *(const u32x4*)(src + (row0 + s) * ld + col0 + 8 * q); const float wv = wts[((8 * q) / dvw) * 128 + s]; u32x4 o;
#pragma unroll
        for (int t = 0; t < 4; ++t) o[t] = pk2(bf2f(x[t] & 0xffffu) * wv, bf2f(x[t] >> 16) * wv);
        *(LAS u32x4*)(dst + s * pitch + 8 * q) = o; }
}
__device__ __forceinline__ void stage_NW(LAS bf16_t* dst, int pitch, const bf16_t* src, int ld, size_t row0, int col0, int ncols, int tid) {
    const int nch = ncols >> 3;
    for (int id = tid; id < 128 * nch; id += 512) { const int q = id % nch, s = id / nch;
        *(LAS u32x4*)(dst + s * pitch + 8 * q) = *(const u32x4*)(src + (row0 + s) * ld + col0 + 8 * q); }
}

template <int DV, int NH, bool SSD> __device__ __forceinline__ void lin_s1_phase(const LinArgs& A, LAS unsigned char* lds, int tid, int lane, int wave) {
    constexpr int NHT = SSD ? 8 : 4, NG = NHT / NH, NSLAB = NH * DV / 16 / 8, PV = NH * DV + 8;
    LAS bf16_t* KN = (LAS bf16_t*)lds;
    LAS bf16_t* VN = (LAS bf16_t*)(lds + 128 * LP * 2);
    LAS float* wts = (LAS float*)(lds + 128 * LP * 2 + 128 * PV * 2);
    const int fr = lane & 15, fq = lane >> 4;
    for (int u = blockIdx.x; u < NB * NCH * NG; u += gridDim.x) {
        const int grp = u % NG, c = (u / NG) % NCH, b = u / (NG * NCH); const size_t row0 = (size_t)b * SA + 128 * c;
        __syncthreads();
        for (int e = tid; e < 2 * NH * 128; e += 512) { const int dir = e / (NH * 128), hh = (e >> 7) % NH, s = e & 127; float g, gl, dt;
            lin_gdt<SSD>(A, row0, dir, grp * NH + hh, s, g, gl, dt); wts[e] = dt * __expf(gl - g); }
        stage_NW(KN, LP, A.Kn, A.ld, row0, grp * 128, 128, tid);
        stage_NW(VN, PV, A.Vn, A.ld, row0, grp * NH * DV, NH * DV, tid);
        __syncthreads();
#pragma unroll 1
        for (int dir = 0; dir < 2; ++dir) {
#pragma unroll
            for (int sl = 0; sl < NSLAB; ++sl) { const int slab = wave * NSLAB + sl;
                const int hh = (slab * 16) / DV, v0 = (slab * 16) % DV;
                const LAS float* wp = wts + (dir * NH + hh) * 128 + 8 * fq;
                f32x4 acc[8];
#pragma unroll
                for (int nt = 0; nt < 8; ++nt) acc[nt] = (f32x4){0.f, 0.f, 0.f, 0.f};
#pragma unroll
                for (int kk = 0; kk < 4; ++kk) { const bf16x8 vr = frag_tr(VN, PV, 32 * kk, slab * 16, fr, fq);
                    const f32x4 wa = *(const LAS f32x4*)(wp + 32 * kk), wb = *(const LAS f32x4*)(wp + 32 * kk + 4);
                    u32x4 vw;
#pragma unroll
                    for (int t = 0; t < 4; ++t) { const float w0 = t < 2 ? wa[2 * t] : wb[2 * t - 4], w1 = t < 2 ? wa[2 * t + 1] : wb[2 * t - 3];
                        vw[t] = pk2(bf2f((unsigned short)vr[2 * t]) * w0, bf2f((unsigned short)vr[2 * t + 1]) * w1); }
                    const bf16x8 vf = __builtin_bit_cast(bf16x8, vw);
#pragma unroll
                    for (int nt = 0; nt < 8; ++nt) acc[nt] = mfma16(frag_tr(KN, LP, 32 * kk, 16 * nt, fr, fq), vf, acc[nt]); }
                bf16_t* sp = A.ST + ((((size_t)b * 2 + dir) * NCH + c) * NHT + grp * NH + hh) * (size_t)(DV * 128) + (size_t)(v0 + fr) * 128 + 4 * fq;
#pragma unroll
                for (int nt = 0; nt < 8; ++nt) { u32x2 o; o.x = pk2(acc[nt][0], acc[nt][1]); o.y = pk2(acc[nt][2], acc[nt][3]); *(u32x2*)(sp + 16 * nt) = o; }
            }
        }
    }
}

template <int DV, bool SSD> __device__ __forceinline__ void lin_s2_phase(const LinArgs& A, int tid) {
    constexpr int NHT = SSD ? 8 : 4, PER = NHT * DV * 128;
    const int gt = blockIdx.x * 512 + tid, NT_ = gridDim.x * 512;
    for (int it = gt; it < 8 * (PER / 4); it += NT_) {
        const int bd = it / (PER / 4), e = (it % (PER / 4)) * 4, h = e / (DV * 128), dir = bd & 1;
        float run[4] = {0.f, 0.f, 0.f, 0.f};
        float dec_r = 1.f; if (!SSD) dec_r = __expf(-128.f * __expf(A.rld[dir * 4 + (h & 3)]));
        for (int s0 = 0; s0 < NCH; s0 += 11) {
            u32x2 x[11]; float dec[11]; bf16_t* pp[11];
#pragma unroll
            for (int j = 0; j < 11; ++j) { const int st = s0 + j; const int c = dir ? (st < 2 ? 1 - st : NCH + 1 - st) : st;
                pp[j] = A.ST + ((size_t)bd * NCH + c) * PER + e; x[j] = *(const u32x2*)pp[j];
                dec[j] = SSD ? A.CD[((size_t)bd * NCH + c) * 8 + h] : dec_r; }
#pragma unroll
            for (int j = 0; j < 11; ++j) {
                u32x2 o; o.x = pk2(run[0], run[1]); o.y = pk2(run[2], run[3]); *(u32x2*)pp[j] = o;
                run[0] = run[0] * dec[j] + bf2f(x[j].x & 0xffffu); run[1] = run[1] * dec[j] + bf2f(x[j].x >> 16);
                run[2] = run[2] * dec[j] + bf2f(x[j].y & 0xffffu); run[3] = run[3] * dec[j] + bf2f(x[j].y >> 16); }
        }
    }
}
template <int DV, int NH, bool SSD> struct LinEpi;
template <int DV, int NH, int NHU, bool SSD, class Epi> __device__ __forceinline__ void lin_s3_phase(const LinArgs& A, const Epi& E, int cmin, LAS unsigned char* lds, int tid, int lane, int wave) {
    constexpr int NHT = SSD ? 8 : 4, NG = NHT / NH, NSUB = NH / NHU, NVT = DV / 16, NSTD = SSD ? 2 : 1, NDG = 2 / NSTD, TILEB = 128 * LP * 2, NGE = 2 * NHU * 128;
    static_assert(NHU * DV == 128 && NGE <= 512, "unit output tile is 128 x 128");
    LAS bf16_t* KN = (LAS bf16_t*)lds;
    LAS bf16_t* VT = (LAS bf16_t*)(lds + TILEB);
    LAS bf16_t* WL = (LAS bf16_t*)(lds + 2 * TILEB) + wave * 16 * LP;
    LAS bf16_t* STL = (LAS bf16_t*)(lds + 3 * TILEB);
    LAS float* gsm = (LAS float*)(lds + 4 * TILEB);
    LAS float* dsm = gsm + NGE;
    const int fr = lane & 15, fq = lane >> 4, l0 = wave * 16;
    const int nunits = NB * NCH * NG * NSUB, G = gridDim.x;
#define S3_DECODE(uu, sub, grp, c, b) const int sub = (uu) % NSUB, grp = ((uu) / NSUB) % NG, c = ((uu) / (NSUB * NG)) % NCH, b = (uu) / (NSUB * NG * NCH)
    int u = blockIdx.x;
    while (u < nunits && ((u / (NSUB * NG)) % NCH) < cmin) u += G;
    u32x4 kreg[4], vreg[4]; bf16x8 qfn[4]; float gvn = 0.f, dvn = 0.f;
#define S3_LOAD_UNIT(uu) do { S3_DECODE(uu, sub_, grp_, c_, b_); const size_t row0_ = (size_t)b_ * SA + 128 * c_; const int h0_ = grp_ * NH + sub_ * NHU; \
        _Pragma("unroll") for (int i = 0; i < 4; ++i) { const int id = tid + 512 * i, q = id & 15, s_ = id >> 4; \
            kreg[i] = *(const u32x4*)(A.Kn + (row0_ + s_) * A.ld + grp_ * 128 + 8 * q); vreg[i] = *(const u32x4*)(A.Vn + (row0_ + s_) * A.ld + h0_ * DV + 8 * q); } \
        _Pragma("unroll") for (int kk = 0; kk < 4; ++kk) qfn[kk] = *(const bf16x8*)(A.Qn + (row0_ + l0 + fr) * A.ld + grp_ * 128 + 32 * kk + 8 * fq); \
        if (tid < NGE) { const int dir = tid / (NHU * 128), hh_ = (tid >> 7) % NHU, s_ = tid & 127; float gl_; lin_gdt<SSD>(A, row0_, dir, h0_ + hh_, s_, gvn, gl_, dvn); } } while (0)
    while (u < nunits) {
        S3_LOAD_UNIT(u);
        S3_DECODE(u, sub, grp, c, b); const size_t row0 = (size_t)b * SA + 128 * c; const int h0 = grp * NH + sub * NHU;
        int un = u + G; while (un < nunits && ((un / (NSUB * NG)) % NCH) < cmin) un += G;
        __syncthreads();
#pragma unroll
        for (int i = 0; i < 4; ++i) { const int id = tid + 512 * i, q = id & 15, s_ = id >> 4; *(LAS u32x4*)(KN + s_ * LP + 8 * q) = kreg[i]; *(LAS u32x4*)(VT + s_ * LP + 8 * q) = vreg[i]; }
        if (tid < NGE) { gsm[tid] = gvn; dsm[tid] = dvn; }
        bf16x8 qf[4];
#pragma unroll
        for (int kk = 0; kk < 4; ++kk) qf[kk] = qfn[kk];
        u32x4 zreg[4], sreg[4];
#pragma unroll
        for (int i = 0; i < 4; ++i) { const int id = tid + 512 * i, q = id & 15, s_ = id >> 4; zreg[i] = *(const u32x4*)(E.buf + (row0 + s_) * 512 + h0 * DV + 8 * q); }
#define S3_LOAD_ST(stage) do { const int hh_ = (stage) / NDG, dg_ = (stage) % NDG; \
        _Pragma("unroll") for (int i = 0; i < 4; ++i) { const int id = tid + 512 * i, q = id & 15, v = id >> 4, d = v / DV, dir = dg_ * NSTD + d; \
            sreg[i] = *(const u32x4*)(A.ST + ((((size_t)b * 2 + dir) * NCH + c) * NHT + h0 + hh_) * (size_t)(DV * 128) + (size_t)(v - d * DV) * 128 + 8 * q); } } while (0)
        S3_LOAD_ST(0);
        __syncthreads();
        f32x4 P[8];
#pragma unroll
        for (int nt = 0; nt < 8; ++nt) { P[nt] = (f32x4){0.f, 0.f, 0.f, 0.f};
#pragma unroll
            for (int kk = 0; kk < 4; ++kk) P[nt] = mfma16(qf[kk], *(const LAS bf16x8*)(KN + (16 * nt + fr) * LP + 32 * kk + 8 * fq), P[nt]); }
        __syncthreads();
#pragma unroll
        for (int i = 0; i < 4; ++i) { const int id = tid + 512 * i, q = id & 15, s_ = id >> 4; *(LAS u32x4*)(KN + s_ * LP + 8 * q) = zreg[i]; }
#pragma unroll 1
        for (int hh = 0; hh < NHU; ++hh) {
            const int h = h0 + hh;
            const LAS float* gf = gsm + hh * 128; const LAS float* gb = gsm + (NHU + hh) * 128;
            const LAS float* df = dsm + hh * 128; const LAS float* db = dsm + (NHU + hh) * 128;
            float gfl[4], gbl[4];
#pragma unroll
            for (int r = 0; r < 4; ++r) { gfl[r] = gf[l0 + 4 * fq + r]; gbl[r] = gb[l0 + 4 * fq + r]; }
#pragma unroll
            for (int nt = 0; nt < 8; ++nt) { const int s = 16 * nt + fr;
                if (16 * nt + 15 < l0) {
                    const float gfs = gf[s], dfs = df[s];
#pragma unroll
                    for (int r = 0; r < 4; ++r) WL[(4 * fq + r) * LP + s] = (bf16_t)f2bf(P[nt][r] * (__expf(fminf(gfl[r] - gfs, 0.f)) * dfs));
                } else if (16 * nt > l0 + 15) {
                    const float gbs = gb[s], dbs = db[s];
#pragma unroll
                    for (int r = 0; r < 4; ++r) WL[(4 * fq + r) * LP + s] = (bf16_t)f2bf(P[nt][r] * (__expf(fminf(gbl[r] - gbs, 0.f)) * dbs));
                } else {
                    const float gfs = gf[s], gbs = gb[s], dfs = df[s], dbs = db[s];
#pragma unroll
                    for (int r = 0; r < 4; ++r) { const int l = l0 + 4 * fq + r;
                        const float mf = (s <= l) ? __expf(fminf(gfl[r] - gfs, 0.f)) * dfs : 0.f;
                        const float mb = (s >= l) ? __expf(fminf(gbl[r] - gbs, 0.f)) * dbs : 0.f;
                        WL[(4 * fq + r) * LP + s] = (bf16_t)f2bf(P[nt][r] * (mf + mb)); } } }
            asm volatile("s_waitcnt lgkmcnt(0)" ::: "memory");
            bf16x8 af[4];
#pragma unroll
            for (int kk = 0; kk < 4; ++kk) af[kk] = *(const LAS bf16x8*)(WL + fr * LP + 32 * kk + 8 * fq);
            f32x4 y[NVT];
#pragma unroll
            for (int vt = 0; vt < NVT; ++vt) { f32x4 ay = {0.f, 0.f, 0.f, 0.f};
#pragma unroll
                for (int kk = 0; kk < 4; ++kk) ay = mfma16(af[kk], frag_tr(VT, LP, 32 * kk, hh * DV + 16 * vt, fr, fq), ay);
                y[vt] = ay; }
#pragma unroll 1
            for (int dg = 0; dg < NDG; ++dg) {
                __syncthreads();
#pragma unroll
                for (int i = 0; i < 4; ++i) { const int id = tid + 512 * i, q = id & 15, v = id >> 4; *(LAS u32x4*)(STL + v * LP + 8 * q) = sreg[i]; }
                { const int nst = hh * NDG + dg + 1; if (nst < NHU * NDG) S3_LOAD_ST(nst); }
                __syncthreads();
#pragma unroll
                for (int d = 0; d < NSTD; ++d) { const int dir = dg * NSTD + d; float ed[4];
#pragma unroll
                    for (int r = 0; r < 4; ++r) ed[r] = __expf((dir ? gb : gf)[l0 + 4 * fq + r]);
#pragma unroll
                    for (int vt = 0; vt < NVT; ++vt) { f32x4 a0 = {0.f, 0.f, 0.f, 0.f};
#pragma unroll
                        for (int kk = 0; kk < 4; ++kk) a0 = mfma16(qf[kk], *(const LAS bf16x8*)(STL + (d * DV + 16 * vt + fr) * LP + 32 * kk + 8 * fq), a0);
#pragma unroll
                        for (int r = 0; r < 4; ++r) y[vt][r] += ed[r] * a0[r]; } }
            }
            E(y, l0 + 4 * fq, row0 + l0 + 4 * fq, h, hh, fr, VT, KN, lane);
        }
        __syncthreads();
        for (int id = tid; id < 128 * 16; id += 512) { const int q = id & 15, s = id >> 4;
            *(u32x4*)(E.buf + (row0 + s) * 512 + h0 * DV + 8 * q) = *(const LAS u32x4*)(KN + s * LP + 8 * q); }
        u = un;
    }
#undef S3_DECODE
#undef S3_LOAD_UNIT
#undef S3_LOAD_ST
}
struct SsdEpi {
    bf16_t* buf; float* SSQ; const float* dskip;
    __device__ __forceinline__ void operator()(f32x4 (&y)[4], int lb, size_t rowb, int h, int hh, int fr, const LAS bf16_t* VT, LAS bf16_t* ZT, int lane) const {
        const float dsk = dskip[h]; float ss[4] = {0.f, 0.f, 0.f, 0.f};
#pragma unroll
        for (int vt = 0; vt < 4; ++vt)
#pragma unroll
            for (int r = 0; r < 4; ++r) { const int v = 16 * vt + fr; LAS bf16_t* zp = ZT + (lb + r) * LP + hh * 64 + v;
                const float x = bf2f(VT[(lb + r) * LP + hh * 64 + v]);
                const float val = (y[vt][r] + dsk * x) * siluf(bf2f(*zp)); ss[r] += val * val; *zp = (bf16_t)f2bf(val); }
#pragma unroll
        for (int r = 0; r < 4; ++r) { float s = ss[r]; s += shx(s, 1, lane); s += shx(s, 2, lane); s += shx(s, 4, lane); s += shx(s, 8, lane);
            if (fr == 0) SSQ[(rowb + r) * 8 + h] = s; }
    }
};
struct RetEpi {
    bf16_t* buf; const float* gnw;
    __device__ __forceinline__ void operator()(f32x4 (&y)[8], int lb, size_t rowb, int h, int hh, int fr, const LAS bf16_t* VT, LAS bf16_t* ZT, int lane) const {
#pragma unroll
        for (int r = 0; r < 4; ++r) { float s = 0.f;
#pragma unroll
            for (int vt = 0; vt < 8; ++vt) s += y[vt][r];
            s += shx(s, 1, lane); s += shx(s, 2, lane); s += shx(s, 4, lane); s += shx(s, 8, lane);
            const float mu = s * (1.f / 128.f); float q = 0.f;
#pragma unroll
            for (int vt = 0; vt < 8; ++vt) { const float d = y[vt][r] - mu; q += d * d; }
            q += shx(q, 1, lane); q += shx(q, 2, lane); q += shx(q, 4, lane); q += shx(q, 8, lane);
            const float rstd = __builtin_amdgcn_rsqf(q * (1.f / 128.f) + EPS);
#pragma unroll
            for (int vt = 0; vt < 8; ++vt) { const int v = 16 * vt + fr; LAS bf16_t* gp = ZT + (lb + r) * LP + v;
                *gp = (bf16_t)f2bf((y[vt][r] - mu) * rstd * gnw[h * 128 + v] * siluf(bf2f(*gp))); } }
    }
};
#ifdef ONLY_PH
#define EN(x) ((x) == ONLY_PH)
#elif defined(SKIP_PH)
#define EN(x) ((x) != SKIP_PH)
#else
#define EN(x) (MODE == 0 || (MODE == 1 && (x) != 15) || (MODE == 2 && (x) == 15))
#endif
#define XB_TMO      128
#define XB_XCNT(j)  (256  + 64 * (j))
#define XB_XSUB(j)  (1280 + 64 * (j))
#define XB_XGEN(j)  (2304 + 64 * (j))
#define XB_TOP      3328
#define XB_TOPGEN   3392
#define XCD_BAR_WORDS 3456
#define XB_SPIN_CAP (1u << 18)

__device__ __forceinline__ unsigned xb_ld(unsigned* p)              { return __hip_atomic_load(p, __ATOMIC_RELAXED, __HIP_MEMORY_SCOPE_AGENT); }
__device__ __forceinline__ unsigned xb_add(unsigned* p, unsigned v) { return __hip_atomic_fetch_add(p, v, __ATOMIC_RELAXED, __HIP_MEMORY_SCOPE_AGENT); }
__device__ __forceinline__ unsigned xb_xcc_id() { return (unsigned)__builtin_amdgcn_s_getreg((3 << 11) | 20) & 0xFu; }
#define XB_SPIN(cond, bar) do { unsigned _sp = 0; while (cond) { __builtin_amdgcn_s_sleep(1); \
    if ((++_sp & 255u) == 0u) { if (xb_ld(&(bar)[XB_TMO])) break; if (_sp > XB_SPIN_CAP) { atomicAdd(&(bar)[XB_TMO], 1u); break; } } } } while (0)

struct XcdBarrier {
    unsigned* bar; unsigned x;
    volatile LAS unsigned* st;
};

__device__ __forceinline__ XcdBarrier xcd_barrier_post(unsigned* bar, volatile LAS unsigned* st) {
    XcdBarrier b; b.bar = bar; b.x = xb_xcc_id(); b.st = st;
    if (threadIdx.x == 0) (void)xb_add(&bar[XB_XCNT(b.x)], 1u);
    return b;
}
__device__ __forceinline__ void xcd_barrier_complete(unsigned* bar, unsigned x, unsigned& nloc, unsigned& nx) {
    const unsigned G = gridDim.x * gridDim.y * gridDim.z;
    unsigned sum, cnt, mine, sp = 0u;
    for (;;) {
        sum = 0u; cnt = 0u; mine = 0u;
#pragma unroll
        for (unsigned j = 0; j < 16; ++j) { const unsigned c = xb_ld(&bar[XB_XCNT(j)]); sum += c; cnt += (c > 0u) ? 1u : 0u; mine = (j == x) ? c : mine; }
        if (sum == G) break;
        __builtin_amdgcn_s_sleep(1);
        if ((++sp & 255u) == 0u) { if (xb_ld(&bar[XB_TMO])) break; if (sp > XB_SPIN_CAP) { atomicAdd(&bar[XB_TMO], 1u); break; } }
    }
    nloc = mine > 0u ? mine : 1u; nx = cnt > 0u ? cnt : 1u;
}

__device__ __forceinline__ void xcd_barrier(const XcdBarrier& b, const int tid_) {
    asm volatile("s_waitcnt vmcnt(0)" ::: "memory");
    __syncthreads();
    if (tid_ == 0) {
        unsigned* bar = b.bar;
        __builtin_amdgcn_s_waitcnt(0);
        unsigned nloc = b.st[0], nx = b.st[1];
        if (nloc == 0u) { xcd_barrier_complete(bar, b.x, nloc, nx); b.st[0] = nloc; b.st[1] = nx; }
        const unsigned old = xb_add(&bar[XB_XSUB(b.x)], 1u);
        const unsigned gen = old / nloc;
        if (old + 1u == (gen + 1u) * nloc) {
            __builtin_amdgcn_fence(__ATOMIC_RELEASE, "agent");
            asm volatile("s_waitcnt vmcnt(0)" ::: "memory");
            const unsigned og = xb_add(&bar[XB_TOP], 1u);
            const unsigned tg = og / nx;
            if (og + 1u == (tg + 1u) * nx) xb_add(&bar[XB_TOPGEN], 1u);
            else XB_SPIN(xb_ld(&bar[XB_TOPGEN]) == tg, bar);
            __builtin_amdgcn_fence(__ATOMIC_ACQUIRE, "agent");
            xb_add(&bar[XB_XGEN(b.x)], 1u);
            asm volatile("s_waitcnt vmcnt(0)" ::: "memory");
        } else {
            XB_SPIN(xb_ld(&bar[XB_XGEN(b.x)]) == gen, bar);
            __builtin_amdgcn_fence(__ATOMIC_ACQUIRE, "agent");
            asm volatile("s_waitcnt vmcnt(0)" ::: "memory");
        }
    }
    __syncthreads();
}

constexpr size_t OFF_PART = 424 * MiB;
constexpr size_t OFF_BAR = 13 * MiB;
constexpr int MISC_OFF = LDS_BYTES - 64;
constexpr int PH_PER_LAYER = 15, N_PHASES = 2 + DEPTH * PH_PER_LAYER;
#define EN(x) (MODE == 0 || (MODE == 1 && (x) != 15) || (MODE == 2 && (x) == 15))
__device__ __forceinline__ int mk_tid(int wave_id) { unsigned m_ = ~0u; asm volatile("" : "+s"(m_)); int t = wave_id * 64 + (int)__builtin_amdgcn_mbcnt_hi(m_, __builtin_amdgcn_mbcnt_lo(m_, 0u)); asm volatile("" : "+v"(t)); return t; }
#define PHASE_BEGIN(p) if (ph_lo <= (p) && (p) < ph_hi) { int tid = mk_tid(wave_id); const int lane = tid & 63, wave = __builtin_amdgcn_readfirstlane(tid >> 6); \
    CArgsP ap = (CArgsP)__builtin_amdgcn_kernarg_segment_ptr(); asm volatile("" : "+s"(ap)); unsigned char* ws = ap->ws; float* hlat = ap->out; (void)lane; (void)wave; (void)hlat;
#define PHASE_END(p) if ((p) + 1 < ph_hi) { if (ph_hi < 0) grid.sync();   else xcd_barrier(xbar, mk_tid(wave_id)); } }

template <int MODE, int L> __device__ __forceinline__ void layer_phases(cg::grid_group& grid, const XcdBarrier& xbar, const int wave_id, LAS unsigned char* lds, unsigned char* lds_raw, const int ph_lo, const int ph_hi) {
    constexpr int P0 = 1 + L * PH_PER_LAYER;
#define LAYER_COMMON const float* modL = (const float*)(ws + OFF_MOD) + (size_t)L * 5 * MODW; unsigned char* wl = ws + OFF_W + (size_t)L * W_LAYER; \
    const float* bl = L == 0 ? ap->in[0] : hlat; const float* bc = L == 0 ? ap->in[2] : (const float*)(ws + OFF_HCTX);     (void)modL; (void)wl; (void)bl; (void)bc;
    PHASE_BEGIN(P0 + 0) LAYER_COMMON
        if (EN(0)) { if (L == 0) norm_mod_phase(bl, bc, ap->in[6] + L * DM, modL, 0, 1, (bf16_t*)(ws + OFF_U), lane, wave);
                     else norm_mod_phase(bl, bc, ap->in[6] + L * DM, modL, 0, 1, (bf16_t*)(ws + OFF_U), lane, wave, (const float*)(ws + OFF_PART), 16, modL - 5 * MODW + 4 * MODW + 5 * DM, nullptr); }
    PHASE_END(P0 + 0)
    PHASE_BEGIN(P0 + 1) LAYER_COMMON
        if (EN(1)) { pg8::Gemm g{(bf16_t*)(ws + OFF_U), (const bf16_t*)(wl + W_P), 0, 0, T, N1, DM, DM, 0, 1};
            pg8::StaticOrder S; S.init(T, N1, gridDim.x, blockIdx.x);
            pg8::EpiInProj E{ws, (float*)(ws + OFF_DT), ap->in[9] + L * 64, ap->in[10] + L * 64, ap->in[13] + L * 16, (const f32x2*)(ws + OFF_ATAB), (const f32x2*)(ws + OFF_RTAB)};
            pg8::gemm_phase<pg8::EpiInProj, pg8::StaticOrder, true, true>(lds, g, S, E, tid); }
    PHASE_END(P0 + 1)
    PHASE_BEGIN(P0 + 2) LAYER_COMMON
        if (EN(2)) postproj_phase((bf16_t*)(ws + OFF_XBC), (bf16_t*)(ws + OFF_CONV), ap->in[11] + L * 3 * 1024, ap->in[12] + L * 1024, (float*)(ws + OFF_DT), (float*)(ws + OFF_G), (float*)(ws + OFF_CD), ap->in[14] + L * 16, (const bf16_t*)(ws + OFF_U), (const bf16_t*)(wl + W_P) + (size_t)N1 * DM, ap->in[13] + L * 16, tid, lane, wave);
    PHASE_END(P0 + 2)
#define SSD_ARGS LinArgs A{(bf16_t*)(ws + OFF_CONV) + 768, (bf16_t*)(ws + OFF_CONV) + 512, (bf16_t*)(ws + OFF_CONV), 1024, (bf16_t*)(ws + OFF_ST), (float*)(ws + OFF_G), (float*)(ws + OFF_DT), (float*)(ws + OFF_CD), nullptr};
#define RET_ARGS LinArgs A{(bf16_t*)(ws + OFF_RQ), (bf16_t*)(ws + OFF_RK), (bf16_t*)(ws + OFF_RV), 512, (bf16_t*)(ws + OFF_ST), nullptr, nullptr, nullptr, ap->in[17] + L * 8};
    PHASE_BEGIN(P0 + 3) SSD_ARGS if (EN(3)) lin_s1_phase<64, 4, true>(A, lds, tid, lane, wave); PHASE_END(P0 + 3)
    PHASE_BEGIN(P0 + 4) SSD_ARGS if (EN(4)) lin_s2_phase<64, true>(A, tid); PHASE_END(P0 + 4)
    PHASE_BEGIN(P0 + 5) SSD_ARGS if (EN(5)) { SsdEpi E{(bf16_t*)(ws + OFF_Z), (float*)(ws + OFF_SSQ), ap->in[15] + L * 8}; lin_s3_phase<64, 4, 2, true, SsdEpi>(A, E, L == DEPTH - 1 ? 2 : 0, lds, tid, lane, wave); } PHASE_END(P0 + 5)
    PHASE_BEGIN(P0 + 6) RET_ARGS if (EN(6)) lin_s1_phase<128, 1, false>(A, lds, tid, lane, wave); PHASE_END(P0 + 6)
    PHASE_BEGIN(P0 + 7) RET_ARGS if (EN(7)) lin_s2_phase<128, false>(A, tid); PHASE_END(P0 + 7)
    PHASE_BEGIN(P0 + 8) RET_ARGS
        if (EN(8)) { RetEpi E{(bf16_t*)(ws + OFF_RG), ap->in[18] + L * 512}; lin_s3_phase<128, 1, 1, false, RetEpi>(A, E, L == DEPTH - 1 ? 2 : 0, lds, tid, lane, wave); __syncthreads(); }
        if (EN(15)) {
            typedef attn_body::bf16 abf; const abf* Qp = (const abf*)(ws + OFF_Q); const abf* KVp = (const abf*)(ws + OFF_KV);
            if (L < DEPTH - 1) for (int u = (int)((blockIdx.x + gridDim.x - 32u) % gridDim.x); u < NB * 8; u += gridDim.x) { const int b = u >> 3, h = u & 7;     const long r0 = (long)b * SA;
                attn_body::attn_unit<8>(r0, r0, 4, Qp + h * 64, KVp + (h >> 2) * 64, KVp + 128 + (h >> 2) * 64, (abf*)Qp + h * 64, (char*)lds_raw, tid); }
            for (int u = blockIdx.x; u < NB * 8 * 32; u += gridDim.x) { const int x = u & 7, qb = (u >> 3) & 31, i = u >> 8; const int b = x >> 1, h = (x & 1) * 4 + i; const long r0 = (long)b * SA;
                attn_body::attn_unit<8>(r0 + NCTX + 256 * qb, r0, SA / 64, Qp + h * 64, KVp + (h >> 2) * 64, KVp + 128 + (h >> 2) * 64, (abf*)Qp + h * 64, (char*)lds_raw, tid); }
        }
    PHASE_END(P0 + 8)
    PHASE_BEGIN(P0 + 9) LAYER_COMMON
        if (EN(9)) { pg8::Gemm g{(bf16_t*)(ws + OFF_U), (const bf16_t*)(wl + W_G), 0, 0, T, NGATE, DM, DM, 0, 1};
            pg8::StaticOrder S; S.init(T, NGATE, gridDim.x, blockIdx.x, L == DEPTH - 1);
            pg8::EpiBf16<2> E{(bf16_t*)(ws + OFF_GATE), NGATE, 0};
            pg8::gemm_phase<pg8::EpiBf16<2>, pg8::StaticOrder, true, true>(lds, g, S, E, tid); }
    PHASE_END(P0 + 9)
    PHASE_BEGIN(P0 + 10) LAYER_COMMON
        if (EN(10)) { pg8::Gemm g{(bf16_t*)(ws + OFF_Q), (const bf16_t*)(wl + W_B), SZ512, (size_t)DM * 512 * 2, T, DM, 512, 512, 0, 1};
            pg8::MergeOrder S; S.S.init(T, DM, gridDim.x, blockIdx.x, L == DEPTH - 1);
            pg8::EpiMerge E{(bf16_t*)(ws + OFF_GATE), (float*)(ws + OFF_SSQ), (bf16_t*)(ws + OFF_U)};
            pg8::gemm_phase<pg8::EpiMerge, pg8::MergeOrder, true, true>(lds, g, S, E, tid); }
    PHASE_END(P0 + 10)
    PHASE_BEGIN(P0 + 11) LAYER_COMMON
        if (EN(11)) { pg8::Gemm g{(bf16_t*)(ws + OFF_U), (const bf16_t*)(wl + W_O), 0, 0, T, DM, DM, DM, 0, 1};
            pg8::StaticOrder S; S.init(T, DM, gridDim.x, blockIdx.x, 1);
            pg8::EpiResid E{bl, bc, hlat, (float*)(ws + OFF_HCTX), modL + 2 * DM};
            pg8::gemm_phase<pg8::EpiResid, pg8::StaticOrder, true, true>(lds, g, S, E, tid);
            if (L < DEPTH - 1) { pg8::Gemm g2{(bf16_t*)(ws + OFF_U), (const bf16_t*)(wl + W_O), 512, 131072, T, DM, 256, DM, 0, 1};
                pg8::CtxSplitOrder S2{4, (int)gridDim.x, (int)blockIdx.x}; pg8::EpiPartial E2{(float*)(ws + OFF_PART)};
                pg8::gemm_phase<pg8::EpiPartial, pg8::CtxSplitOrder, true, true>(lds, g2, S2, E2, mk_tid(wave_id)); } }
    PHASE_END(P0 + 11)
    PHASE_BEGIN(P0 + 12) LAYER_COMMON
        if (EN(12)) { if (L == 0) norm_mod_phase(hlat, ap->in[2], ap->in[7] + L * DM, modL, 3, 4, (bf16_t*)(ws + OFF_U), lane, wave, (const float*)(ws + OFF_PART), 4, modL + 4 * MODW + 2 * DM, (float*)(ws + OFF_HCTX));
                      else norm_mod_phase(hlat, (const float*)(ws + OFF_HCTX), ap->in[7] + L * DM, modL, 3, 4, (bf16_t*)(ws + OFF_U), lane, wave); }
    PHASE_END(P0 + 12)
    PHASE_BEGIN(P0 + 13) LAYER_COMMON
        if (EN(13)) { pg8::Gemm g{(bf16_t*)(ws + OFF_U), (const bf16_t*)(wl + W_1), 0, 0, T, HID, DM, DM, 0, 1};
            pg8::StaticOrder S; S.init(T, HID, gridDim.x, blockIdx.x, L == DEPTH - 1);
            pg8::EpiBf16<1> E{(bf16_t*)(ws + OFF_HID), HID, 1};
            pg8::gemm_phase<pg8::EpiBf16<1>, pg8::StaticOrder, true, true>(lds, g, S, E, tid); }
    PHASE_END(P0 + 13)
    PHASE_BEGIN(P0 + 14) LAYER_COMMON
        if (EN(14)) { pg8::Gemm g{(bf16_t*)(ws + OFF_HID), (const bf16_t*)(wl + W_2), 0, 0, T, DM, HID, HID, 1, 1};
            pg8::StaticOrder S; S.init(T, DM, gridDim.x, blockIdx.x, 1);
            pg8::EpiResid E{hlat, (const float*)(ws + OFF_HCTX), hlat, (float*)(ws + OFF_HCTX), modL + 5 * DM};
            pg8::gemm_phase<pg8::EpiResid, pg8::StaticOrder, true, true>(lds, g, S, E, tid);
            if (L < DEPTH - 1) { pg8::Gemm g2{(bf16_t*)(ws + OFF_HID), (const bf16_t*)(wl + W_2), 131072, 131072, T, DM, 256, HID, 1, 1};
                pg8::CtxSplitOrder S2{16, (int)gridDim.x, (int)blockIdx.x}; pg8::EpiPartial E2{(float*)(ws + OFF_PART)};
                pg8::gemm_phase<pg8::EpiPartial, pg8::CtxSplitOrder, true, true>(lds, g2, S2, E2, mk_tid(wave_id)); } }
    PHASE_END(P0 + 14)
}

template <int MODE> __global__ void __launch_bounds__(512, 2) mega_fwd(Args args) {
    extern __shared__ __attribute__((aligned(16))) unsigned char lds_raw[];
    LAS unsigned char* lds = (LAS unsigned char*)lds_raw;
    cg::grid_group grid = cg::this_grid();
    const int ph_lo = args.ph_lo, ph_hi = args.ph_hi;
    if (threadIdx.x < 16) ((LAS unsigned*)(lds + MISC_OFF))[threadIdx.x] = 0u;
    __syncthreads();
    const int wave_id = __builtin_amdgcn_readfirstlane((int)threadIdx.x >> 6);
    XcdBarrier xbar; xbar.bar = (unsigned*)(args.ws + OFF_BAR); xbar.x = 0; xbar.st = nullptr;
    if (ph_hi - ph_lo > 1) xbar = xcd_barrier_post((unsigned*)(args.ws + OFF_BAR), (volatile LAS unsigned*)(lds + MISC_OFF));
    PHASE_BEGIN(0) if (EN(100)) prologue_phase(ap, lds, tid, lane, wave); PHASE_END(0)
    layer_phases<MODE, 0>(grid, xbar, wave_id, lds, lds_raw, ph_lo, ph_hi);
    layer_phases<MODE, 1>(grid, xbar, wave_id, lds, lds_raw, ph_lo, ph_hi);
    PHASE_BEGIN(N_PHASES - 1) if (EN(101)) final_norm_phase(hlat, ap->in[23], lane, wave); PHASE_END(N_PHASES - 1)
}

extern "C" void kernel_launch(void* const* d_in, const int* in_sizes, int n_in, void* d_out, int out_size, void* d_ws, size_t ws_size, hipStream_t stream) {
    static int grid = 0;
    if (grid == 0) {
        if (n_in != 24 || ws_size < OFF_END) { fprintf(stderr, "kernel_launch: unexpected problem (n_in %d, ws %zu)\n", n_in, ws_size); grid = -1; return; }
        int dev = 0, cus = 0, per_cu = 0;
        (void)hipGetDevice(&dev); (void)hipDeviceGetAttribute(&cus, hipDeviceAttributeMultiprocessorCount, dev);
        #if MK_ONE_LAUNCH
        (void)hipFuncSetAttribute((const void*)mega_fwd<0>, hipFuncAttributeMaxDynamicSharedMemorySize, LDS_BYTES);
#else
        (void)hipFuncSetAttribute((const void*)mega_fwd<1>, hipFuncAttributeMaxDynamicSharedMemorySize, LDS_BYTES); (void)hipFuncSetAttribute((const void*)mega_fwd<2>, hipFuncAttributeMaxDynamicSharedMemorySize, LDS_BYTES);
#endif
        (void)hipOccupancyMaxActiveBlocksPerMultiprocessor(&per_cu, (const void*)mega_fwd<MK_ONE_LAUNCH ? 0 : 1>, 512, LDS_BYTES);
        if (per_cu < 1) { fprintf(stderr, "kernel_launch: occupancy query says %d\n", per_cu); per_cu = 1; }
        (void)hipGetLastError();
        grid = cus * 1;
    }
    if (grid < 0) return;
    Args a{};
    for (int i = 0; i < 24; ++i) a.in[i] = (const float*)d_in[i];
    a.out = (float*)d_out; a.ws = (unsigned char*)d_ws;
#if MK_ONE_LAUNCH
    (void)hipMemsetAsync((char*)d_ws + OFF_BAR, 0, 16384, stream);
    a.ph_lo = 0; a.ph_hi = N_PHASES;
    { void* kargs[] = {&a}; hipError_t e = hipLaunchCooperativeKernel((const void*)mega_fwd<0>, dim3(grid), dim3(512), kargs, LDS_BYTES, stream);
      if (e != hipSuccess) fprintf(stderr, "cooperative launch failed: %s\n", hipGetErrorString(e)); }
#ifdef PROBE_LO
    (void)hipMemsetAsync((char*)d_ws + OFF_BAR, 0, 16384, stream);
    a.ph_lo = PROBE_LO; a.ph_hi = PROBE_HI;
    { void* kargs[] = {&a}; (void)hipLaunchCooperativeKernel((const void*)mega_fwd<0>, dim3(grid), dim3(512), kargs, LDS_BYTES, stream); }
#endif
#else
    for (int ph = 0; ph < N_PHASES; ++ph) { a.ph_lo = ph; a.ph_hi = ph + 1; void* kargs[] = {&a};
        hipError_t e = hipLaunchCooperativeKernel((const void*)mega_fwd<1>, dim3(grid), dim3(512), kargs, LDS_BYTES, stream);
        if (e != hipSuccess) { fprintf(stderr, "launch %d failed: %s\n", ph, hipGetErrorString(e)); break; }
        if (ph >= 1 && ph < N_PHASES - 1 && (ph - 1) % PH_PER_LAYER == 8) { e = hipLaunchCooperativeKernel((const void*)mega_fwd<2>, dim3(grid), dim3(512), kargs, LDS_BYTES, stream);
            if (e != hipSuccess) { fprintf(stderr, "attn launch %d failed: %s\n", ph, hipGetErrorString(e)); break; } } }
#endif
}
```
